# Optimizing an MI355X kernel written in HIP

```python
import math
import jax, jax.numpy as jnp
from jax import lax
import numpy as np

D_MODEL = 1024
BATCH = 8
SEQ = 2048
DEPTH = 2

RWKV_HEAD_SIZE = 64
RWKV_HEADS = D_MODEL // RWKV_HEAD_SIZE
DECAY_LORA = 64
AAA_LORA = 64
GATE_LORA = 128
RWKV_GN_EPS = 64e-5
N_LERP = 6
BRANCHES = ((128, 1), (512, 4), (2048, 16))
N_BRANCH = len(BRANCHES)
ATTN_HEAD_DIM = 64
HEADS_PER_BRANCH = 8
Q_DIM = N_BRANCH * HEADS_PER_BRANCH * ATTN_HEAD_DIM
ATTN_OUT_DIM = HEADS_PER_BRANCH * ATTN_HEAD_DIM
Q_BLOCK = 128
ALIBI_MAX = 8.0
FF_DENSE = 2816
N_EXPERTS = 8
TOP_K = 2
FF_EXPERT = 3584
RMS_EPS = 1e-5

kernel_name = "rwkv7_yoco_dilated_moe_block"


def _layer_counts():
    n_a = DEPTH - DEPTH // 2
    n_b = DEPTH // 2
    n_dense = (DEPTH + 1) // 2
    n_moe = DEPTH // 2
    return n_a, n_b, n_dense, n_moe


def rmsnorm(x, g):
    xf = x.astype(jnp.float32)
    y = xf * lax.rsqrt(jnp.mean(xf * xf, axis=-1, keepdims=True) + RMS_EPS)
    return (y * g.astype(jnp.float32)).astype(x.dtype)


def token_shift(h):
    return jnp.pad(h[:, :-1], ((0, 0), (1, 0), (0, 0)))


def wkv7_scan(r, decay, k, v, kk, a):
    b, _, h, n = r.shape

    def step(state, inp):
        r_t, w_t, k_t, v_t, kk_t, a_t = inp
        sa = jnp.einsum('bhvk,bhk->bhv', state, -kk_t)
        state = (state * w_t[:, :, None, :]
                 + sa[..., None] * (kk_t * a_t)[:, :, None, :]
                 + v_t[..., None] * k_t[:, :, None, :])
        y = jnp.einsum('bhvk,bhk->bhv', state, r_t)
        return state, y

    xs = tuple(jnp.moveaxis(t, 1, 0) for t in (r, decay, k, v, kk, a))
    state0 = jnp.zeros((b, h, n, n), jnp.float32)
    _, y = lax.scan(step, state0, xs)
    return jnp.moveaxis(y, 0, 1)


def rwkv7_time_mix(h, mu, wr, wk, wv, w0, w1, w2, a0, a1, a2, g1, g2,
                   k_k, k_a, r_k, lnx_w, lnx_b, wo):
    b, s, d = h.shape
    xx = token_shift(h) - h
    xr, xw, xk, xv, xa, xg = (h + xx * mu[i] for i in range(N_LERP))
    r = xr @ wr
    k = xk @ wk
    v = xv @ wv
    w_log = -jax.nn.softplus(-(w0 + jnp.tanh(xw @ w1) @ w2)) - 0.5
    a = jax.nn.sigmoid(a0 + (xa @ a1) @ a2)
    g = jax.nn.sigmoid(xg @ g1) @ g2

    def heads(t):
        return t.reshape(b, s, RWKV_HEADS, RWKV_HEAD_SIZE).astype(jnp.float32)

    kk = heads(k * k_k)
    kk = kk / jnp.maximum(jnp.sqrt(jnp.sum(kk * kk, axis=-1, keepdims=True)), 1e-12)
    k = k * (1.0 + (a - 1.0) * k_a)
    decay = jnp.exp(-jnp.exp(heads(w_log)))
    rh, kh, vh, ah = heads(r), heads(k), heads(v), heads(a)
    y = wkv7_scan(rh, decay, kh, vh, kk, ah)
    mean = jnp.mean(y, axis=-1, keepdims=True)
    var = jnp.mean(jnp.square(y - mean), axis=-1, keepdims=True)
    yn = ((y - mean) * lax.rsqrt(var + RWKV_GN_EPS)).reshape(b, s, d)
    yn = yn * lnx_w.astype(jnp.float32) + lnx_b.astype(jnp.float32)
    bonus = (jnp.sum(rh * kh * r_k.astype(jnp.float32), axis=-1, keepdims=True) * vh).reshape(b, s, d)
    return ((yn + bonus).astype(h.dtype) * g) @ wo


def dilated_branch(q, k, v, slopes, window, dilation):
    b, s, h, dh = q.shape
    n_keys = window // dilation + 1
    offs = jnp.arange(n_keys, dtype=jnp.int32) * dilation
    dist = offs.astype(jnp.float32)
    scale = 1.0 / math.sqrt(dh)
    slopes = slopes.astype(jnp.float32)

    def block(i):
        t = i * Q_BLOCK + jnp.arange(Q_BLOCK, dtype=jnp.int32)
        pos = t[:, None] - offs[None, :]
        valid = pos >= 0
        idx = jnp.maximum(pos, 0)
        qb = lax.dynamic_slice_in_dim(q, i * Q_BLOCK, Q_BLOCK, axis=1)
        kg = jnp.take(k, idx, axis=1)
        vg = jnp.take(v, idx, axis=1)
        sc = jnp.einsum('bqhd,bqkhd->bhqk', qb, kg).astype(jnp.float32) * scale
        sc = sc - slopes[None, :, None, None] * dist[None, None, None, :]
        sc = jnp.where(valid[None, None], sc, -jnp.inf)
        lse = jax.nn.logsumexp(sc, axis=-1)
        p = jnp.exp(sc - lse[..., None])
        o = jnp.einsum('bhqk,bqkhd->bqhd', p.astype(vg.dtype), vg)
        return o, jnp.transpose(lse, (0, 2, 1))

    o, lse = lax.map(block, jnp.arange(s // Q_BLOCK, dtype=jnp.int32))
    o = jnp.moveaxis(o, 0, 1).reshape(b, s, h, dh)
    lse = jnp.moveaxis(lse, 0, 1).reshape(b, s, h)
    return o, lse


def dilated_attention(h, wq, wo, k_sh, v_sh, slopes):
    b, s, _ = h.shape
    q = (h @ wq).reshape(b, s, N_BRANCH, HEADS_PER_BRANCH, ATTN_HEAD_DIM)
    outs, lses = [], []
    for gi, (window, dilation) in enumerate(BRANCHES):
        o, lse = dilated_branch(q[:, :, gi], k_sh[:, :, gi], v_sh[:, :, gi], slopes[gi], window, dilation)
        outs.append(o)
        lses.append(lse)
    wts = jax.nn.softmax(jnp.stack(lses), axis=0)
    o = jnp.sum(wts[..., None] * jnp.stack(outs).astype(jnp.float32), axis=0)
    return o.reshape(b, s, ATTN_OUT_DIM).astype(h.dtype) @ wo


def swiglu(h, w1, w3, w2):
    return (jax.nn.silu(h @ w1) * (h @ w3)) @ w2


def moe_swiglu(h, router, router_bias, w1, w3, w2):
    b, s, d = h.shape
    t = h.reshape(b * s, d)
    logits = (t @ router + router_bias).astype(jnp.float32)
    top_v, top_i = lax.top_k(logits, TOP_K)
    top_w = jax.nn.softmax(top_v, axis=-1)
    gates = jnp.sum(jax.nn.one_hot(top_i, N_EXPERTS, dtype=jnp.float32) * top_w[..., None], axis=1)
    out = jnp.zeros_like(t)
    for e in range(N_EXPERTS):
        out = out + gates[:, e:e + 1].astype(t.dtype) * swiglu(t, w1[e], w3[e], w2[e])
    return out.reshape(b, s, d)


def alibi_slopes():
    n = N_BRANCH * HEADS_PER_BRANCH
    sl = jnp.exp2(-ALIBI_MAX * (jnp.arange(n, dtype=jnp.float32) + 1.0) / n)
    return sl.reshape(N_BRANCH, HEADS_PER_BRANCH)


def setup_inputs(seed: int = 0) -> dict:
    key = jax.random.key(seed)
    ks = iter(jax.random.split(key, 48))
    n_a, n_b, n_dense, n_moe = _layer_counts()
    D = D_MODEL

    def nrm(shape, scale):
        return jax.random.normal(next(ks), shape, jnp.float32) * scale

    def unif(shape, lo, hi):
        return jax.random.uniform(next(ks), shape, jnp.float32, lo, hi)

    return {
        "x": nrm((BATCH, SEQ, D), 1.0),
        "norm_gain": 1.0 + nrm((DEPTH, 2, D), 0.05),
        "rwkv_mu": unif((n_a, N_LERP, D), 0.0, 1.0),
        "rwkv_wr": nrm((n_a, D, D), D ** -0.5),
        "rwkv_wk": nrm((n_a, D, D), D ** -0.5),
        "rwkv_wv": nrm((n_a, D, D), D ** -0.5),
        "rwkv_w0": unif((n_a, D), -6.0, -1.0),
        "rwkv_w1": nrm((n_a, D, DECAY_LORA), D ** -0.5),
        "rwkv_w2": nrm((n_a, DECAY_LORA, D), 0.5 * DECAY_LORA ** -0.5),
        "rwkv_a0": unif((n_a, D), -1.0, 1.0),
        "rwkv_a1": nrm((n_a, D, AAA_LORA), D ** -0.5),
        "rwkv_a2": nrm((n_a, AAA_LORA, D), 0.5 * AAA_LORA ** -0.5),
        "rwkv_g1": nrm((n_a, D, GATE_LORA), D ** -0.5),
        "rwkv_g2": nrm((n_a, GATE_LORA, D), GATE_LORA ** -0.5),
        "rwkv_k_k": 0.85 + nrm((n_a, D), 0.05),
        "rwkv_k_a": 1.0 + nrm((n_a, D), 0.05),
        "rwkv_r_k": nrm((n_a, RWKV_HEADS, RWKV_HEAD_SIZE), 0.1),
        "rwkv_lnx_w": 1.0 + nrm((n_a, D), 0.05),
        "rwkv_lnx_b": nrm((n_a, D), 0.02),
        "rwkv_wo": nrm((n_a, D, D), D ** -0.5),
        "kv_norm_gain": 1.0 + nrm((D,), 0.05),
        "w_kv": nrm((D, 2 * Q_DIM), D ** -0.5),
        "attn_wq": nrm((n_b, D, Q_DIM), D ** -0.5),
        "attn_wo": nrm((n_b, ATTN_OUT_DIM, D), ATTN_OUT_DIM ** -0.5),
        "ffn_w1": nrm((n_dense, D, FF_DENSE), D ** -0.5),
        "ffn_w3": nrm((n_dense, D, FF_DENSE), D ** -0.5),
        "ffn_w2": nrm((n_dense, FF_DENSE, D), FF_DENSE ** -0.5),
        "moe_router": nrm((n_moe, D, N_EXPERTS), D ** -0.5),
        "moe_router_bias": nrm((n_moe, N_EXPERTS), 0.01),
        "moe_w1": nrm((n_moe, N_EXPERTS, D, FF_EXPERT), D ** -0.5),
        "moe_w3": nrm((n_moe, N_EXPERTS, D, FF_EXPERT), D ** -0.5),
        "moe_w2": nrm((n_moe, N_EXPERTS, FF_EXPERT, D), FF_EXPERT ** -0.5),
        "final_norm_gain": 1.0 + nrm((D,), 0.05),
    }


def reference(x, norm_gain, rwkv_mu, rwkv_wr, rwkv_wk, rwkv_wv, rwkv_w0, rwkv_w1, rwkv_w2,
              rwkv_a0, rwkv_a1, rwkv_a2, rwkv_g1, rwkv_g2, rwkv_k_k, rwkv_k_a, rwkv_r_k,
              rwkv_lnx_w, rwkv_lnx_b, rwkv_wo, kv_norm_gain, w_kv, attn_wq, attn_wo,
              ffn_w1, ffn_w3, ffn_w2, moe_router, moe_router_bias, moe_w1, moe_w3, moe_w2,
              final_norm_gain):
    n_a, n_b, n_dense, n_moe = _layer_counts()
    b, s, _ = x.shape
    slopes = alibi_slopes()
    k_sh = v_sh = None
    for l in range(DEPTH):
        if l < n_a:
            h = rmsnorm(x, norm_gain[l, 0])
            x = x + rwkv7_time_mix(h, rwkv_mu[l], rwkv_wr[l], rwkv_wk[l], rwkv_wv[l],
                                   rwkv_w0[l], rwkv_w1[l], rwkv_w2[l],
                                   rwkv_a0[l], rwkv_a1[l], rwkv_a2[l],
                                   rwkv_g1[l], rwkv_g2[l], rwkv_k_k[l], rwkv_k_a[l], rwkv_r_k[l],
                                   rwkv_lnx_w[l], rwkv_lnx_b[l], rwkv_wo[l])
        else:
            if l == n_a:
                kv = (rmsnorm(x, kv_norm_gain) @ w_kv).reshape(
                    b, s, 2, N_BRANCH, HEADS_PER_BRANCH, ATTN_HEAD_DIM)
                k_sh, v_sh = kv[:, :, 0], kv[:, :, 1]
            j = l - n_a
            h = rmsnorm(x, norm_gain[l, 0])
            x = x + dilated_attention(h, attn_wq[j], attn_wo[j], k_sh, v_sh, slopes)
        h = rmsnorm(x, norm_gain[l, 1])
        if l % 2 == 0:
            i = l // 2
            x = x + swiglu(h, ffn_w1[i], ffn_w3[i], ffn_w2[i])
        else:
            i = l // 2
            x = x + moe_swiglu(h, moe_router[i], moe_router_bias[i], moe_w1[i], moe_w3[i], moe_w2[i])
    return rmsnorm(x, final_norm_gain)
```

```cpp
#include <hip/hip_runtime.h>
#include <cstdio>
#include <cstdint>

#ifndef MK_ONE_LAUNCH
#define MK_ONE_LAUNCH 0
#endif

namespace pg8 {
#define PG8_LAS __attribute__((address_space(3)))
typedef unsigned short bf16_t;
typedef short bf16x8 __attribute__((ext_vector_type(8)));
typedef float f32x4 __attribute__((ext_vector_type(4)));
typedef unsigned u32x4 __attribute__((ext_vector_type(4)));
typedef unsigned u32x2 __attribute__((ext_vector_type(2)));
constexpr int BM = 256, BK = 64, HALF = 128, HTB = HALF * BK * 2, STAGE_BYTES = 8 * HTB, NXCD = 8, WGM = 8;

__host__ __device__ __forceinline__ int lds_byte(int r, int c) { const int st = (r >> 4) * 2 + (c >> 5), rr = r & 15, cc = c & 31, ob = rr * 64 + cc * 2; return st * 1024 + (ob ^ (((ob >> 9) & 1) << 5)); }
__host__ __device__ __forceinline__ void stage_rc(int b, int& R, int& C) { const int st = b / 1024, sb = b % 1024, swz = sb ^ (((sb >> 9) & 1) << 5); R = (st >> 1) * 16 + swz / 64; C = (st & 1) * 32 + (swz % 64) / 2; }
__host__ __device__ __forceinline__ int perm32(int rho) { const int n = rho >> 4, i = rho & 15; return 8 * (i >> 2) + 4 * n + (i & 3); }

struct Unit { int pm, pn, e; };
struct Gemm { const bf16_t* A; const bf16_t* Bt; int lda, K; size_t bstride_e; };

struct StaticOrder {
    int nM, nN, nwg, G, c;
    __device__ void init(int nM_, int nN_, int G_, int c_) { nM = nM_; nN = nN_; nwg = nM * nN; G = G_; c = c_; }
    __device__ bool next(int i, Unit& u) const {
        const long L = (long)i * G + c; if (L >= nwg) return false;
        int wgid = (int)L; { const int q = nwg / NXCD, r = nwg % NXCD, xcd = wgid % NXCD, off = wgid / NXCD; wgid = (xcd < r ? xcd * (q + 1) : r * (q + 1) + (xcd - r) * q) + off; }
        const int nig = WGM * nN, gid = wgid / nig, fm = gid * WGM, gsz = (nM - fm) < WGM ? (nM - fm) : WGM;
        u.pm = fm + ((wgid % nig) % gsz); u.pn = (wgid % nig) / gsz; u.e = 0; return true;
    }
};
struct MoeOrder {
    int nM, nN, nwg, G, c; int tp[9];
    __device__ void init(const int* cnt, int nN_, int G_, int c_) { int s = 0;
_Pragma("unroll")
        for (int e = 0; e < 8; ++e) { tp[e] = s; s += (cnt[e] + 255) >> 8; } tp[8] = s; nM = s; nN = nN_; nwg = nM * nN; G = G_; c = c_; }
    __device__ bool next(int i, Unit& u) const {
        const long L = (long)i * G + c; if (L >= nwg) return false;
        int wgid = (int)L; { const int q = nwg / NXCD, r = nwg % NXCD, xcd = wgid % NXCD, off = wgid / NXCD; wgid = (xcd < r ? xcd * (q + 1) : r * (q + 1) + (xcd - r) * q) + off; }
        const int nig = WGM * nN, gid = wgid / nig, fm = gid * WGM, gsz = (nM - fm) < WGM ? (nM - fm) : WGM;
        u.pm = fm + ((wgid % nig) % gsz); u.pn = (wgid % nig) / gsz;
        int e = 0;
#pragma unroll
        for (int k = 1; k < 8; ++k) e += (u.pm >= tp[k]) ? 1 : 0;
        u.e = e; return true;
    }
};

__device__ __forceinline__ unsigned cvt_pk_bf16(float lo, float hi) { unsigned r; asm volatile("v_cvt_pk_bf16_f32 %0, %1, %2" : "=v"(r) : "v"(lo), "v"(hi)); return r; }

template <class Epi, class Sched>
__device__ __forceinline__ void gemm_phase(PG8_LAS unsigned char* lds, const Gemm g, const Sched& S, const Epi& E) {
    const int tid = threadIdx.x, wid = __builtin_amdgcn_readfirstlane(tid >> 6), lane = tid & 63, wr = wid >> 2, wc = wid & 3, fr = lane & 15, fq = lane >> 4;
    int K = g.K; asm volatile("" : "+s"(K));
    const int nt = K / BK, lda = g.lda;
    unsigned voffA[2], voffB[2];
#pragma unroll
    for (int i = 0; i < 2; ++i) { int R, C; stage_rc(tid * 16 + i * 8192, R, C); const int Rb = (R & ~31) + perm32(R & 31);
        voffA[i] = (unsigned)(R * lda + C) * 2u; voffB[i] = (unsigned)(Rb * K + C) * 2u; }
    const size_t kstep = (size_t)(BK * 2);
    const size_t hstepA = (size_t)HALF * lda * 2, hstepB = (size_t)HALF * K * 2;
    const size_t tstepA = 2 * hstepA, tstepB = 2 * hstepB;
    const unsigned ldsw = (unsigned)wid * 1024u;
    const int aoff = lds_byte(wr * 64 + fr, fq * 8), boff = lds_byte(wc * 32 + fr, fq * 8);
#define PG8_SA(b, h) (((b) * 2 + (h)) * HTB)
#define PG8_SB(b, h) ((4 + (b) * 2 + (h)) * HTB)
#define PG8_STAGE(bufoff, gbase, voff) do { _Pragma("unroll") for (int _i = 0; _i < 2; ++_i) \
        __builtin_amdgcn_global_load_lds((const unsigned*)((const char*)(gbase) + (voff)[_i]), (PG8_LAS unsigned*)(lds + (bufoff) + ldsw + _i * 8192), 16, 0, 0); } while (0)
#define PG8_LDA(dst, b, h) do { _Pragma("unroll") for (int m = 0; m < 4; ++m) _Pragma("unroll") for (int k = 0; k < 2; ++k) dst[m][k] = *(const PG8_LAS bf16x8*)(lds + PG8_SA(b, h) + aoff + m * 2048 + k * 1024); } while (0)
#define PG8_LDB(dst, b, h) do { _Pragma("unroll") for (int n = 0; n < 2; ++n) _Pragma("unroll") for (int k = 0; k < 2; ++k) dst[n][k] = *(const PG8_LAS bf16x8*)(lds + PG8_SB(b, h) + boff + n * 2048 + k * 1024); } while (0)
#define PG8_MMA(ai, bj, At, Bt) do { __builtin_amdgcn_s_setprio(1); _Pragma("unroll") for (int m = 0; m < 4; ++m) _Pragma("unroll") for (int n = 0; n < 2; ++n) _Pragma("unroll") for (int k = 0; k < 2; ++k) \
        acc[ai][bj][m][n] = __builtin_amdgcn_mfma_f32_16x16x32_bf16(Bt[n][k], At[m][k], acc[ai][bj][m][n], 0, 0, 0); __builtin_amdgcn_s_setprio(0); } while (0)
#define PG8_WAIT_V(n) asm volatile("s_waitcnt vmcnt(" #n ")" ::: "memory")
#define PG8_WAIT_L(n) asm volatile("s_waitcnt lgkmcnt(" #n ")" ::: "memory")
#define PG8_BAR __builtin_amdgcn_s_barrier()
#define PG8_SCHED __builtin_amdgcn_sched_barrier(0)
    Unit cur, nxt; int ui = 0;
    if (!S.next(0, cur)) return;
    f32x4 acc[2][2][4][2];
#pragma unroll
    for (int a = 0; a < 2; ++a)
#pragma unroll
        for (int b = 0; b < 2; ++b)
#pragma unroll
            for (int m = 0; m < 4; ++m)
#pragma unroll
                for (int n = 0; n < 2; ++n) acc[a][b][m][n] = (f32x4){0.f, 0.f, 0.f, 0.f};
    bf16x8 At[4][2], B0[2][2], B1[2][2];
    const char* cA = (const char*)g.A + (size_t)cur.pm * tstepA; const char* cB = (const char*)(g.Bt + (size_t)cur.e * g.bstride_e) + (size_t)cur.pn * tstepB;
    PG8_STAGE(PG8_SB(0, 0), cB, voffB); PG8_STAGE(PG8_SB(0, 1), cB + hstepB, voffB); PG8_STAGE(PG8_SA(0, 0), cA, voffA); PG8_STAGE(PG8_SA(0, 1), cA + hstepA, voffA);
    if (wr == 1) PG8_BAR;
    PG8_WAIT_V(2); PG8_BAR;
    PG8_STAGE(PG8_SB(1, 0), cB + kstep, voffB); PG8_STAGE(PG8_SA(1, 0), cA + kstep, voffA); PG8_STAGE(PG8_SB(1, 1), cB + hstepB + kstep, voffB);
    PG8_WAIT_V(6); PG8_BAR;
    for (;;) {
        const bool has_next = S.next(ui + 1, nxt);
        const char* nA = has_next ? (const char*)g.A + (size_t)nxt.pm * tstepA : cA;
        const char* nB = has_next ? (const char*)(g.Bt + (size_t)nxt.e * g.bstride_e) + (size_t)nxt.pn * tstepB : cB;
        for (int t = 0; t < nt; t += 2) {
            const bool last = (t == nt - 2);
            const char* a1 = cA + (size_t)(t + 1) * kstep;
            const char* a2 = last ? nA : cA + (size_t)(t + 2) * kstep; const char* b2 = last ? nB : cB + (size_t)(t + 2) * kstep;
            const char* a3 = a2 + kstep; const char* b3 = b2 + kstep;
            PG8_LDB(B0, 0, 0); PG8_LDB(B1, 0, 1); PG8_SCHED; PG8_LDA(At, 0, 0); PG8_STAGE(PG8_SA(1, 1), a1 + hstepA, voffA);
            PG8_WAIT_V(8); PG8_WAIT_L(0); PG8_BAR; PG8_MMA(0, 0, At, B0); PG8_MMA(0, 1, At, B1); PG8_BAR; PG8_SCHED;
            PG8_LDA(At, 0, 1); PG8_STAGE(PG8_SB(0, 0), b2, voffB); PG8_STAGE(PG8_SB(0, 1), b2 + hstepB, voffB); PG8_STAGE(PG8_SA(0, 0), a2, voffA);
            PG8_WAIT_V(8); PG8_WAIT_L(0); PG8_BAR; PG8_MMA(1, 0, At, B0); PG8_MMA(1, 1, At, B1); PG8_BAR; PG8_SCHED;
            PG8_LDB(B0, 1, 0); PG8_LDB(B1, 1, 1); PG8_SCHED; PG8_LDA(At, 1, 0); PG8_STAGE(PG8_SA(0, 1), a2 + hstepA, voffA);
            PG8_WAIT_V(8); PG8_WAIT_L(0); PG8_BAR; PG8_MMA(0, 0, At, B0); PG8_MMA(0, 1, At, B1); PG8_BAR; PG8_SCHED;
            PG8_LDA(At, 1, 1); PG8_STAGE(PG8_SB(1, 0), b3, voffB); PG8_STAGE(PG8_SB(1, 1), b3 + hstepB, voffB); PG8_STAGE(PG8_SA(1, 0), a3, voffA);
            PG8_WAIT_V(8); PG8_WAIT_L(0); PG8_BAR; PG8_MMA(1, 0, At, B0); PG8_MMA(1, 1, At, B1); PG8_BAR; PG8_SCHED;
        }
        if (wr == 0) PG8_BAR;
        E(acc, cur, wr, wc, fr, fq);
        if (!has_next) break;
#pragma unroll
        for (int a = 0; a < 2; ++a)
#pragma unroll
            for (int b = 0; b < 2; ++b)
#pragma unroll
                for (int m = 0; m < 4; ++m)
#pragma unroll
                    for (int n = 0; n < 2; ++n) acc[a][b][m][n] = (f32x4){0.f, 0.f, 0.f, 0.f};
        cur = nxt; cA = nA; cB = nB; ++ui;
        if (wr == 1) PG8_BAR;
    }
    PG8_WAIT_V(0);
    PG8_BAR;
#undef PG8_SA
#undef PG8_SB
#undef PG8_STAGE
#undef PG8_LDA
#undef PG8_LDB
#undef PG8_MMA
#undef PG8_WAIT_V
#undef PG8_WAIT_L
#undef PG8_BAR
#undef PG8_SCHED
}
}

constexpr int NB = 8, SEQ = 2048, D = 1024, T = NB * SEQ;
constexpr int NH = 16, HS = 64;
constexpr int FFD = 2816, FFE = 3584, NE = 8;
constexpr int QD = 1536;
constexpr int NCAT = 3328;
constexpr int MOE_ROWS = 34816;
constexpr float RMS_EPS = 1e-5f, GN_EPS = 64e-5f;
constexpr float SS_SCALE = 1048576.0f;

constexpr size_t MiB = 1u << 20;
constexpr size_t WS_CTL = 0, CTL_ZERO_BYTES = 1 * MiB;
constexpr size_t CTL_BAR = 16384;
constexpr size_t CTL_SS1 = 65536, CTL_SS2 = CTL_SS1 + 131072, CTL_SS3 = CTL_SS2 + 131072;
constexpr size_t CTL_CNT = 524288;
constexpr size_t WS_LIST = 1 * MiB;
constexpr size_t WS_LGATE = WS_LIST + 512 * 1024;
constexpr size_t WS_TOKEP = 2 * MiB;
constexpr size_t WS_SRSTD = WS_TOKEP + 128 * 1024;
constexpr size_t WS_SGATE = WS_SRSTD + 160 * 1024;
constexpr size_t WS_WCAT = 3 * MiB;
constexpr size_t WS_WLU = 16 * MiB;
constexpr size_t WS_WO = 18 * MiB;
constexpr size_t WS_W13F = 20 * MiB;
constexpr size_t WS_W2F = 31 * MiB;
constexpr size_t WS_WQKV = 37 * MiB;
constexpr size_t WS_WAO = 46 * MiB;
constexpr size_t WS_R = 47 * MiB, WS_K = 79 * MiB, WS_V = 111 * MiB, WS_LW = 143 * MiB, WS_AA = 175 * MiB, WS_GG = 207 * MiB;
constexpr size_t WS_MH = 3 * MiB;
constexpr size_t WS_MW13 = 241 * MiB;
constexpr size_t WS_HCAT = 353 * MiB;
constexpr size_t WS_Z = 353 * MiB;
constexpr size_t WS_LH = 417 * MiB;
constexpr size_t WS_X1B = 47 * MiB;
constexpr size_t WS_FH = 79 * MiB;
constexpr size_t WS_X2B = 207 * MiB;
constexpr size_t WS_Q = 47 * MiB, WS_KK = 95 * MiB, WS_VV = 143 * MiB;
constexpr size_t WS_OM = 191 * MiB;
constexpr size_t WS_X3B = 207 * MiB;
constexpr size_t WS_XG = 353 * MiB;
constexpr size_t WS_MW2 = 353 * MiB;
constexpr size_t WS_CONTRIB = 241 * MiB;
constexpr size_t WS_END = 425 * MiB;

constexpr int NWAVES = 8;
constexpr int LDS_BYTES = 163840;
constexpr int RING_OFF = 0;
constexpr int MISC_OFF = 163840 - 256;

#define GAS __attribute__((address_space(1)))
#define LAS __attribute__((address_space(3)))
typedef unsigned short bf16;
typedef float f32x4 __attribute__((ext_vector_type(4)));
typedef float f32x2 __attribute__((ext_vector_type(2)));
typedef unsigned u32x4 __attribute__((ext_vector_type(4)));
typedef unsigned u32x2 __attribute__((ext_vector_type(2)));

__device__ __forceinline__ unsigned pk2(float lo, float hi) { return pg8::cvt_pk_bf16(lo, hi); }
__device__ __forceinline__ float bf_lo(unsigned u) { return __uint_as_float(u << 16); }
__device__ __forceinline__ float bf_hi(unsigned u) { return __uint_as_float(u & 0xffff0000u); }
__device__ __forceinline__ float bf1(bf16 b) { return __uint_as_float(((unsigned)b) << 16); }
__device__ __forceinline__ float fast_rcp(float x) { return __builtin_amdgcn_rcpf(x); }
__device__ __forceinline__ float sigmoidf_(float x) { return 1.0f / (1.0f + __expf(-x)); }

#define XB_TMO      128
#define XB_XCNT(j)  (256  + 64 * (j))
#define XB_XSUB(j)  (1280 + 64 * (j))
#define XB_XGEN(j)  (2304 + 64 * (j))
#define XB_TOP      3328
#define XB_TOPGEN   3392
#define XCD_BAR_WORDS 3456
#define XB_SPIN_CAP (1u << 18)

__device__ __forceinline__ unsigned xb_ld(unsigned* p)              { return __hip_atomic_load(p, __ATOMIC_RELAXED, __HIP_MEMORY_SCOPE_AGENT); }
__device__ __forceinline__ unsigned xb_add(unsigned* p, unsigned v) { return __hip_atomic_fetch_add(p, v, __ATOMIC_RELAXED, __HIP_MEMORY_SCOPE_AGENT); }
__device__ __forceinline__ unsigned xb_xcc_id() { return (unsigned)__builtin_amdgcn_s_getreg((3 << 11) | 20) & 0xFu; }
#define XB_SPIN(cond, bar) do { unsigned _sp = 0; while (cond) { __builtin_amdgcn_s_sleep(1); \
    if ((++_sp & 255u) == 0u) { if (xb_ld(&(bar)[XB_TMO])) break; if (_sp > XB_SPIN_CAP) { atomicAdd(&(bar)[XB_TMO], 1u); break; } } } } while (0)

struct XcdBarrier { unsigned* bar; unsigned x; volatile LAS unsigned* st; };

__device__ __forceinline__ XcdBarrier xcd_barrier_post(unsigned* bar, volatile LAS unsigned* st) {
    XcdBarrier b; b.bar = bar; b.x = xb_xcc_id(); b.st = st;
    if (threadIdx.x == 0) (void)xb_add(&bar[XB_XCNT(b.x)], 1u);
    return b;
}
__device__ __forceinline__ void xcd_barrier_complete(unsigned* bar, unsigned x, unsigned& nloc, unsigned& nx) {
    const unsigned G = gridDim.x * gridDim.y * gridDim.z;
    unsigned sum, cnt, mine, sp = 0u;
    for (;;) {
        sum = 0u; cnt = 0u; mine = 0u;
#pragma unroll
        for (unsigned j = 0; j < 16; ++j) { const unsigned c = xb_ld(&bar[XB_XCNT(j)]); sum += c; cnt += (c > 0u) ? 1u : 0u; mine = (j == x) ? c : mine; }
        if (sum == G) break;
        __builtin_amdgcn_s_sleep(1);
        if ((++sp & 255u) == 0u) { if (xb_ld(&bar[XB_TMO])) break; if (sp > XB_SPIN_CAP) { atomicAdd(&bar[XB_TMO], 1u); break; } }
    }
    nloc = mine > 0u ? mine : 1u; nx = cnt > 0u ? cnt : 1u;
}
__device__ __forceinline__ void xcd_barrier(const XcdBarrier& b) {
    asm volatile("s_waitcnt vmcnt(0)" ::: "memory");
    __syncthreads();
    if (threadIdx.x == 0) {
        unsigned* bar = b.bar;
        __builtin_amdgcn_s_waitcnt(0);
        unsigned nloc = b.st[0], nx = b.st[1];
        if (nloc == 0u) { xcd_barrier_complete(bar, b.x, nloc, nx); b.st[0] = nloc; b.st[1] = nx; }
        const unsigned old = xb_add(&bar[XB_XSUB(b.x)], 1u);
        const unsigned gen = old / nloc;
        if (old + 1u == (gen + 1u) * nloc) {
            __builtin_amdgcn_fence(__ATOMIC_RELEASE, "agent");
            asm volatile("s_waitcnt vmcnt(0)" ::: "memory");
            const unsigned og = xb_add(&bar[XB_TOP], 1u);
            const unsigned tg = og / nx;
            if (og + 1u == (tg + 1u) * nx) xb_add(&bar[XB_TOPGEN], 1u);
            else XB_SPIN(xb_ld(&bar[XB_TOPGEN]) == tg, bar);
            __builtin_amdgcn_fence(__ATOMIC_ACQUIRE, "agent");
            xb_add(&bar[XB_XGEN(b.x)], 1u);
            asm volatile("s_waitcnt vmcnt(0)" ::: "memory");
        } else {
            XB_SPIN(xb_ld(&bar[XB_XGEN(b.x)]) == gen, bar);
            __builtin_amdgcn_fence(__ATOMIC_ACQUIRE, "agent");
            asm volatile("s_waitcnt vmcnt(0)" ::: "memory");
        }
    }
    __syncthreads();
}

struct Args { const float* in[33]; float* out; unsigned char* ws; int ph_lo, ph_hi; };
enum { I_X = 0, I_NG, I_MU, I_WR, I_WK, I_WV, I_W0, I_W1, I_W2, I_A0, I_A1, I_A2, I_G1, I_G2, I_KK, I_KA, I_RK, I_LNW, I_LNB, I_WO, I_KVG, I_WKV, I_WQ, I_AWO,
       I_F1, I_F3, I_F2, I_ROUTER, I_RBIAS, I_M1, I_M3, I_M2, I_FG };

struct TrJob { const float* src; int K, N; bf16* dst; int ldd, drow, dcol; const float* sc; int mode  , ileave  ; };
__device__ __forceinline__ int trjob_items(const TrJob& j) { return (j.K >> 6) * (j.N >> 6); }
__device__ __forceinline__ void tr_item(const TrJob& j, int item, LAS float* scr, int lane) {
    const int nblk = j.N >> 6, kb = item / nblk, nb = item - kb * nblk, k0 = kb << 6, n0 = nb << 6;
    const int lr = lane >> 4, n4 = (lane & 15) * 4;
#pragma unroll
    for (int half = 0; half < 2; ++half) {
        f32x4 v[8];
#pragma unroll
        for (int i = 0; i < 8; ++i) { const int kk = half * 32 + i * 4 + lr; v[i] = *(const GAS f32x4*)(j.src + (size_t)(k0 + kk) * j.N + n0 + n4); }
#pragma unroll
        for (int i = 0; i < 8; ++i) { const int kk = half * 32 + i * 4 + lr; float s = 1.0f;
            if (j.mode == 1) s = j.sc[k0 + kk]; else if (j.mode == 2) s = 1.0f - j.sc[k0 + kk];
            *(LAS f32x4*)(scr + kk * 68 + ((n4 + 4 * (kk >> 3)) & 63)) = v[i] * s; }
    }
    asm volatile("s_waitcnt lgkmcnt(0)" ::: "memory");
    const int c8 = lane & 7;
#pragma unroll
    for (int it = 0; it < 8; ++it) {
        const int n = it * 8 + (lane >> 3); const int col = (n + 4 * c8) & 63;
        const LAS float* s = scr + (8 * c8) * 68 + col;
        u32x4 o; o.x = pk2(s[0 * 68], s[1 * 68]); o.y = pk2(s[2 * 68], s[3 * 68]); o.z = pk2(s[4 * 68], s[5 * 68]); o.w = pk2(s[6 * 68], s[7 * 68]);
        const int ng = n0 + n; int row = j.drow + ng;
        if (j.ileave) row = j.drow + (ng >> 7) * 256 + (j.ileave - 1) * 128 + (ng & 127);
        *(GAS u32x4*)(j.dst + (size_t)row * j.ldd + j.dcol + k0 + 8 * c8) = o;
    }
    asm volatile("s_waitcnt lgkmcnt(0)" ::: "memory");
}

constexpr int NJ0 = 12 + 3 + 1 + 2 + 1 + 2 + 1;
__device__ __forceinline__ TrJob job0(const Args& a, int j) {
    unsigned char* ws = a.ws; TrJob t; t.ileave = 0; t.mode = 0; t.sc = nullptr; t.dcol = 0; t.drow = 0;
    if (j < 12) {
        const int w = j >> 1, hi = j & 1;
        const float* sp = w == 0 ? a.in[I_WR] : w == 1 ? a.in[I_WK] : w == 2 ? a.in[I_WV] : w == 3 ? a.in[I_W1] : w == 4 ? a.in[I_A1] : a.in[I_G1];
        const int mu = w == 0 ? 0 : w == 1 ? 2 : w == 2 ? 3 : w == 3 ? 1 : w == 4 ? 4 : 5;
        const int nn = w < 3 ? 1024 : (w == 5 ? 128 : 64);
        const int rr = w == 0 ? 0 : w == 1 ? 1024 : w == 2 ? 2048 : w == 3 ? 3072 : w == 4 ? 3136 : 3200;
        t.src = sp; t.K = 1024; t.N = nn; t.dst = (bf16*)(ws + WS_WCAT); t.ldd = 2048; t.drow = rr; t.dcol = hi * 1024; t.sc = a.in[I_MU] + mu * D; t.mode = hi ? 1 : 2;
        return t; }
    j -= 12;
    if (j < 3) {
        t.src = j == 0 ? a.in[I_W2] : (j == 1 ? a.in[I_A2] : a.in[I_G2]); t.K = j == 2 ? 128 : 64; t.N = 1024; t.dst = (bf16*)(ws + WS_WLU); t.ldd = 256; t.drow = 1024 * j; t.dcol = 64 * j; return t; }
    j -= 3;
    if (j < 1) { t.src = a.in[I_WO]; t.K = 1024; t.N = 1024; t.dst = (bf16*)(ws + WS_WO); t.ldd = 1024; return t; }
    j -= 1;
    if (j < 2) { t.src = a.in[j ? I_F3 : I_F1]; t.K = 1024; t.N = FFD; t.dst = (bf16*)(ws + WS_W13F); t.ldd = 1024; t.sc = a.in[I_NG] + 1 * D; t.mode = 1; t.ileave = 1 + j; return t; }
    j -= 2;
    if (j < 1) { t.src = a.in[I_F2]; t.K = FFD; t.N = 1024; t.dst = (bf16*)(ws + WS_W2F); t.ldd = FFD; return t; }
    j -= 1;
    if (j < 2) { if (j == 0) { t.src = a.in[I_WQ]; t.K = 1024; t.N = QD; t.dst = (bf16*)(ws + WS_WQKV); t.ldd = 1024; t.sc = a.in[I_NG] + 2 * D; t.mode = 1; }
                 else        { t.src = a.in[I_WKV]; t.K = 1024; t.N = 2 * QD; t.dst = (bf16*)(ws + WS_WQKV); t.ldd = 1024; t.drow = QD; t.sc = a.in[I_KVG]; t.mode = 1; }
                 return t; }
    t.src = a.in[I_AWO]; t.K = 512; t.N = 1024; t.dst = (bf16*)(ws + WS_WAO); t.ldd = 512; return t;
}
__device__ __forceinline__ TrJob job_m13(const Args& a, int j) {
    TrJob t; const int e = j >> 1, w = j & 1;
    t.src = a.in[w ? I_M3 : I_M1] + (size_t)e * D * FFE; t.K = 1024; t.N = FFE; t.dst = (bf16*)(a.ws + WS_MW13) + (size_t)e * 7168 * 1024; t.ldd = 1024; t.drow = 0; t.dcol = 0;
    t.sc = a.in[I_NG] + 3 * D; t.mode = 1; t.ileave = 1 + w; return t;
}
__device__ __forceinline__ TrJob job_m2(const Args& a, int e) {
    TrJob t; t.src = a.in[I_M2] + (size_t)e * FFE * D; t.K = FFE; t.N = 1024; t.dst = (bf16*)(a.ws + WS_MW2) + (size_t)e * 1024 * FFE; t.ldd = FFE; t.drow = 0; t.dcol = 0; t.sc = nullptr; t.mode = 0; t.ileave = 0; return t;
}

__device__ __forceinline__ float wave_sum(float v) {
#pragma unroll
    for (int o = 1; o < 64; o <<= 1) v += __shfl_xor(v, o);
    return v;
}
__device__ __forceinline__ float row16_sum(float v) {
    v += __builtin_bit_cast(float, __builtin_amdgcn_update_dpp(0, __builtin_bit_cast(int, v), 0xB1, 0xf, 0xf, false));
    v += __builtin_bit_cast(float, __builtin_amdgcn_update_dpp(0, __builtin_bit_cast(int, v), 0x4E, 0xf, 0xf, false));
    v += __builtin_bit_cast(float, __builtin_amdgcn_update_dpp(0, __builtin_bit_cast(int, v), 0x141, 0xf, 0xf, false));
    v += __builtin_bit_cast(float, __builtin_amdgcn_update_dpp(0, __builtin_bit_cast(int, v), 0x140, 0xf, 0xf, false));
    return v;
}

using pg8::Unit;
__device__ __forceinline__ float rstd_from_ss(const unsigned long long* ss, int row) {
    const float s = (float)ss[row] * (1.0f / SS_SCALE);
    return 1.0f / sqrtf(s * (1.0f / D) + RMS_EPS);
}
struct EpiG1 {
    bf16 *r, *lh;
    __device__ __forceinline__ void operator()(const f32x4 (&acc)[2][2][4][2], const Unit& u, int wr, int wc, int fr, int fq) const {
        const int row0 = u.pm * 256 + wr * 64 + fr, cw = wc * 32 + 8 * fq;
        if (u.pn < 12) {
            bf16* base = r + (size_t)(u.pn >> 2) * ((size_t)T * D); const int colt = (u.pn & 3) * 256 + cw;
#pragma unroll
            for (int ai = 0; ai < 2; ++ai)
#pragma unroll
                for (int m = 0; m < 4; ++m) { bf16* rowp = base + (size_t)(row0 + ai * 128 + m * 16) * D + colt;
#pragma unroll
                    for (int bj = 0; bj < 2; ++bj) { const f32x4 v0 = acc[ai][bj][m][0], v1 = acc[ai][bj][m][1];
                        u32x4 w; w.x = pk2(v0[0], v0[1]); w.y = pk2(v0[2], v0[3]); w.z = pk2(v1[0], v1[1]); w.w = pk2(v1[2], v1[3]);
                        *(GAS u32x4*)(rowp + bj * 128) = w; } }
        } else {
#pragma unroll
            for (int ai = 0; ai < 2; ++ai)
#pragma unroll
                for (int m = 0; m < 4; ++m) { bf16* rowp = lh + (size_t)(row0 + ai * 128 + m * 16) * 256 + cw;
#pragma unroll
                    for (int bj = 0; bj < 2; ++bj) { const int c = cw + bj * 128; float x[8];
#pragma unroll
                        for (int i = 0; i < 4; ++i) { x[i] = acc[ai][bj][m][0][i]; x[4 + i] = acc[ai][bj][m][1][i]; }
#pragma unroll
                        for (int i = 0; i < 8; ++i) { if (c < 64) x[i] = 1.0f - 2.0f / (1.0f + __expf(2.0f * x[i])); else if (c >= 128) x[i] = sigmoidf_(x[i]); }
                        u32x4 w; w.x = pk2(x[0], x[1]); w.y = pk2(x[2], x[3]); w.z = pk2(x[4], x[5]); w.w = pk2(x[6], x[7]);
                        *(GAS u32x4*)(rowp + bj * 128) = w; } }
        }
    }
};
struct EpiG2 {
    bf16 *lw; const float *w0, *a0;
    __device__ __forceinline__ void operator()(const f32x4 (&acc)[2][2][4][2], const Unit& u, int wr, int wc, int fr, int fq) const {
        const int row0 = u.pm * 256 + wr * 64 + fr, which = u.pn >> 2, colt = (u.pn & 3) * 256 + wc * 32 + 8 * fq;
        bf16* base = lw + (size_t)which * ((size_t)T * D);
        const float* bp = which == 0 ? w0 : a0; const float bsc = which == 2 ? 0.f : 1.f, osc = which == 0 ? -0.6065306597f : 1.0f;
#pragma unroll
        for (int bj = 0; bj < 2; ++bj) {
            const f32x4 b0 = *(const GAS f32x4*)(bp + colt + bj * 128) * bsc, b1 = *(const GAS f32x4*)(bp + colt + bj * 128 + 4) * bsc;
#pragma unroll
            for (int ai = 0; ai < 2; ++ai)
#pragma unroll
                for (int m = 0; m < 4; ++m) { bf16* rowp = base + (size_t)(row0 + ai * 128 + m * 16) * D + colt; float x[8];
#pragma unroll
                    for (int i = 0; i < 4; ++i) { x[i] = acc[ai][bj][m][0][i] + b0[i]; x[4 + i] = acc[ai][bj][m][1][i] + b1[i]; }
                    if (which != 2) {
#pragma unroll
                        for (int i = 0; i < 8; ++i) x[i] = osc * sigmoidf_(x[i]);
                    }
                    u32x4 w; w.x = pk2(x[0], x[1]); w.y = pk2(x[2], x[3]); w.z = pk2(x[4], x[5]); w.w = pk2(x[6], x[7]);
                    *(GAS u32x4*)(rowp + bj * 128) = w;
                    asm volatile("" ::: "memory"); }
        }
    }
};
struct EpiRes {
    const float* resid; float* out; bf16* xb; unsigned long long* ss;
    __device__ __forceinline__ void operator()(const f32x4 (&acc)[2][2][4][2], const Unit& u, int wr, int wc, int fr, int fq) const {
        const int row0 = u.pm * 256 + wr * 64 + fr, col0 = u.pn * 256 + wc * 32 + 8 * fq;
#pragma unroll
        for (int ai = 0; ai < 2; ++ai)
#pragma unroll
            for (int m = 0; m < 4; ++m) { const int row = row0 + ai * 128 + m * 16; const size_t off = (size_t)row * D + col0; float sq = 0.f;
#pragma unroll
                for (int bj = 0; bj < 2; ++bj) {
                    const f32x4 r0 = *(const GAS f32x4*)(resid + off + bj * 128), r1 = *(const GAS f32x4*)(resid + off + bj * 128 + 4);
                    const f32x4 o0 = r0 + acc[ai][bj][m][0], o1 = r1 + acc[ai][bj][m][1];
                    *(GAS f32x4*)(out + off + bj * 128) = o0; *(GAS f32x4*)(out + off + bj * 128 + 4) = o1;
                    u32x4 w; w.x = pk2(o0[0], o0[1]); w.y = pk2(o0[2], o0[3]); w.z = pk2(o1[0], o1[1]); w.w = pk2(o1[2], o1[3]);
                    *(GAS u32x4*)(xb + off + bj * 128) = w;
                    sq += (o0[0] * o0[0] + o0[1] * o0[1]) + (o0[2] * o0[2] + o0[3] * o0[3]) + (o1[0] * o1[0] + o1[1] * o1[1]) + (o1[2] * o1[2] + o1[3] * o1[3]); }
                sq += __shfl_xor(sq, 16); sq += __shfl_xor(sq, 32);
                if (fq == 0) atomicAdd(ss + row, (unsigned long long)(sq * SS_SCALE + 0.5f)); }
    }
};
struct EpiSwiglu {
    bf16* hid; int ldc; const unsigned long long* ss; const float* srstd;
    __device__ __forceinline__ void operator()(const f32x4 (&acc)[2][2][4][2], const Unit& u, int wr, int wc, int fr, int fq) const {
        const int row0 = u.pm * 256 + wr * 64 + fr, col0 = u.pn * 128 + wc * 32 + 8 * fq;
#pragma unroll
        for (int ai = 0; ai < 2; ++ai)
#pragma unroll
            for (int m = 0; m < 4; ++m) { const int row = row0 + ai * 128 + m * 16; const float rs = ss ? rstd_from_ss(ss, row) : srstd[row]; float x[8];
#pragma unroll
                for (int n = 0; n < 2; ++n)
#pragma unroll
                    for (int i = 0; i < 4; ++i) { const float a = acc[ai][0][m][n][i] * rs, b = acc[ai][1][m][n][i] * rs; x[n * 4 + i] = a * b / (1.0f + __expf(-a)); }
                u32x4 w; w.x = pk2(x[0], x[1]); w.y = pk2(x[2], x[3]); w.z = pk2(x[4], x[5]); w.w = pk2(x[6], x[7]);
                *(GAS u32x4*)(hid + (size_t)row * ldc + col0) = w; }
    }
};
struct EpiQKV {
    bf16 *q; const unsigned long long* ss;
    __device__ __forceinline__ void operator()(const f32x4 (&acc)[2][2][4][2], const Unit& u, int wr, int wc, int fr, int fq) const {
        const int row0 = u.pm * 256 + wr * 64 + fr, which = u.pn / 6, colt = (u.pn - which * 6) * 256 + wc * 32 + 8 * fq;
        bf16* base = q + (size_t)which * ((size_t)T * QD);
#pragma unroll
        for (int ai = 0; ai < 2; ++ai)
#pragma unroll
            for (int m = 0; m < 4; ++m) { const int row = row0 + ai * 128 + m * 16; const float rs = rstd_from_ss(ss, row); bf16* rowp = base + (size_t)row * QD + colt;
#pragma unroll
                for (int bj = 0; bj < 2; ++bj) { const f32x4 v0 = acc[ai][bj][m][0] * rs, v1 = acc[ai][bj][m][1] * rs;
                    u32x4 w; w.x = pk2(v0[0], v0[1]); w.y = pk2(v0[2], v0[3]); w.z = pk2(v1[0], v1[1]); w.w = pk2(v1[2], v1[3]);
                    *(GAS u32x4*)(rowp + bj * 128) = w; } }
    }
};
struct EpiGate {
    bf16* c; const float* gate;
    __device__ __forceinline__ void operator()(const f32x4 (&acc)[2][2][4][2], const Unit& u, int wr, int wc, int fr, int fq) const {
        const int row0 = u.pm * 256 + wr * 64 + fr, col0 = u.pn * 256 + wc * 32 + 8 * fq;
#pragma unroll
        for (int ai = 0; ai < 2; ++ai)
#pragma unroll
            for (int m = 0; m < 4; ++m) { const int row = row0 + ai * 128 + m * 16; const float gs = gate[row]; bf16* rowp = c + (size_t)row * D + col0;
#pragma unroll
                for (int bj = 0; bj < 2; ++bj) { const f32x4 v0 = acc[ai][bj][m][0] * gs, v1 = acc[ai][bj][m][1] * gs;
                    u32x4 w; w.x = pk2(v0[0], v0[1]); w.y = pk2(v0[2], v0[3]); w.z = pk2(v1[0], v1[1]); w.w = pk2(v1[2], v1[3]);
                    *(GAS u32x4*)(rowp + bj * 128) = w; } }
    }
};

struct Frame { LAS unsigned char* lds; int tid, lane, wave, G, bid; };

__device__ __forceinline__ void run_jobs(const Args& a, Frame& F, int kind  , int njobs, int gw, int NGW) {
    LAS float* scr = (LAS float*)(F.lds) + F.wave * (64 * 68);
    int base = 0;
    for (int j = 0; j < njobs; ++j) {
        const TrJob t = kind == 0 ? job0(a, j) : (kind == 1 ? job_m13(a, j) : job_m2(a, j));
        const int ni = trjob_items(t);
        int first = (gw - (base % NGW) + NGW) % NGW;
        for (int it = first; it < ni; it += NGW) tr_item(t, it, scr, F.lane);
        base += ni;
    }
}
__device__ __forceinline__ void p0_hcat(const Args& a, Frame& F) {
    const float* x = a.in[I_X]; const float* g = a.in[I_NG];
    bf16* hc = (bf16*)(a.ws + WS_HCAT);
    const int gw = F.bid * NWAVES + F.wave, NGW = F.G * NWAVES;
    f32x4 gv[4];
#pragma unroll
    for (int j = 0; j < 4; ++j) gv[j] = *(const GAS f32x4*)(g + 4 * F.lane + 256 * j);
    for (int m = gw; m < T; m += NGW) {
        const GAS f32x4* xr = (const GAS f32x4*)(x + (size_t)m * D) + F.lane;
        f32x4 v[4]; float s = 0.f;
#pragma unroll
        for (int j = 0; j < 4; ++j) { v[j] = xr[64 * j]; s += (v[j].x * v[j].x + v[j].y * v[j].y) + (v[j].z * v[j].z + v[j].w * v[j].w); }
        const float rstd = 1.f / sqrtf(wave_sum(s) * (1.f / D) + RMS_EPS);
        const bool has_next = ((m + 1) & (SEQ - 1)) != 0, first = (m & (SEQ - 1)) == 0;
#pragma unroll
        for (int j = 0; j < 4; ++j) { const f32x4 h = v[j] * rstd * gv[j]; u32x2 w; w.x = pk2(h.x, h.y); w.y = pk2(h.z, h.w);
            *(GAS u32x2*)(hc + (size_t)m * 2048 + 4 * F.lane + 256 * j) = w;
            if (has_next) *(GAS u32x2*)(hc + (size_t)(m + 1) * 2048 + 1024 + 4 * F.lane + 256 * j) = w;
            if (first) *(GAS u32x2*)(hc + (size_t)m * 2048 + 1024 + 4 * F.lane + 256 * j) = (u32x2){0u, 0u}; }
    }
}

constexpr int SC_TOK = 32;
__device__ __forceinline__ void p3_scan(const Args& a, Frame& F, int pair) {
    unsigned char* ws = a.ws;
    const bf16 *R = (const bf16*)(ws + WS_R), *K = (const bf16*)(ws + WS_K), *V = (const bf16*)(ws + WS_V), *LW = (const bf16*)(ws + WS_LW), *AA = (const bf16*)(ws + WS_AA), *GG = (const bf16*)(ws + WS_GG);
    bf16* Z = (bf16*)(ws + WS_Z);
    const int b = pair >> 4, h = pair & 15;
    LAS float* buf = (LAS float*)F.lds;
    LAS float* ybuf = buf + 2 * SC_TOK * 6 * 64;
    LAS float* scb = ybuf + SC_TOK * 64;
    const int tok = F.tid >> 4, j = F.tid & 15, ch = h * 64 + 4 * j;
    const f32x4 kkp = *(const GAS f32x4*)(a.in[I_KK] + ch), kap = *(const GAS f32x4*)(a.in[I_KA] + ch), rkp = *(const GAS f32x4*)(a.in[I_RK] + ch),
                lnw = *(const GAS f32x4*)(a.in[I_LNW] + ch), lnb = *(const GAS f32x4*)(a.in[I_LNB] + ch);
    const int rg = F.lane >> 4, c = F.lane & 15, rowA = 8 * F.wave + 2 * rg;
    f32x4 S0 = (f32x4){0.f, 0.f, 0.f, 0.f}, S1 = S0;
    const size_t tbase = (size_t)b * SEQ;
    u32x2 raw[6];
    { const size_t off = (tbase + tok) * D + ch;
      raw[0] = *(const GAS u32x2*)(R + off); raw[1] = *(const GAS u32x2*)(K + off); raw[2] = *(const GAS u32x2*)(V + off);
      raw[3] = *(const GAS u32x2*)(LW + off); raw[4] = *(const GAS u32x2*)(AA + off); raw[5] = *(const GAS u32x2*)(GG + off); }
    for (int cnk = 0; cnk < SEQ / SC_TOK; ++cnk) {
        LAS float* cb = buf + (cnk & 1) * (SC_TOK * 6 * 64);
        const f32x4 r4 = (f32x4){bf_lo(raw[0].x), bf_hi(raw[0].x), bf_lo(raw[0].y), bf_hi(raw[0].y)};
        const f32x4 k4 = (f32x4){bf_lo(raw[1].x), bf_hi(raw[1].x), bf_lo(raw[1].y), bf_hi(raw[1].y)};
        const f32x4 v4 = (f32x4){bf_lo(raw[2].x), bf_hi(raw[2].x), bf_lo(raw[2].y), bf_hi(raw[2].y)};
        const f32x4 l4 = (f32x4){bf_lo(raw[3].x), bf_hi(raw[3].x), bf_lo(raw[3].y), bf_hi(raw[3].y)};
        const f32x4 a4 = (f32x4){bf_lo(raw[4].x), bf_hi(raw[4].x), bf_lo(raw[4].y), bf_hi(raw[4].y)};
        const f32x4 g4 = (f32x4){bf_lo(raw[5].x), bf_hi(raw[5].x), bf_lo(raw[5].y), bf_hi(raw[5].y)};
        {
            f32x4 w4; w4.x = __expf(l4.x); w4.y = __expf(l4.y); w4.z = __expf(l4.z); w4.w = __expf(l4.w);
            const f32x4 kr = k4 * kkp;
            const float ssq = row16_sum((kr.x * kr.x + kr.y * kr.y) + (kr.z * kr.z + kr.w * kr.w));
            const float inv = 1.0f / fmaxf(sqrtf(ssq), 1e-12f);
            const f32x4 kk = kr * inv;
            const f32x4 kp = k4 * (1.0f + (a4 - 1.0f) * kap);
            const f32x4 rkk = r4 * kp * rkp;
            const float rk = row16_sum((rkk.x + rkk.y) + (rkk.z + rkk.w));
            LAS float* tb = cb + tok * (6 * 64) + 4 * j;
            *(LAS f32x4*)(tb + 0 * 64) = -kk; *(LAS f32x4*)(tb + 1 * 64) = kk * a4; *(LAS f32x4*)(tb + 2 * 64) = w4;
            *(LAS f32x4*)(tb + 3 * 64) = kp; *(LAS f32x4*)(tb + 4 * 64) = r4; *(LAS f32x4*)(tb + 5 * 64) = v4;
            if (j == 0) scb[(cnk & 1) * SC_TOK + tok] = rk;
        }
        if (cnk + 1 < SEQ / SC_TOK) { const size_t off = (tbase + (size_t)(cnk + 1) * SC_TOK + tok) * D + ch;
            raw[0] = *(const GAS u32x2*)(R + off); raw[1] = *(const GAS u32x2*)(K + off); raw[2] = *(const GAS u32x2*)(V + off);
            raw[3] = *(const GAS u32x2*)(LW + off); raw[4] = *(const GAS u32x2*)(AA + off); raw[5] = *(const GAS u32x2*)(GG + off); }
        __syncthreads();
#pragma unroll 4
        for (int t = 0; t < SC_TOK; ++t) {
            const LAS float* tb = cb + t * (6 * 64) + 4 * c;
            const f32x4 A4 = *(const LAS f32x4*)(tb), B4 = *(const LAS f32x4*)(tb + 64), W4 = *(const LAS f32x4*)(tb + 128), K4 = *(const LAS f32x4*)(tb + 192), R4 = *(const LAS f32x4*)(tb + 256);
            const f32x2 vv = *(const LAS f32x2*)(cb + t * (6 * 64) + 5 * 64 + rowA);
            float sa0 = (S0.x * A4.x + S0.y * A4.y) + (S0.z * A4.z + S0.w * A4.w);
            float sa1 = (S1.x * A4.x + S1.y * A4.y) + (S1.z * A4.z + S1.w * A4.w);
            sa0 = row16_sum(sa0); sa1 = row16_sum(sa1);
            S0 = S0 * W4 + sa0 * B4 + vv.x * K4;
            S1 = S1 * W4 + sa1 * B4 + vv.y * K4;
            float y0 = (S0.x * R4.x + S0.y * R4.y) + (S0.z * R4.z + S0.w * R4.w);
            float y1 = (S1.x * R4.x + S1.y * R4.y) + (S1.z * R4.z + S1.w * R4.w);
            y0 = row16_sum(y0); y1 = row16_sum(y1);
            if (c == 0) *(LAS f32x2*)(ybuf + t * 64 + rowA) = (f32x2){y0, y1};
        }
        __syncthreads();
        {
            const f32x4 y4 = *(const LAS f32x4*)(ybuf + tok * 64 + 4 * j);
            const float mean = row16_sum((y4.x + y4.y) + (y4.z + y4.w)) * (1.0f / 64.0f);
            const f32x4 d4 = y4 - mean;
            const float var = row16_sum((d4.x * d4.x + d4.y * d4.y) + (d4.z * d4.z + d4.w * d4.w)) * (1.0f / 64.0f);
            const float rs = 1.0f / sqrtf(var + GN_EPS);
            const f32x4 vt = *(const LAS f32x4*)(cb + tok * (6 * 64) + 5 * 64 + 4 * j);
            const float rk = scb[(cnk & 1) * SC_TOK + tok];
            const f32x4 o = (d4 * rs * lnw + lnb + rk * vt) * g4;
            u32x2 w; w.x = pk2(o.x, o.y); w.y = pk2(o.z, o.w);
            *(GAS u32x2*)(Z + (tbase + (size_t)cnk * SC_TOK + tok) * D + ch) = w;
        }
    }
}

__device__ __forceinline__ void p8_attn(const Args& a, Frame& F) {
    unsigned char* ws = a.ws;
    const bf16 *Q = (const bf16*)(ws + WS_Q), *KK = (const bf16*)(ws + WS_KK), *VV = (const bf16*)(ws + WS_VV); bf16* OM = (bf16*)(ws + WS_OM);
    LAS float* pl = (LAS float*)F.lds + F.wave * 512;
    const int gw = F.bid * NWAVES + F.wave, NGW = F.G * NWAVES, lane = F.lane;
    for (int item = gw; item < T * 8; item += NGW) {
        const int tg = item >> 3, hs = item & 7, bb = tg >> 11, t = tg & (SEQ - 1);
        float sc[3][3]; float mx = -1e30f;
#pragma unroll
        for (int g = 0; g < 3; ++g) {
            const int dil = g == 0 ? 1 : (g == 1 ? 4 : 16);
            const float slope = exp2f(-8.0f * (float)(g * 8 + hs + 1) / 24.0f);
            const bf16* qp = Q + (size_t)tg * QD + g * 512 + hs * 64;
            float q[64];
#pragma unroll
            for (int i = 0; i < 8; ++i) { const u32x4 w = *(const GAS u32x4*)(qp + 8 * i); q[8 * i] = bf_lo(w.x); q[8 * i + 1] = bf_hi(w.x); q[8 * i + 2] = bf_lo(w.y); q[8 * i + 3] = bf_hi(w.y);
                q[8 * i + 4] = bf_lo(w.z); q[8 * i + 5] = bf_hi(w.z); q[8 * i + 6] = bf_lo(w.w); q[8 * i + 7] = bf_hi(w.w); }
#pragma unroll
            for (int kk = 0; kk < 3; ++kk) {
                const int jn = lane + 64 * kk; const int pos = t - jn * dil; float s = -1e30f;
                if (jn <= 128 && pos >= 0) {
                    const bf16* kp = KK + ((size_t)bb * SEQ + pos) * QD + g * 512 + hs * 64; float dacc = 0.f;
#pragma unroll
                    for (int i = 0; i < 8; ++i) { const u32x4 w = *(const GAS u32x4*)(kp + 8 * i);
                        dacc += q[8 * i] * bf_lo(w.x) + q[8 * i + 1] * bf_hi(w.x) + q[8 * i + 2] * bf_lo(w.y) + q[8 * i + 3] * bf_hi(w.y)
                              + q[8 * i + 4] * bf_lo(w.z) + q[8 * i + 5] * bf_hi(w.z) + q[8 * i + 6] * bf_lo(w.w) + q[8 * i + 7] * bf_hi(w.w); }
                    s = dacc * 0.125f - slope * (float)(jn * dil);
                }
                sc[g][kk] = s; mx = fmaxf(mx, s);
            }
        }
#pragma unroll
        for (int o = 1; o < 64; o <<= 1) mx = fmaxf(mx, __shfl_xor(mx, o));
        float l = 0.f;
#pragma unroll
        for (int g = 0; g < 3; ++g)
#pragma unroll
            for (int kk = 0; kk < 3; ++kk) { const float p = sc[g][kk] > -1e29f ? __expf(sc[g][kk] - mx) : 0.f; l += p; const int jn = lane + 64 * kk; if (jn <= 128) pl[g * 132 + jn] = p; }
        l = wave_sum(l);
        asm volatile("s_waitcnt lgkmcnt(0)" ::: "memory");
        float o = 0.f;
#pragma unroll
        for (int g = 0; g < 3; ++g) {
            const int dil = g == 0 ? 1 : (g == 1 ? 4 : 16);
            int nk = t / dil + 1; if (nk > 129) nk = 129;
            const bf16* vp = VV + ((size_t)bb * SEQ + t) * QD + g * 512 + hs * 64 + lane;
            for (int jn = 0; jn < nk; ++jn) o += pl[g * 132 + jn] * bf1(vp[-(ptrdiff_t)jn * dil * QD]);
        }
        o = o / l;
        const float o2 = __shfl_down(o, 1);
        if ((lane & 1) == 0) *(GAS unsigned*)(OM + (size_t)tg * 512 + hs * 64 + lane) = pk2(o, o2);
        asm volatile("s_waitcnt lgkmcnt(0)" ::: "memory");
    }
}

__device__ __forceinline__ void p10_router(const Args& a, Frame& F) {
    unsigned char* ws = a.ws;
    const float* x3 = a.out; const unsigned long long* ss3 = (const unsigned long long*)(ws + CTL_SS3);
    unsigned* gcnt = (unsigned*)(ws + CTL_CNT); int* list = (int*)(ws + WS_LIST); float* lgate = (float*)(ws + WS_LGATE); int* tokep = (int*)(ws + WS_TOKEP);
    LAS float* rw = (LAS float*)F.lds;
    LAS int* lcnt = (LAS int*)(rw + 8192);
    LAS int* lbase = lcnt + 8;
    LAS int* te = lbase + 8;
    LAS int* tp = te + 128;
    LAS float* tgt = (LAS float*)(tp + 128);
    const float* g = a.in[I_NG] + 3 * D; const float* rt = a.in[I_ROUTER]; const float* rb = a.in[I_RBIAS];
    for (int i = F.tid; i < 8192; i += 512) rw[i] = rt[i] * g[i >> 3];
    for (int cb = F.bid; cb < T / 64; cb += F.G) {
        if (F.tid < 8) lcnt[F.tid] = 0;
        __syncthreads();
        for (int tt = 0; tt < 8; ++tt) {
            const int tl = F.wave * 8 + tt, tok = cb * 64 + tl;
            float acc[8];
#pragma unroll
            for (int e = 0; e < 8; ++e) acc[e] = 0.f;
#pragma unroll
            for (int jq = 0; jq < 4; ++jq) { const f32x4 xv = *(const GAS f32x4*)(x3 + (size_t)tok * D + 4 * F.lane + 256 * jq);
#pragma unroll
                for (int i = 0; i < 4; ++i) { const int k = 4 * F.lane + 256 * jq + i; const f32x4 w0 = *(const LAS f32x4*)(rw + k * 8), w1 = *(const LAS f32x4*)(rw + k * 8 + 4);
                    acc[0] += xv[i] * w0.x; acc[1] += xv[i] * w0.y; acc[2] += xv[i] * w0.z; acc[3] += xv[i] * w0.w; acc[4] += xv[i] * w1.x; acc[5] += xv[i] * w1.y; acc[6] += xv[i] * w1.z; acc[7] += xv[i] * w1.w; } }
#pragma unroll
            for (int e = 0; e < 8; ++e) acc[e] = wave_sum(acc[e]);
            if (F.lane == 0) {
                const float rs = rstd_from_ss(ss3, tok);
                float lg[8];
#pragma unroll
                for (int e = 0; e < 8; ++e) lg[e] = acc[e] * rs + rb[e];
                int e0 = 0; float v0 = lg[0];
#pragma unroll
                for (int e = 1; e < 8; ++e) if (lg[e] > v0) { v0 = lg[e]; e0 = e; }
                int e1 = -1; float v1 = -3.0e38f;
#pragma unroll
                for (int e = 0; e < 8; ++e) if (e != e0 && lg[e] > v1) { v1 = lg[e]; e1 = e; }
                const float p1 = __expf(v1 - v0), g0 = 1.0f / (1.0f + p1), g1 = p1 * g0;
                te[tl * 2] = e0; te[tl * 2 + 1] = e1; tgt[tl * 2] = g0; tgt[tl * 2 + 1] = g1;
                tp[tl * 2] = __hip_atomic_fetch_add(&lcnt[e0], 1, __ATOMIC_RELAXED, __HIP_MEMORY_SCOPE_WORKGROUP); tp[tl * 2 + 1] = __hip_atomic_fetch_add(&lcnt[e1], 1, __ATOMIC_RELAXED, __HIP_MEMORY_SCOPE_WORKGROUP);
            }
        }
        __syncthreads();
        if (F.tid < 8) lbase[F.tid] = (int)__hip_atomic_fetch_add(gcnt + F.tid, (unsigned)lcnt[F.tid], __ATOMIC_RELAXED, __HIP_MEMORY_SCOPE_AGENT);
        __syncthreads();
        if (F.tid < 128) { const int tl = F.tid >> 1, s = F.tid & 1, e = te[tl * 2 + s], pos = lbase[e] + tp[tl * 2 + s];
            list[e * T + pos] = cb * 64 + tl; lgate[e * T + pos] = tgt[tl * 2 + s]; tokep[(cb * 64 + tl) * 2 + s] = (e << 16) | pos; }
        __syncthreads();
    }
}
__device__ __forceinline__ void p11_gather(const Args& a, Frame& F) {
    unsigned char* ws = a.ws;
    const unsigned* gcnt = (const unsigned*)(ws + CTL_CNT); const int* list = (const int*)(ws + WS_LIST); const float* lgate = (const float*)(ws + WS_LGATE);
    const bf16* x3b = (const bf16*)(ws + WS_X3B); bf16* xg = (bf16*)(ws + WS_XG); float* srstd = (float*)(ws + WS_SRSTD); float* sgate = (float*)(ws + WS_SGATE);
    const unsigned long long* ss3 = (const unsigned long long*)(ws + CTL_SS3);
    int cnt[8], up[9], pp[8]; { int s = 0, p = 0;
_Pragma("unroll")
        for (int e = 0; e < 8; ++e) { cnt[e] = (int)gcnt[e]; up[e] = s; pp[e] = p; s += cnt[e]; p += ((cnt[e] + 255) >> 8) << 8; } up[8] = s; }
    const int gw = F.bid * NWAVES + F.wave, NGW = F.G * NWAVES, total = up[8];
    for (int i = gw; i < total; i += NGW) {
        int e = 0;
#pragma unroll
        for (int k = 1; k < 8; ++k) e += (i >= up[k]) ? 1 : 0;
        int pos = i, pbase = 0;
#pragma unroll
        for (int k = 0; k < 8; ++k) if (k == e) { pos = i - up[k]; pbase = pp[k]; }
        const int tok = list[e * T + pos], slot = pbase + pos;
        const GAS u32x4* src = (const GAS u32x4*)(x3b + (size_t)tok * D); GAS u32x4* dst = (GAS u32x4*)(xg + (size_t)slot * D);
        dst[F.lane] = src[F.lane]; dst[F.lane + 64] = src[F.lane + 64];
        if (F.lane == 0) { srstd[slot] = rstd_from_ss(ss3, tok); sgate[slot] = lgate[e * T + pos]; }
    }
}
__device__ __forceinline__ void p15_final(const Args& a, Frame& F) {
    unsigned char* ws = a.ws;
    const unsigned* gcnt = (const unsigned*)(ws + CTL_CNT); const int* tokep = (const int*)(ws + WS_TOKEP); const bf16* cb = (const bf16*)(ws + WS_CONTRIB);
    const float* fg = a.in[I_FG]; float* out = a.out;
    int pp[8]; { int p = 0;
_Pragma("unroll")
        for (int e = 0; e < 8; ++e) { pp[e] = p; p += (((int)gcnt[e] + 255) >> 8) << 8; } }
    const int gw = F.bid * NWAVES + F.wave, NGW = F.G * NWAVES;
    f32x4 gv[4];
#pragma unroll
    for (int j = 0; j < 4; ++j) gv[j] = *(const GAS f32x4*)(fg + 4 * F.lane + 256 * j);
    for (int m = gw; m < T; m += NGW) {
        const int ep0 = tokep[m * 2], ep1 = tokep[m * 2 + 1];
        int s0 = ep0 & 0xffff, s1 = ep1 & 0xffff;
#pragma unroll
        for (int k = 0; k < 8; ++k) { if ((ep0 >> 16) == k) s0 += pp[k]; if ((ep1 >> 16) == k) s1 += pp[k]; }
        GAS f32x4* xr = (GAS f32x4*)(out + (size_t)m * D) + F.lane;
        const GAS u32x2* c0 = (const GAS u32x2*)(cb + (size_t)s0 * D) + F.lane; const GAS u32x2* c1 = (const GAS u32x2*)(cb + (size_t)s1 * D) + F.lane;
        f32x4 v[4]; float s = 0.f;
#pragma unroll
        for (int j = 0; j < 4; ++j) { v[j] = xr[64 * j]; const u32x2 p = c0[64 * j], q = c1[64 * j];
            v[j].x += bf_lo(p.x) + bf_lo(q.x); v[j].y += bf_hi(p.x) + bf_hi(q.x); v[j].z += bf_lo(p.y) + bf_lo(q.y); v[j].w += bf_hi(p.y) + bf_hi(q.y);
            s += (v[j].x * v[j].x + v[j].y * v[j].y) + (v[j].z * v[j].z + v[j].w * v[j].w); }
        const float rstd = 1.f / sqrtf(wave_sum(s) * (1.f / D) + RMS_EPS);
#pragma unroll
        for (int j = 0; j < 4; ++j) xr[64 * j] = v[j] * rstd * gv[j];
    }
}

constexpr int NPHASE = 16;
__global__ void __launch_bounds__(NWAVES * 64, 2) fwd(Args args) {
    extern __shared__ __attribute__((aligned(16))) unsigned char lds[];
    Frame F; F.lds = (LAS unsigned char*)lds; F.tid = threadIdx.x; F.lane = F.tid & 63; F.wave = __builtin_amdgcn_readfirstlane(F.tid >> 6); F.G = gridDim.x; F.bid = blockIdx.x;
    volatile LAS unsigned* MISC = (volatile LAS unsigned*)(F.lds + MISC_OFF);
    unsigned char* ws = args.ws;
    if (F.tid < 64) MISC[F.tid] = 0u;
    __syncthreads();
    const int lo = args.ph_lo, hi = args.ph_hi;
    XcdBarrier bar; bar.bar = (unsigned*)(ws + CTL_BAR); bar.x = 0; bar.st = nullptr;
    if (hi - lo > 1) bar = xcd_barrier_post((unsigned*)(ws + CTL_BAR), MISC + 8);
#ifdef ONLY_PHASE
#define IN(k) ((k) == ONLY_PHASE && lo <= (k) && (k) < hi)
#else
#define IN(k) (lo <= (k) && (k) < hi)
#endif
#define SEAM(k) do { if (IN(k) && IN((k) + 1)) xcd_barrier(bar); } while (0)
    LAS unsigned char* ring = F.lds + RING_OFF;
    unsigned long long* ss1 = (unsigned long long*)(ws + CTL_SS1); unsigned long long* ss2 = (unsigned long long*)(ws + CTL_SS2); unsigned long long* ss3 = (unsigned long long*)(ws + CTL_SS3);

    if (IN(0)) { run_jobs(args, F, 0, NJ0, F.bid * NWAVES + F.wave, F.G * NWAVES); p0_hcat(args, F); }
    SEAM(0);
    if (IN(1)) {
        pg8::Gemm g{(const bf16*)(ws + WS_HCAT), (const bf16*)(ws + WS_WCAT), 2048, 2048, 0}; pg8::StaticOrder S; S.init(T / 256, NCAT / 256, F.G, F.bid);
        EpiG1 E{(bf16*)(ws + WS_R), (bf16*)(ws + WS_LH)};
        pg8::gemm_phase<EpiG1, pg8::StaticOrder>(ring, g, S, E); }
    SEAM(1);
    if (IN(2)) {
        pg8::Gemm g{(const bf16*)(ws + WS_LH), (const bf16*)(ws + WS_WLU), 256, 256, 0}; pg8::StaticOrder S; S.init(T / 256, 3072 / 256, F.G, F.bid);
        EpiG2 E{(bf16*)(ws + WS_LW), args.in[I_W0], args.in[I_A0]};
        pg8::gemm_phase<EpiG2, pg8::StaticOrder>(ring, g, S, E); }
    SEAM(2);
    if (IN(3)) {
        const int nscan = F.G > 128 ? 128 : F.G, nconv = F.G - nscan;
        if (F.bid < nscan) { for (int pair = F.bid; pair < 128; pair += nscan) { p3_scan(args, F, pair); __syncthreads(); } }
        else run_jobs(args, F, 1, 16, (F.bid - nscan) * NWAVES + F.wave, nconv * NWAVES);
        if (nconv == 0) { __syncthreads(); run_jobs(args, F, 1, 16, F.bid * NWAVES + F.wave, F.G * NWAVES); }
    }
    SEAM(3);
    if (IN(4)) {
        pg8::Gemm g{(const bf16*)(ws + WS_Z), (const bf16*)(ws + WS_WO), 1024, 1024, 0}; pg8::StaticOrder S; S.init(T / 256, 4, F.G, F.bid);
        EpiRes E{args.in[I_X], args.out, (bf16*)(ws + WS_X1B), ss1};
        pg8::gemm_phase<EpiRes, pg8::StaticOrder>(ring, g, S, E); }
    SEAM(4);
    if (IN(5)) {
        pg8::Gemm g{(const bf16*)(ws + WS_X1B), (const bf16*)(ws + WS_W13F), 1024, 1024, 0}; pg8::StaticOrder S; S.init(T / 256, 2 * FFD / 256, F.G, F.bid);
        EpiSwiglu E{(bf16*)(ws + WS_FH), FFD, ss1, nullptr};
        pg8::gemm_phase<EpiSwiglu, pg8::StaticOrder>(ring, g, S, E); }
    SEAM(5);
    if (IN(6)) {
        pg8::Gemm g{(const bf16*)(ws + WS_FH), (const bf16*)(ws + WS_W2F), FFD, FFD, 0}; pg8::StaticOrder S; S.init(T / 256, 4, F.G, F.bid);
        EpiRes E{args.out, args.out, (bf16*)(ws + WS_X2B), ss2};
        pg8::gemm_phase<EpiRes, pg8::StaticOrder>(ring, g, S, E); }
    SEAM(6);
    if (IN(7)) {
        pg8::Gemm g{(const bf16*)(ws + WS_X2B), (const bf16*)(ws + WS_WQKV), 1024, 1024, 0}; pg8::StaticOrder S; S.init(T / 256, 18, F.G, F.bid);
        EpiQKV E{(bf16*)(ws + WS_Q), ss2};
        pg8::gemm_phase<EpiQKV, pg8::StaticOrder>(ring, g, S, E); }
    SEAM(7);
    if (IN(8)) p8_attn(args, F);
    SEAM(8);
    if (IN(9)) {
        pg8::Gemm g{(const bf16*)(ws + WS_OM), (const bf16*)(ws + WS_WAO), 512, 512, 0}; pg8::StaticOrder S; S.init(T / 256, 4, F.G, F.bid);
        EpiRes E{args.out, args.out, (bf16*)(ws + WS_X3B), ss3};
        pg8::gemm_phase<EpiRes, pg8::StaticOrder>(ring, g, S, E); }
    SEAM(9);
    if (IN(10)) p10_router(args, F);
    SEAM(10);
    if (IN(11)) p11_gather(args, F);
    SEAM(11);
    if (IN(12)) {
        int cnt[8];
_Pragma("unroll")
        for (int e = 0; e < 8; ++e) cnt[e] = (int)((const unsigned*)(ws + CTL_CNT))[e];
        pg8::Gemm g{(const bf16*)(ws + WS_XG), (const bf16*)(ws + WS_MW13), 1024, 1024, (size_t)7168 * 1024}; pg8::MoeOrder S; S.init(cnt, 28, F.G, F.bid);
        EpiSwiglu E{(bf16*)(ws + WS_MH), FFE, nullptr, (const float*)(ws + WS_SRSTD)};
        pg8::gemm_phase<EpiSwiglu, pg8::MoeOrder>(ring, g, S, E); }
    SEAM(12);
    if (IN(13)) run_jobs(args, F, 2, 8, F.bid * NWAVES + F.wave, F.G * NWAVES);
    SEAM(13);
    if (IN(14)) {
        int cnt[8];
_Pragma("unroll")
        for (int e = 0; e < 8; ++e) cnt[e] = (int)((const unsigned*)(ws + CTL_CNT))[e];
        pg8::Gemm g{(const bf16*)(ws + WS_MH), (const bf16*)(ws + WS_MW2), FFE, FFE, (size_t)1024 * FFE}; pg8::MoeOrder S; S.init(cnt, 4, F.G, F.bid);
        EpiGate E{(bf16*)(ws + WS_CONTRIB), (const float*)(ws + WS_SGATE)};
        pg8::gemm_phase<EpiGate, pg8::MoeOrder>(ring, g, S, E); }
    SEAM(14);
    if (IN(15)) p15_final(args, F);
#undef IN
#undef SEAM
}

extern "C" void kernel_launch(void* const* d_in, const int* in_sizes, int n_in, void* d_out, int out_size, void* d_ws, size_t ws_size, hipStream_t stream) {
    static int grid = 0;
    if (grid == 0) {
        if (n_in != 33 || in_sizes[0] != T * D || out_size != T * D || ws_size < WS_END) { fprintf(stderr, "kernel_launch: unexpected shapes: n_in %d in0 %d out %d ws %zu (need %zu)\n", n_in, n_in > 0 ? in_sizes[0] : -1, out_size, ws_size, (size_t)WS_END); grid = -1; return; }
        int dev = 0, cus = 0, per_cu = 0;
        if (hipGetDevice(&dev) != hipSuccess || hipDeviceGetAttribute(&cus, hipDeviceAttributeMultiprocessorCount, dev) != hipSuccess) { grid = -1; return; }
        if (hipFuncSetAttribute((const void*)fwd, hipFuncAttributeMaxDynamicSharedMemorySize, LDS_BYTES) != hipSuccess) { fprintf(stderr, "kernel_launch: hipFuncSetAttribute failed\n"); grid = -1; return; }
        if (hipOccupancyMaxActiveBlocksPerMultiprocessor(&per_cu, (const void*)fwd, NWAVES * 64, LDS_BYTES) != hipSuccess || per_cu < 1) fprintf(stderr, "kernel_launch: occupancy query says %d\n", per_cu);
        (void)hipGetLastError();
        grid = cus;
    }
    if (grid < 0) return;
    (void)hipMemsetAsync((char*)d_ws + WS_CTL, 0, CTL_ZERO_BYTES, stream);
    (void)hipMemsetAsync((char*)d_ws + WS_WLU, 0, (size_t)3072 * 256 * 2, stream);
    Args a{};
    for (int i = 0; i < 33; ++i) a.in[i] = (const float*)d_in[i];
    a.out = (float*)d_out; a.ws = (unsigned char*)d_ws;
#if MK_ONE_LAUNCH
    a.ph_lo = 0; a.ph_hi = NPHASE;
    hipLaunchKernelGGL(fwd, dim3(grid), dim3(NWAVES * 64), LDS_BYTES, stream, a);
#else
    for (int p = 0; p < NPHASE; ++p) { a.ph_lo = p; a.ph_hi = p + 1; hipLaunchKernelGGL(fwd, dim3(grid), dim3(NWAVES * 64), LDS_BYTES, stream, a); }
#endif
}
```

```cpp
#include <hip/hip_runtime.h>
#include <cstdio>
#include <cstdint>

#ifndef MOEUP_ALIGN
#define MOEUP_ALIGN true
#endif
#ifndef MK_ONE_LAUNCH
#define MK_ONE_LAUNCH 1
#endif

namespace pg8 {
#define PG8_LAS __attribute__((address_space(3)))
typedef unsigned short bf16_t;
typedef short bf16x8 __attribute__((ext_vector_type(8)));
typedef float f32x4 __attribute__((ext_vector_type(4)));
typedef unsigned u32x4 __attribute__((ext_vector_type(4)));
typedef unsigned u32x2 __attribute__((ext_vector_type(2)));
typedef int i32x8 __attribute__((ext_vector_type(8)));
constexpr int BM = 256, BK = 64, HALF = 128, HTB = HALF * BK * 2, STAGE_BYTES = 8 * HTB, NXCD = 8, WGM = 8;

__host__ __device__ __forceinline__ int lds_byte(int r, int c) { const int st = (r >> 4) * 2 + (c >> 5), rr = r & 15, cc = c & 31, ob = rr * 64 + cc * 2; return st * 1024 + (ob ^ (((ob >> 9) & 1) << 5)); }
__host__ __device__ __forceinline__ void stage_rc(int b, int& R, int& C) { const int st = b / 1024, sb = b % 1024, swz = sb ^ (((sb >> 9) & 1) << 5); R = (st >> 1) * 16 + swz / 64; C = (st & 1) * 32 + (swz % 64) / 2; }
__host__ __device__ __forceinline__ int perm32(int rho) { const int n = rho >> 4, i = rho & 15; return 8 * (i >> 2) + 4 * n + (i & 3); }

struct Unit { int pm, pn, e, acol, k0, ntu, slice, mh; };
struct Gemm { const bf16_t* A; const bf16_t* Bt; int lda, K; size_t bstride_e; };
struct Gemm2 { const bf16_t* A[2]; const bf16_t* Bt[2]; int lda[2], K[2]; };

__device__ __forceinline__ void static_map(int L, int nM, int nN, int nwg, Unit& u) {
    int wgid = L; { const int q = nwg / NXCD, r = nwg % NXCD, xcd = wgid % NXCD, off = wgid / NXCD; wgid = (xcd < r ? xcd * (q + 1) : r * (q + 1) + (xcd - r) * q) + off; }
    const int nig = WGM * nN, gid = wgid / nig, fm = gid * WGM, gsz = (nM - fm) < WGM ? (nM - fm) : WGM;
    u.pm = fm + ((wgid % nig) % gsz); u.pn = (wgid % nig) / gsz; u.e = 0; u.acol = 0;
}
__device__ __forceinline__ int tail_tiles(int nwg, int G) { const int rem = nwg % G; return 2 * rem > G ? 0 : rem; }
struct StaticOrder {
    int nM, nN, nwg, G, c, lim;
    __device__ __forceinline__ void init(int nM_, int nN_, int G_, int c_, bool whole = false) { nM = nM_; nN = nN_; nwg = nM * nN; G = G_; c = c_; lim = whole ? nwg - tail_tiles(nwg, G) : nwg; }
    __device__ __forceinline__ bool next(int i, Unit& u) const { const long L = (long)i * G + c; if (L >= lim) return false; static_map((int)L, nM, nN, nwg, u); return true; }
};
struct TailHalfOrder {
    int nM, nN, nwg, G, c, Lbase, rem;
    __device__ __forceinline__ void init(int nM_, int nN_, int G_, int c_, bool active = true) { nM = nM_; nN = nN_; nwg = nM * nN; G = G_; c = c_; rem = active ? tail_tiles(nwg, G) : 0; Lbase = nwg - tail_tiles(nwg, G); }
    __device__ __forceinline__ bool next(int i, Unit& u) const { const long v = (long)i * G + c; if (v >= 2 * rem) return false; const int mh = (int)v / rem; static_map(Lbase + ((int)v - mh * rem), nM, nN, nwg, u); u.mh = mh; return true; }
};
struct MoeOrder {
    int nM, nN, nwg, G, c; int tp[9];
    __device__ void init(const int* cnt, int nN_, int G_, int c_) { int s = 0;
_Pragma("unroll")
        for (int e = 0; e < 8; ++e) { tp[e] = s; s += (cnt[e] + 255) >> 8; } tp[8] = s; nM = s; nN = nN_; nwg = nM * nN; G = G_; c = c_; }
    __device__ bool next(int i, Unit& u) const {
        const long L = (long)i * G + c; if (L >= nwg) return false;
        int wgid = (int)L; { const int q = nwg / NXCD, r = nwg % NXCD, xcd = wgid % NXCD, off = wgid / NXCD; wgid = (xcd < r ? xcd * (q + 1) : r * (q + 1) + (xcd - r) * q) + off; }
        const int nig = WGM * nN, gid = wgid / nig, fm = gid * WGM, gsz = (nM - fm) < WGM ? (nM - fm) : WGM;
        u.pm = fm + ((wgid % nig) % gsz); u.pn = (wgid % nig) / gsz;
        int e = 0;
#pragma unroll
        for (int k = 1; k < 8; ++k) e += (u.pm >= tp[k]) ? 1 : 0;
        u.e = e; u.acol = e * 64 - tp_of(e) + u.pm; return true;
    }
    __device__ int tp_of(int e) const { int r = 0;
_Pragma("unroll")
        for (int k = 0; k < 8; ++k) r = (k == e) ? tp[k] : r; return r; }
};

__device__ __forceinline__ unsigned cvt_pk_bf16(float lo, float hi) { unsigned r; asm volatile("v_cvt_pk_bf16_f32 %0, %1, %2" : "=v"(r) : "v"(lo), "v"(hi)); return r; }

#if defined(FORCE_SLICE)
__host__ __device__ __forceinline__ int moe_tail_tiles(int MT) { return (MT & 63) ? (MT & 63) : 8; }
#else
__host__ __device__ __forceinline__ int moe_tail_tiles(int MT) { return MT & 63; }
#endif
struct MoeDownOrder {
    int MT, MTf, nfull, nwg, G, c, ntK; int tp[9];
    __device__ void init(const int* cnt, int ntK_, int G_, int c_) { int s = 0;
_Pragma("unroll")
        for (int e = 0; e < 8; ++e) { tp[e] = s; s += (cnt[e] + 255) >> 8; } tp[8] = s; MT = s; MTf = MT - moe_tail_tiles(MT); nfull = MTf * 4; nwg = nfull + (MT - MTf) * 4 * 7; G = G_; c = c_; ntK = ntK_; }
    __device__ bool next(int i, Unit& u) const {
        const long L = (long)i * G + c; if (L >= nwg) return false;
        if (L < nfull) {
            int wgid = (int)L; { const int q = nfull / NXCD, xcd = wgid % NXCD, off = wgid / NXCD; wgid = xcd * q + off; }
            const int nig = WGM * 4, gid = wgid / nig, fm = gid * WGM;
            u.pm = fm + ((wgid % nig) % WGM); u.pn = (wgid % nig) / WGM; u.k0 = 0; u.ntu = ntK; u.slice = -1;
        } else { const int r = (int)L - nfull, q = r / 7; u.slice = r - 7 * q; u.pn = q & 3; u.pm = MTf + (q >> 2); u.k0 = 4 * u.slice; u.ntu = 4; }
        int e = 0;
#pragma unroll
        for (int k = 1; k < 8; ++k) e += (u.pm >= tp[k]) ? 1 : 0;
        u.e = e; u.acol = 0; return true;
    }
};
template <class Epi, class Sched, bool FP8 = false, bool KS = false, bool ALIGN = true, bool PA = false, bool HM = false>
__device__ __forceinline__ void gemm_phase(PG8_LAS unsigned char* lds, const Gemm g, const Sched& S, const Epi& E, int scale_w = 0x7F7F7F7F, int scale_x = 0x7F7F7F7F) {
    const int tid = threadIdx.x, wid = __builtin_amdgcn_readfirstlane(tid >> 6), lane = tid & 63, wr = wid >> 2, wc = wid & 3, fr = lane & 15, fq = lane >> 4;
    int K = g.K; asm volatile("" : "+s"(K));
    const int nt = K / BK, lda = g.lda;
    unsigned voffA[2], voffB[2];
#pragma unroll
    for (int i = 0; i < 2; ++i) { int R, C; stage_rc(tid * 16 + i * 8192, R, C); const int Rb = (R & ~31) + perm32(R & 31);
        voffA[i] = (unsigned)(R * lda + C) * 2u; voffB[i] = (unsigned)(Rb * K + C) * 2u; }
    const size_t kstep = (size_t)(BK * 2);
    const size_t hstepA = (size_t)HALF * lda * 2, hstepB = (size_t)HALF * K * 2;
    const size_t tstepA = 2 * hstepA, tstepB = 2 * hstepB;
    const unsigned ldsw = (unsigned)wid * 1024u;
    const int aoff = lds_byte(wr * 64 + fr, fq * 8), boff = lds_byte(wc * 32 + fr, fq * 8);
#define PG8_SA(b, h) (((b) * 2 + (h)) * HTB)
#define PG8_SB(b, h) ((4 + (b) * 2 + (h)) * HTB)
#define PG8_STAGE(bufoff, gbase, voff) do { _Pragma("unroll") for (int _i = 0; _i < 2; ++_i) \
        __builtin_amdgcn_global_load_lds((const unsigned*)((const char*)(gbase) + (voff)[_i]), (PG8_LAS unsigned*)(lds + (bufoff) + ldsw + _i * 8192), 16, 0, 0); } while (0)
#define PG8_LDA(dst, b, h) do { _Pragma("unroll") for (int m = 0; m < 4; ++m) { const u32x4 _l = *(const PG8_LAS u32x4*)(lds + PG8_SA(b, h) + aoff + m * 2048), _h = *(const PG8_LAS u32x4*)(lds + PG8_SA(b, h) + aoff + m * 2048 + 1024); \
        dst[m] = (i32x8){(int)_l.x, (int)_l.y, (int)_l.z, (int)_l.w, (int)_h.x, (int)_h.y, (int)_h.z, (int)_h.w}; } } while (0)
#define PG8_LDB(dst, b, h) do { _Pragma("unroll") for (int n = 0; n < 2; ++n) { const u32x4 _l = *(const PG8_LAS u32x4*)(lds + PG8_SB(b, h) + boff + n * 2048), _h = *(const PG8_LAS u32x4*)(lds + PG8_SB(b, h) + boff + n * 2048 + 1024); \
        dst[n] = (i32x8){(int)_l.x, (int)_l.y, (int)_l.z, (int)_l.w, (int)_h.x, (int)_h.y, (int)_h.z, (int)_h.w}; } } while (0)
#define PG8_MMA(ai, bj, At, Bt) do { __builtin_amdgcn_s_setprio(1); \
        if constexpr (FP8) { _Pragma("unroll") for (int m = 0; m < 4; ++m) _Pragma("unroll") for (int n = 0; n < 2; ++n) \
            asm volatile("v_mfma_scale_f32_16x16x128_f8f6f4 %0, %1, %2, %0, %3, %4 op_sel_hi:[0,0,0]" : "+v"(acc[ai][bj][m][n]) : "v"(Bt[n]), "v"(At[m]), "v"(scale_w), "v"(scale_x)); } \
        else { _Pragma("unroll") for (int m = 0; m < 4; ++m) _Pragma("unroll") for (int n = 0; n < 2; ++n) { \
            const i32x8 _a = At[m], _b = Bt[n]; \
            const bf16x8 _a0 = __builtin_bit_cast(bf16x8, (u32x4){(unsigned)_a[0], (unsigned)_a[1], (unsigned)_a[2], (unsigned)_a[3]}), _a1 = __builtin_bit_cast(bf16x8, (u32x4){(unsigned)_a[4], (unsigned)_a[5], (unsigned)_a[6], (unsigned)_a[7]}); \
            const bf16x8 _b0 = __builtin_bit_cast(bf16x8, (u32x4){(unsigned)_b[0], (unsigned)_b[1], (unsigned)_b[2], (unsigned)_b[3]}), _b1 = __builtin_bit_cast(bf16x8, (u32x4){(unsigned)_b[4], (unsigned)_b[5], (unsigned)_b[6], (unsigned)_b[7]}); \
            acc[ai][bj][m][n] = __builtin_amdgcn_mfma_f32_16x16x32_bf16(_b0, _a0, acc[ai][bj][m][n], 0, 0, 0); \
            acc[ai][bj][m][n] = __builtin_amdgcn_mfma_f32_16x16x32_bf16(_b1, _a1, acc[ai][bj][m][n], 0, 0, 0); } } \
        __builtin_amdgcn_s_setprio(0); } while (0)
#define PG8_WAIT_V(n) asm volatile("s_waitcnt vmcnt(" #n ")" ::: "memory")
#define PG8_WAIT_L(n) asm volatile("s_waitcnt lgkmcnt(" #n ")" ::: "memory")
#define PG8_BAR __builtin_amdgcn_s_barrier()
#define PG8_SCHED __builtin_amdgcn_sched_barrier(0)
    Unit cur, nxt; int ui = 0;
    if (!S.next(0, cur)) return;
    f32x4 acc[2][2][4][2];
#pragma unroll
    for (int a = 0; a < 2; ++a)
#pragma unroll
        for (int b = 0; b < 2; ++b)
#pragma unroll
            for (int m = 0; m < 4; ++m)
#pragma unroll
                for (int n = 0; n < 2; ++n) acc[a][b][m][n] = (f32x4){0.f, 0.f, 0.f, 0.f};
    i32x8 At[4], B0[2], B1[2];
    const char* cA = (const char*)g.A + (size_t)(PA ? cur.acol : cur.pm) * tstepA + (HM ? (size_t)cur.mh * hstepA : 0); const char* cB = (const char*)(g.Bt + (size_t)cur.e * g.bstride_e) + (size_t)cur.pn * tstepB;
    if constexpr (KS) { cA += (size_t)cur.k0 * kstep; cB += (size_t)cur.k0 * kstep; }
    int ntc = KS ? cur.ntu : nt;
    PG8_STAGE(PG8_SB(0, 0), cB, voffB); PG8_STAGE(PG8_SB(0, 1), cB + hstepB, voffB); PG8_STAGE(PG8_SA(0, 0), cA, voffA); PG8_STAGE(PG8_SA(0, 1), cA + hstepA, voffA);
    if (wr == 1) PG8_BAR;
    PG8_WAIT_V(2); PG8_BAR;
    PG8_STAGE(PG8_SB(1, 0), cB + kstep, voffB); PG8_STAGE(PG8_SA(1, 0), cA + kstep, voffA); PG8_STAGE(PG8_SB(1, 1), cB + hstepB + kstep, voffB);
    PG8_WAIT_V(6); PG8_BAR;
    for (;;) {
        const bool has_next = S.next(ui + 1, nxt);
        const char* nA = has_next ? (const char*)g.A + (size_t)(PA ? nxt.acol : nxt.pm) * tstepA + (KS ? (size_t)nxt.k0 * kstep : 0) + (HM ? (size_t)nxt.mh * hstepA : 0) : cA;
        const char* nB = has_next ? (const char*)(g.Bt + (size_t)nxt.e * g.bstride_e) + (size_t)nxt.pn * tstepB + (KS ? (size_t)nxt.k0 * kstep : 0) : cB;
        for (int t = 0; t < ntc; t += 2) {
            const bool last = (t == ntc - 2);
            const char* a1 = cA + (size_t)(t + 1) * kstep;
            const char* a2 = last ? nA : cA + (size_t)(t + 2) * kstep; const char* b2 = last ? nB : cB + (size_t)(t + 2) * kstep;
            const char* a3 = a2 + kstep; const char* b3 = b2 + kstep;
            PG8_LDB(B0, 0, 0); PG8_LDB(B1, 0, 1); PG8_SCHED; PG8_LDA(At, 0, 0); PG8_STAGE(PG8_SA(1, 1), a1 + hstepA, voffA);
            PG8_WAIT_V(8); PG8_WAIT_L(0); PG8_BAR; PG8_MMA(0, 0, At, B0); PG8_MMA(0, 1, At, B1); PG8_BAR; PG8_SCHED;
            PG8_LDA(At, 0, 1); PG8_STAGE(PG8_SB(0, 0), b2, voffB); PG8_STAGE(PG8_SB(0, 1), b2 + hstepB, voffB); PG8_STAGE(PG8_SA(0, 0), a2, voffA);
            PG8_WAIT_V(8); PG8_WAIT_L(0); PG8_BAR; if constexpr (!HM) { PG8_MMA(1, 0, At, B0); PG8_MMA(1, 1, At, B1); } PG8_BAR; PG8_SCHED;
            PG8_LDB(B0, 1, 0); PG8_LDB(B1, 1, 1); PG8_SCHED; PG8_LDA(At, 1, 0); PG8_STAGE(PG8_SA(0, 1), a2 + hstepA, voffA);
            PG8_WAIT_V(8); PG8_WAIT_L(0); PG8_BAR; PG8_MMA(0, 0, At, B0); PG8_MMA(0, 1, At, B1); PG8_BAR; PG8_SCHED;
            PG8_LDA(At, 1, 1); PG8_STAGE(PG8_SB(1, 0), b3, voffB); PG8_STAGE(PG8_SB(1, 1), b3 + hstepB, voffB); PG8_STAGE(PG8_SA(1, 0), a3, voffA);
            PG8_WAIT_V(8); PG8_WAIT_L(0); PG8_BAR; if constexpr (!HM) { PG8_MMA(1, 0, At, B0); PG8_MMA(1, 1, At, B1); } PG8_BAR; PG8_SCHED;
        }
        if constexpr (ALIGN) { if (wr == 0) PG8_BAR; }
        if constexpr (FP8) asm volatile("s_nop 15\n\ts_nop 15" ::: "memory");
        E(acc, cur, wr, wc, fr, fq);
        if (!has_next) break;
#pragma unroll
        for (int a = 0; a < 2; ++a)
#pragma unroll
            for (int b = 0; b < 2; ++b)
#pragma unroll
                for (int m = 0; m < 4; ++m)
#pragma unroll
                    for (int n = 0; n < 2; ++n) acc[a][b][m][n] = (f32x4){0.f, 0.f, 0.f, 0.f};
        cur = nxt; cA = nA; cB = nB; ++ui; if constexpr (KS) ntc = cur.ntu;
        if constexpr (ALIGN) { if (wr == 1) PG8_BAR; }
    }
    PG8_WAIT_V(0);
    if constexpr (!ALIGN) { if (wr == 0) PG8_BAR; }
    PG8_BAR;
#undef PG8_SA
#undef PG8_SB
#undef PG8_STAGE
#undef PG8_LDA
#undef PG8_LDB
#undef PG8_MMA
#undef PG8_WAIT_V
#undef PG8_WAIT_L
#undef PG8_BAR
#undef PG8_SCHED
}
template <class Epi, class Sched>
__device__ __forceinline__ void gemm_phase2(PG8_LAS unsigned char* lds, const Gemm2 g, const Sched& S, const Epi& E, unsigned* sig = nullptr) {
    const int tid = threadIdx.x, wid = __builtin_amdgcn_readfirstlane(tid >> 6), lane = tid & 63, wr = wid >> 2, wc = wid & 3, fr = lane & 15, fq = lane >> 4;
    int K0 = g.K[0], K1 = g.K[1]; asm volatile("" : "+s"(K0), "+s"(K1));
    unsigned voffA0[2], voffA1[2], voffB0[2], voffB1[2];
#pragma unroll
    for (int i = 0; i < 2; ++i) { int R, C; stage_rc(tid * 16 + i * 8192, R, C); const int Rb = (R & ~31) + perm32(R & 31);
        voffA0[i] = (unsigned)(R * g.lda[0] + C) * 2u; voffB0[i] = (unsigned)(Rb * K0 + C) * 2u; voffA1[i] = (unsigned)(R * g.lda[1] + C) * 2u; voffB1[i] = (unsigned)(Rb * K1 + C) * 2u; }
    const size_t kstep = (size_t)(BK * 2);
    const unsigned ldsw = (unsigned)wid * 1024u;
    const int aoff = lds_byte(wr * 64 + fr, fq * 8), boff = lds_byte(wc * 32 + fr, fq * 8);
#define PG8_SA(b, h) (((b) * 2 + (h)) * HTB)
#define PG8_SB(b, h) ((4 + (b) * 2 + (h)) * HTB)
#define PG8_STAGE(bufoff, gbase, v0, v1) do { \
        __builtin_amdgcn_global_load_lds((const unsigned*)((const char*)(gbase) + (v0)), (PG8_LAS unsigned*)(lds + (bufoff) + ldsw), 16, 0, 0); \
        __builtin_amdgcn_global_load_lds((const unsigned*)((const char*)(gbase) + (v1)), (PG8_LAS unsigned*)(lds + (bufoff) + ldsw + 8192), 16, 0, 0); } while (0)
#define PG8_LDA(dst, b, h) do { _Pragma("unroll") for (int m = 0; m < 4; ++m) _Pragma("unroll") for (int k = 0; k < 2; ++k) dst[m][k] = *(const PG8_LAS bf16x8*)(lds + PG8_SA(b, h) + aoff + m * 2048 + k * 1024); } while (0)
#define PG8_LDB(dst, b, h) do { _Pragma("unroll") for (int n = 0; n < 2; ++n) _Pragma("unroll") for (int k = 0; k < 2; ++k) dst[n][k] = *(const PG8_LAS bf16x8*)(lds + PG8_SB(b, h) + boff + n * 2048 + k * 1024); } while (0)
#define PG8_MMA(ai, bj, At, Bt) do { __builtin_amdgcn_s_setprio(1); _Pragma("unroll") for (int m = 0; m < 4; ++m) _Pragma("unroll") for (int n = 0; n < 2; ++n) _Pragma("unroll") for (int k = 0; k < 2; ++k) \
        acc[ai][bj][m][n] = __builtin_amdgcn_mfma_f32_16x16x32_bf16(Bt[n][k], At[m][k], acc[ai][bj][m][n], 0, 0, 0); __builtin_amdgcn_s_setprio(0); } while (0)
#define PG8_WAIT_V(n) asm volatile("s_waitcnt vmcnt(" #n ")" ::: "memory")
#define PG8_WAIT_L(n) asm volatile("s_waitcnt lgkmcnt(" #n ")" ::: "memory")
#define PG8_BAR __builtin_amdgcn_s_barrier()
#define PG8_SCHED __builtin_amdgcn_sched_barrier(0)
    Unit cur, nxt; int ui = 0;
    if (!S.next(0, cur)) return;
    f32x4 acc[2][2][4][2];
#pragma unroll
    for (int a = 0; a < 2; ++a)
#pragma unroll
        for (int b = 0; b < 2; ++b)
#pragma unroll
            for (int m = 0; m < 4; ++m)
#pragma unroll
                for (int n = 0; n < 2; ++n) acc[a][b][m][n] = (f32x4){0.f, 0.f, 0.f, 0.f};
    bf16x8 At[4][2], B0[2][2], B1[2][2];
#define PG8_CFG(u, cA_, cB_, hA_, hB_, vA0_, vA1_, vB0_, vB1_, nt_) do { const int _k = (u).e; const int _K = _k ? K1 : K0; const int _lda = _k ? g.lda[1] : g.lda[0]; \
        hA_ = (size_t)HALF * _lda * 2; hB_ = (size_t)HALF * _K * 2; nt_ = _K / BK; \
        cA_ = (const char*)(_k ? g.A[1] : g.A[0]) + (size_t)(u).pm * 2 * hA_ + (size_t)(u).acol * 2; cB_ = (const char*)(_k ? g.Bt[1] : g.Bt[0]) + (size_t)(u).pn * 2 * hB_; \
        vA0_ = _k ? voffA1[0] : voffA0[0]; vA1_ = _k ? voffA1[1] : voffA0[1]; vB0_ = _k ? voffB1[0] : voffB0[0]; vB1_ = _k ? voffB1[1] : voffB0[1]; } while (0)
    const char *cA, *cB, *nA, *nB; size_t chA, chB, nhA, nhB; unsigned cvA0, cvA1, cvB0, cvB1, nvA0, nvA1, nvB0, nvB1; int nt, nnt;
    PG8_CFG(cur, cA, cB, chA, chB, cvA0, cvA1, cvB0, cvB1, nt);
    PG8_STAGE(PG8_SB(0, 0), cB, cvB0, cvB1); PG8_STAGE(PG8_SB(0, 1), cB + chB, cvB0, cvB1); PG8_STAGE(PG8_SA(0, 0), cA, cvA0, cvA1); PG8_STAGE(PG8_SA(0, 1), cA + chA, cvA0, cvA1);
    if (wr == 1) PG8_BAR;
    PG8_WAIT_V(2); PG8_BAR;
    PG8_STAGE(PG8_SB(1, 0), cB + kstep, cvB0, cvB1); PG8_STAGE(PG8_SA(1, 0), cA + kstep, cvA0, cvA1); PG8_STAGE(PG8_SB(1, 1), cB + chB + kstep, cvB0, cvB1);
    PG8_WAIT_V(6); PG8_BAR;
    for (;;) {
        const bool has_next = S.next(ui + 1, nxt);
        if (has_next) { PG8_CFG(nxt, nA, nB, nhA, nhB, nvA0, nvA1, nvB0, nvB1, nnt); }
        else { nA = cA; nB = cB; nhA = chA; nhB = chB; nvA0 = cvA0; nvA1 = cvA1; nvB0 = cvB0; nvB1 = cvB1; nnt = nt; }
        for (int t = 0; t < nt; t += 2) {
            const bool last = (t == nt - 2);
            const char* a1 = cA + (size_t)(t + 1) * kstep;
            const char* a2 = last ? nA : cA + (size_t)(t + 2) * kstep; const char* b2 = last ? nB : cB + (size_t)(t + 2) * kstep;
            const char* a3 = a2 + kstep; const char* b3 = b2 + kstep;
            const size_t hA2 = last ? nhA : chA, hB2 = last ? nhB : chB;
            const unsigned xA0 = last ? nvA0 : cvA0, xA1 = last ? nvA1 : cvA1, xB0 = last ? nvB0 : cvB0, xB1 = last ? nvB1 : cvB1;
            PG8_LDB(B0, 0, 0); PG8_LDB(B1, 0, 1); PG8_SCHED; PG8_LDA(At, 0, 0); PG8_STAGE(PG8_SA(1, 1), a1 + chA, cvA0, cvA1);
            PG8_WAIT_V(8); PG8_WAIT_L(0); PG8_BAR; PG8_MMA(0, 0, At, B0); PG8_MMA(0, 1, At, B1); PG8_BAR; PG8_SCHED;
            PG8_LDA(At, 0, 1); PG8_STAGE(PG8_SB(0, 0), b2, xB0, xB1); PG8_STAGE(PG8_SB(0, 1), b2 + hB2, xB0, xB1); PG8_STAGE(PG8_SA(0, 0), a2, xA0, xA1);
            PG8_WAIT_V(8); PG8_WAIT_L(0); PG8_BAR; PG8_MMA(1, 0, At, B0); PG8_MMA(1, 1, At, B1); PG8_BAR; PG8_SCHED;
            PG8_LDB(B0, 1, 0); PG8_LDB(B1, 1, 1); PG8_SCHED; PG8_LDA(At, 1, 0); PG8_STAGE(PG8_SA(0, 1), a2 + hA2, xA0, xA1);
            PG8_WAIT_V(8); PG8_WAIT_L(0); PG8_BAR; PG8_MMA(0, 0, At, B0); PG8_MMA(0, 1, At, B1); PG8_BAR; PG8_SCHED;
            PG8_LDA(At, 1, 1); PG8_STAGE(PG8_SB(1, 0), b3, xB0, xB1); PG8_STAGE(PG8_SB(1, 1), b3 + hB2, xB0, xB1); PG8_STAGE(PG8_SA(1, 0), a3, xA0, xA1);
            PG8_WAIT_V(8); PG8_WAIT_L(0); PG8_BAR; PG8_MMA(1, 0, At, B0); PG8_MMA(1, 1, At, B1); PG8_BAR; PG8_SCHED;
        }
        if (wr == 0) PG8_BAR;
        E(acc, cur, wr, wc, fr, fq);
        if (sig != nullptr && cur.e == 1) {
            PG8_WAIT_V(0); PG8_BAR;
            if (tid == 0) { __builtin_amdgcn_fence(__ATOMIC_RELEASE, "agent"); __hip_atomic_fetch_add(sig, 1u, __ATOMIC_RELAXED, __HIP_MEMORY_SCOPE_AGENT); } }
        if (!has_next) break;
#pragma unroll
        for (int a = 0; a < 2; ++a)
#pragma unroll
            for (int b = 0; b < 2; ++b)
#pragma unroll
                for (int m = 0; m < 4; ++m)
#pragma unroll
                    for (int n = 0; n < 2; ++n) acc[a][b][m][n] = (f32x4){0.f, 0.f, 0.f, 0.f};
        cur = nxt; cA = nA; cB = nB; chA = nhA; chB = nhB; cvA0 = nvA0; cvA1 = nvA1; cvB0 = nvB0; cvB1 = nvB1; nt = nnt; ++ui;
        if (wr == 1) PG8_BAR;
    }
    PG8_WAIT_V(0);
    PG8_BAR;
#undef PG8_CFG
#undef PG8_SA
#undef PG8_SB
#undef PG8_STAGE
#undef PG8_LDA
#undef PG8_LDB
#undef PG8_MMA
#undef PG8_WAIT_V
#undef PG8_WAIT_L
#undef PG8_BAR
#undef PG8_SCHED
}
}

constexpr int NB = 8, SEQ = 2048, D = 1024, T = NB * SEQ;
constexpr int NH = 16, HS = 64;
constexpr int FFD = 2816, FFE = 3584, NE = 8;
constexpr int QD = 1536;
constexpr int NCAT = 3328;
constexpr int MOE_ROWS = 34816;
constexpr float RMS_EPS = 1e-5f, GN_EPS = 64e-5f;
constexpr float SS_SCALE = 1048576.0f;

constexpr size_t MiB = 1u << 20;
constexpr size_t WS_CTL = 0, CTL_ZERO_BYTES = 32768;
constexpr size_t CTL_LORA_DONE = 1024;
constexpr size_t CTL_BAR = 16384;
constexpr size_t CTL_SS1 = 65536, CTL_SS2 = CTL_SS1 + 131072, CTL_SS3 = CTL_SS2 + 131072;
constexpr size_t CTL_CNT = 524288;
constexpr size_t WS_LIST = 1 * MiB;
constexpr size_t WS_LGATE = WS_LIST + 512 * 1024;
constexpr size_t WS_TOKEP = 2 * MiB;
constexpr size_t WS_TGATE = WS_TOKEP + 128 * 1024;
constexpr size_t WS_SRSTD = WS_TGATE + 128 * 1024;
constexpr size_t WS_SGATE = WS_SRSTD + 160 * 1024;
constexpr size_t WS_WRKV = 3 * MiB;
constexpr size_t WS_WLORA = 9 * MiB;
constexpr size_t WS_WLU = 16 * MiB;
constexpr size_t WS_WO = 18 * MiB;
constexpr size_t WS_W13F = 20 * MiB;
constexpr size_t WS_W2F = 31 * MiB;
constexpr size_t WS_WQKV = 37 * MiB;
constexpr size_t WS_WAO = 46 * MiB;
constexpr size_t WS_R = 47 * MiB, WS_K = 79 * MiB, WS_V = 111 * MiB, WS_LW = 143 * MiB, WS_AA = 175 * MiB, WS_GG = 207 * MiB;
constexpr size_t WS_MH = 3 * MiB;
constexpr size_t WS_MW13 = 241 * MiB;
constexpr size_t WS_MW2 = 297 * MiB;
constexpr size_t WS_HCAT = 353 * MiB;
constexpr size_t WS_XR = 241 * MiB;
constexpr size_t WS_Z = 353 * MiB;
constexpr size_t WS_LH = 417 * MiB;
constexpr size_t WS_X1B = 47 * MiB;
constexpr size_t WS_FH = 79 * MiB;
constexpr size_t WS_X2B = 207 * MiB;
constexpr size_t WS_Q = 47 * MiB, WS_KK = 95 * MiB, WS_VV = 143 * MiB;
constexpr size_t WS_OM = 191 * MiB;
constexpr size_t WS_X3B = 207 * MiB;
constexpr size_t WS_X2F8 = 425 * MiB;
constexpr size_t WS_XG = 325 * MiB;
constexpr size_t WS_CONTRIB = 122 * MiB;
constexpr size_t WS_SLAB = 325 * MiB;
constexpr size_t WS_OG = 353 * MiB;
constexpr size_t WS_LSE = 401 * MiB;
constexpr size_t WS_END = 453 * MiB;

constexpr int NWAVES = 8;
constexpr int LDS_BYTES = 163840;
constexpr int RING_OFF = 0;
constexpr int MISC_OFF = 163840 - 256;

#define GAS __attribute__((address_space(1)))
#define LAS __attribute__((address_space(3)))
typedef unsigned short bf16;
typedef float f32x4 __attribute__((ext_vector_type(4)));
typedef float f32x2 __attribute__((ext_vector_type(2)));
typedef unsigned u32x4 __attribute__((ext_vector_type(4)));
typedef unsigned u32x2 __attribute__((ext_vector_type(2)));

typedef __bf16 bf16x2_t __attribute__((ext_vector_type(2)));
__device__ __forceinline__ unsigned pk2(float lo, float hi) { bf16x2_t v; v.x = (__bf16)lo; v.y = (__bf16)hi; return __builtin_bit_cast(unsigned, v); }
__device__ __forceinline__ float bf_lo(unsigned u) { return __uint_as_float(u << 16); }
__device__ __forceinline__ float bf_hi(unsigned u) { return __uint_as_float(u & 0xffff0000u); }
__device__ __forceinline__ float bf1(bf16 b) { return __uint_as_float(((unsigned)b) << 16); }
__device__ __forceinline__ float fast_rcp(float x) { return __builtin_amdgcn_rcpf(x); }
__device__ __forceinline__ float sigmoidf_(float x) { return __builtin_amdgcn_rcpf(1.0f + __expf(-x)); }

#define XB_TMO      128
#define XB_XCNT(j)  (256  + 64 * (j))
#define XB_XSUB(j)  (1280 + 64 * (j))
#define XB_XGEN(j)  (2304 + 64 * (j))
#define XB_TOP      3328
#define XB_TOPGEN   3392
#define XCD_BAR_WORDS 3456
#define XB_SPIN_CAP (1u << 18)

__device__ __forceinline__ unsigned xb_ld(unsigned* p)              { return __hip_atomic_load(p, __ATOMIC_RELAXED, __HIP_MEMORY_SCOPE_AGENT); }
__device__ __forceinline__ unsigned xb_add(unsigned* p, unsigned v) { return __hip_atomic_fetch_add(p, v, __ATOMIC_RELAXED, __HIP_MEMORY_SCOPE_AGENT); }
__device__ __forceinline__ unsigned xb_xcc_id() { return (unsigned)__builtin_amdgcn_s_getreg((3 << 11) | 20) & 0xFu; }
#define XB_SPIN(cond, bar) do { unsigned _sp = 0; while (cond) { __builtin_amdgcn_s_sleep(1); \
    if ((++_sp & 255u) == 0u) { if (xb_ld(&(bar)[XB_TMO])) break; if (_sp > XB_SPIN_CAP) { atomicAdd(&(bar)[XB_TMO], 1u); break; } } } } while (0)

struct XcdBarrier { unsigned* bar; unsigned x; volatile LAS unsigned* st; };

__device__ __forceinline__ XcdBarrier xcd_barrier_post(unsigned* bar, volatile LAS unsigned* st) {
    XcdBarrier b; b.bar = bar; b.x = xb_xcc_id(); b.st = st;
    if (threadIdx.x == 0) (void)xb_add(&bar[XB_XCNT(b.x)], 1u);
    return b;
}
__device__ __forceinline__ void xcd_barrier_complete(unsigned* bar, unsigned x, unsigned& nloc, unsigned& nx) {
    const unsigned G = gridDim.x * gridDim.y * gridDim.z;
    unsigned sum, cnt, mine, sp = 0u;
    for (;;) {
        sum = 0u; cnt = 0u; mine = 0u;
#pragma unroll
        for (unsigned j = 0; j < 16; ++j) { const unsigned c = xb_ld(&bar[XB_XCNT(j)]); sum += c; cnt += (c > 0u) ? 1u : 0u; mine = (j == x) ? c : mine; }
        if (sum == G) break;
        __builtin_amdgcn_s_sleep(1);
        if ((++sp & 255u) == 0u) { if (xb_ld(&bar[XB_TMO])) break; if (sp > XB_SPIN_CAP) { atomicAdd(&bar[XB_TMO], 1u); break; } }
    }
    nloc = mine > 0u ? mine : 1u; nx = cnt > 0u ? cnt : 1u;
}
__device__ __forceinline__ void xcd_barrier(const XcdBarrier& b) {
    asm volatile("s_waitcnt vmcnt(0)" ::: "memory");
    __syncthreads();
    if (threadIdx.x == 0) {
        unsigned* bar = b.bar;
        __builtin_amdgcn_s_waitcnt(0);
        unsigned nloc = b.st[0], nx = b.st[1];
        if (nloc == 0u) { xcd_barrier_complete(bar, b.x, nloc, nx); b.st[0] = nloc; b.st[1] = nx; }
        const unsigned old = xb_add(&bar[XB_XSUB(b.x)], 1u);
        const unsigned gen = old / nloc;
        if (old + 1u == (gen + 1u) * nloc) {
            __builtin_amdgcn_fence(__ATOMIC_RELEASE, "agent");
            asm volatile("s_waitcnt vmcnt(0)" ::: "memory");
            const unsigned og = xb_add(&bar[XB_TOP], 1u);
            const unsigned tg = og / nx;
            if (og + 1u == (tg + 1u) * nx) {
#pragma unroll
                for (unsigned j = 0; j < 16; ++j) (void)xb_add(&bar[XB_XGEN(j)], 1u);
            }
        }
        XB_SPIN(xb_ld(&bar[XB_XGEN(b.x)]) == gen, bar);
        __builtin_amdgcn_fence(__ATOMIC_ACQUIRE, "agent");
        asm volatile("s_waitcnt vmcnt(0)" ::: "memory");
    }
    __syncthreads();
}

struct Args { const float* in[33]; float* out; unsigned char* ws; int ph_lo, ph_hi; };
enum { I_X = 0, I_NG, I_MU, I_WR, I_WK, I_WV, I_W0, I_W1, I_W2, I_A0, I_A1, I_A2, I_G1, I_G2, I_KK, I_KA, I_RK, I_LNW, I_LNB, I_WO, I_KVG, I_WKV, I_WQ, I_AWO,
       I_F1, I_F3, I_F2, I_ROUTER, I_RBIAS, I_M1, I_M3, I_M2, I_FG };

struct TrJob { const float* src; int K, N; bf16* dst; int ldd, drow, dcol; const float* sc; int mode  , ileave  ; };
__device__ __forceinline__ int trjob_items(const TrJob& j) { return (j.K >> 6) * (j.N >> 6); }
__device__ __forceinline__ void tr_item(const TrJob& j, int item, LAS float* scr, int lane) {
    const int nblk = j.N >> 6, kb = item / nblk, nb = item - kb * nblk, k0 = kb << 6, n0 = nb << 6;
    const int lr = lane >> 4, n4 = (lane & 15) * 4;
#pragma unroll
    for (int half = 0; half < 2; ++half) {
        f32x4 v[8];
#pragma unroll
        for (int i = 0; i < 8; ++i) { const int kk = half * 32 + i * 4 + lr; v[i] = __builtin_nontemporal_load((const GAS f32x4*)(j.src + (size_t)(k0 + kk) * j.N + n0 + n4)); }
#pragma unroll
        for (int i = 0; i < 8; ++i) { const int kk = half * 32 + i * 4 + lr; float s = 1.0f;
            if (j.mode == 1) s = j.sc[k0 + kk]; else if (j.mode == 2) s = 1.0f - j.sc[k0 + kk];
            *(LAS f32x4*)(scr + kk * 68 + ((n4 + 4 * (kk >> 3)) & 63)) = v[i] * s; }
    }
    asm volatile("s_waitcnt lgkmcnt(0)" ::: "memory");
    const int c8 = lane & 7;
#pragma unroll
    for (int it = 0; it < 8; ++it) {
        const int n = it * 8 + (lane >> 3); const int col = (n + 4 * c8) & 63;
        const LAS float* s = scr + (8 * c8) * 68 + col;
        u32x4 o; o.x = pk2(s[0 * 68], s[1 * 68]); o.y = pk2(s[2 * 68], s[3 * 68]); o.z = pk2(s[4 * 68], s[5 * 68]); o.w = pk2(s[6 * 68], s[7 * 68]);
        const int ng = n0 + n; int row = j.drow + ng;
        if (j.ileave) row = j.drow + (ng >> 7) * 256 + (j.ileave - 1) * 128 + (ng & 127);
        *(GAS u32x4*)(j.dst + (size_t)row * j.ldd + j.dcol + k0 + 8 * c8) = o;
    }
    asm volatile("s_waitcnt lgkmcnt(0)" ::: "memory");
}

__device__ __forceinline__ unsigned pk4_fp8(float a, float b, float c, float d) { int w = 0; w = __builtin_amdgcn_cvt_pk_fp8_f32(a, b, w, false); w = __builtin_amdgcn_cvt_pk_fp8_f32(c, d, w, true); return (unsigned)w; }
__device__ __forceinline__ float clamp_fp8(float x) { return __builtin_amdgcn_fmed3f(x, -448.0f, 448.0f); }
struct TrJob8 { const float* src; int K, N; unsigned char* dst; int ldd; const float* sc; float mul; int ileave; };
__device__ __forceinline__ void tr_item8(const TrJob8& j, int item, LAS float* scr, int lane) {
    const int nblk = j.N >> 6, kb = item / nblk, nb = item - kb * nblk, k0 = kb << 6, n0 = nb << 6;
    const int lr = lane >> 4, n4 = (lane & 15) * 4;
#pragma unroll
    for (int half = 0; half < 2; ++half) {
        f32x4 v[8];
#pragma unroll
        for (int i = 0; i < 8; ++i) { const int kk = half * 32 + i * 4 + lr; v[i] = __builtin_nontemporal_load((const GAS f32x4*)(j.src + (size_t)(k0 + kk) * j.N + n0 + n4)); }
#pragma unroll
        for (int i = 0; i < 8; ++i) { const int kk = half * 32 + i * 4 + lr; const float s = j.sc ? j.sc[k0 + kk] * j.mul : j.mul;
            *(LAS f32x4*)(scr + kk * 68 + ((n4 + 4 * (kk >> 3)) & 63)) = v[i] * s; }
    }
    asm volatile("s_waitcnt lgkmcnt(0)" ::: "memory");
    const int c16 = lane & 3;
#pragma unroll
    for (int it = 0; it < 4; ++it) {
        const int n = it * 16 + (lane >> 2);
        u32x4 o; unsigned wv[4];
#pragma unroll
        for (int q = 0; q < 4; ++q) { const int c8 = 2 * c16 + (q >> 1), kb8 = 8 * c8 + 4 * (q & 1); const LAS float* sp = scr + kb8 * 68 + ((n + 4 * c8) & 63);
            wv[q] = pk4_fp8(sp[0], sp[68], sp[2 * 68], sp[3 * 68]); }
        o.x = wv[0]; o.y = wv[1]; o.z = wv[2]; o.w = wv[3];
        const int ng = n0 + n; int row = ng;
        if (j.ileave) row = (ng >> 7) * 256 + (j.ileave - 1) * 128 + (ng & 127);
        *(GAS u32x4*)(j.dst + (size_t)row * j.ldd + k0 + 16 * c16) = o;
    }
    asm volatile("s_waitcnt lgkmcnt(0)" ::: "memory");
}
constexpr int NJ0 = 3 + 6 + 3 + 1 + 2 + 1;
constexpr int NJ_EARLY = 12;
__device__ __forceinline__ TrJob job0(const Args& a, int j) {
    unsigned char* ws = a.ws; TrJob t; t.ileave = 0; t.mode = 0; t.sc = nullptr; t.dcol = 0; t.drow = 0;
    if (j < 3) { t.src = j == 0 ? a.in[I_WR] : (j == 1 ? a.in[I_WK] : a.in[I_WV]); t.K = 1024; t.N = 1024; t.dst = (bf16*)(ws + WS_WRKV); t.ldd = 1024; t.drow = 1024 * j; return t; }
    j -= 3;
    if (j < 6) {
        const int w = j >> 1, hi = j & 1;
        t.src = w == 0 ? a.in[I_W1] : (w == 1 ? a.in[I_A1] : a.in[I_G1]); const int mu = w == 0 ? 1 : (w == 1 ? 4 : 5);
        t.K = 1024; t.N = w == 2 ? 128 : 64; t.dst = (bf16*)(ws + WS_WLORA); t.ldd = 2048; t.drow = 64 * w; t.dcol = hi * 1024; t.sc = a.in[I_MU] + mu * D; t.mode = hi ? 1 : 2;
        return t; }
    j -= 6;
    if (j < 3) {
        t.src = j == 0 ? a.in[I_W2] : (j == 1 ? a.in[I_A2] : a.in[I_G2]); t.K = j == 2 ? 128 : 64; t.N = 1024; t.dst = (bf16*)(ws + WS_WLU); t.ldd = 128; t.drow = 1024 * j; t.dcol = j == 1 ? 64 : 0; return t; }
    j -= 3;
    if (j < 1) { t.src = a.in[I_WO]; t.K = 1024; t.N = 1024; t.dst = (bf16*)(ws + WS_WO); t.ldd = 1024; return t; }
    j -= 1;
    if (j < 2) { t.src = a.in[j ? I_F3 : I_F1]; t.K = 1024; t.N = FFD; t.dst = (bf16*)(ws + WS_W13F); t.ldd = 1024; t.sc = a.in[I_NG] + 1 * D; t.mode = 1; t.ileave = 1 + j; return t; }
    j -= 2;
    t.src = a.in[I_AWO]; t.K = 512; t.N = 1024; t.dst = (bf16*)(ws + WS_WAO); t.ldd = 512; return t;
}
constexpr float MW13_MUL = 64.0f, MW2_MUL = 128.0f, WQKV_MUL = 64.0f; constexpr int MW13_SCALE_BYTE = 127 - 6, MW2_SCALE_BYTE = 127 - 7, WQKV_SCALE_BYTE = 127 - 6;
__device__ __forceinline__ TrJob8 job_moe(const Args& a, int j) {
    TrJob8 t;
    if (j < 16) { const int e = j >> 1, w = j & 1;
        t.src = a.in[w ? I_M3 : I_M1] + (size_t)e * D * FFE; t.K = 1024; t.N = FFE; t.dst = a.ws + WS_MW13 + (size_t)e * 7168 * 1024; t.ldd = 1024; t.sc = a.in[I_NG] + 3 * D; t.mul = MW13_MUL; t.ileave = 1 + w; }
    else if (j == 26) { t.src = a.in[I_F2]; t.K = FFD; t.N = 1024; t.dst = a.ws + WS_W2F; t.ldd = FFD; t.sc = nullptr; t.mul = MW2_MUL; t.ileave = 0; }
    else if (j == 24) { t.src = a.in[I_WQ]; t.K = 1024; t.N = QD; t.dst = a.ws + WS_WQKV; t.ldd = 1024; t.sc = a.in[I_NG] + 2 * D; t.mul = WQKV_MUL; t.ileave = 0; }
    else if (j == 25) { t.src = a.in[I_WKV]; t.K = 1024; t.N = 2 * QD; t.dst = a.ws + WS_WQKV + (size_t)QD * 1024; t.ldd = 1024; t.sc = a.in[I_KVG]; t.mul = WQKV_MUL; t.ileave = 0; }
    else { const int e = j - 16;
        t.src = a.in[I_M2] + (size_t)e * FFE * D; t.K = FFE; t.N = 1024; t.dst = a.ws + WS_MW2 + (size_t)e * 1024 * FFE; t.ldd = FFE; t.sc = nullptr; t.mul = MW2_MUL; t.ileave = 0; }
    return t;
}
__device__ __forceinline__ float wave_sum(float v) {
#pragma unroll
    for (int o = 1; o < 64; o <<= 1) v += __shfl_xor(v, o);
    return v;
}
__device__ __forceinline__ float row16_sum(float v) {
    v += __builtin_bit_cast(float, __builtin_amdgcn_update_dpp(0, __builtin_bit_cast(int, v), 0xB1, 0xf, 0xf, false));
    v += __builtin_bit_cast(float, __builtin_amdgcn_update_dpp(0, __builtin_bit_cast(int, v), 0x4E, 0xf, 0xf, false));
    v += __builtin_bit_cast(float, __builtin_amdgcn_update_dpp(0, __builtin_bit_cast(int, v), 0x141, 0xf, 0xf, false));
    v += __builtin_bit_cast(float, __builtin_amdgcn_update_dpp(0, __builtin_bit_cast(int, v), 0x140, 0xf, 0xf, false));
    return v;
}


using pg8::Unit;
__device__ __forceinline__ float rstd_from_ss(const unsigned long long* ss, int row) {
    const float s = (float)ss[row] * (1.0f / SS_SCALE);
    return __builtin_amdgcn_rsqf(s * (1.0f / D) + RMS_EPS);
}
struct G1Order {
    int G, c;
    __device__ bool next(int i, Unit& u) const {
        int L;
        if (c < 64) { if (i == 0) { u.pm = c; u.pn = 0; u.e = 1; u.acol = 0; return true; } if (i > 2) return false; L = (i - 1) * 64 + c; }
        else { L = 128 + (c - 64) + (G - 64) * i; if (L >= 768) return false; }
        const int xcd = L % 8, off = L / 8, wgid = xcd * 96 + off;
        const int gid = wgid / 32, fm = gid * 8;
        u.pm = fm + ((wgid % 32) % 8); u.pn = (u.pm >> 6) * 4 + (wgid % 32) / 8; u.e = 0; u.acol = 0; return true;
    }
};
struct EpiG1 {
    bf16 *r, *lh;
    __device__ __forceinline__ void operator()(const f32x4 (&acc)[2][2][4][2], const Unit& u, int wr, int wc, int fr, int fq) const {
        const int cw = wc * 32 + 8 * fq;
        if (u.e == 0) {
            const int which = u.pn >> 2, row0 = (u.pm - 64 * which) * 256 + wr * 64 + fr;
            bf16* base = r + (size_t)which * ((size_t)T * D); const int colt = (u.pn & 3) * 256 + cw;
#pragma unroll
            for (int ai = 0; ai < 2; ++ai)
#pragma unroll
                for (int m = 0; m < 4; ++m) { bf16* rowp = base + (size_t)(row0 + ai * 128 + m * 16) * D + colt;
#pragma unroll
                    for (int bj = 0; bj < 2; ++bj) { const f32x4 v0 = acc[ai][bj][m][0], v1 = acc[ai][bj][m][1];
                        u32x4 w; w.x = pk2(v0[0], v0[1]); w.y = pk2(v0[2], v0[3]); w.z = pk2(v1[0], v1[1]); w.w = pk2(v1[2], v1[3]);
                        *(GAS u32x4*)(rowp + bj * 128) = w; } }
        } else {
            const int row0 = u.pm * 256 + wr * 64 + fr;
#pragma unroll
            for (int ai = 0; ai < 2; ++ai)
#pragma unroll
                for (int m = 0; m < 4; ++m) { bf16* rowp = lh + (size_t)(row0 + ai * 128 + m * 16) * 256 + cw;
#pragma unroll
                    for (int bj = 0; bj < 2; ++bj) { const int c = cw + bj * 128; float x[8];
#pragma unroll
                        for (int i = 0; i < 4; ++i) { x[i] = acc[ai][bj][m][0][i]; x[4 + i] = acc[ai][bj][m][1][i]; }
#pragma unroll
                        for (int i = 0; i < 8; ++i) { if (c < 64) x[i] = 1.0f - 2.0f * __builtin_amdgcn_rcpf(1.0f + __expf(2.0f * x[i])); else if (c >= 128) x[i] = sigmoidf_(x[i]); }
                        u32x4 w; w.x = pk2(x[0], x[1]); w.y = pk2(x[2], x[3]); w.z = pk2(x[4], x[5]); w.w = pk2(x[6], x[7]);
                        *(GAS u32x4*)(rowp + bj * 128) = w; } }
        }
    }
};
struct G2Order { pg8::StaticOrder so;
    __device__ bool next(int i, Unit& u) const {
        if (so.G == 256) { int L; if (so.c >= 128) { if (i >= 4) return false; L = i * 128 + so.c - 128; } else { if (i >= 2) return false; L = 512 + i * 128 + so.c; }
            pg8::static_map(L, so.nM, so.nN, so.nwg, u); }
        else if (!so.next(i, u)) return false;
        u.acol = u.pn >= 8 ? 128 : 0; return true; } };
struct EpiG2 {
    bf16 *lw; const float *w0, *a0;
    __device__ __forceinline__ void operator()(const f32x4 (&acc)[2][2][4][2], const Unit& u, int wr, int wc, int fr, int fq) const {
        const int row0 = u.pm * 256 + wr * 64 + fr, which = u.pn >> 2, colt = (u.pn & 3) * 256 + wc * 32 + 8 * fq;
        bf16* base = lw + (size_t)which * ((size_t)T * D);
        const float* bp = which == 0 ? w0 : a0; const float bsc = which == 2 ? 0.f : 1.f, osc = which == 0 ? -0.6065306597f * 1.4426950408889634f : 1.0f;
#pragma unroll
        for (int bj = 0; bj < 2; ++bj) {
            const f32x4 b0 = *(const GAS f32x4*)(bp + colt + bj * 128) * bsc, b1 = *(const GAS f32x4*)(bp + colt + bj * 128 + 4) * bsc;
#pragma unroll
            for (int ai = 0; ai < 2; ++ai)
#pragma unroll
                for (int m = 0; m < 4; ++m) { bf16* rowp = base + (size_t)(row0 + ai * 128 + m * 16) * D + colt; float x[8];
#pragma unroll
                    for (int i = 0; i < 4; ++i) { x[i] = acc[ai][bj][m][0][i] + b0[i]; x[4 + i] = acc[ai][bj][m][1][i] + b1[i]; }
                    if (which != 2) {
#pragma unroll
                        for (int i = 0; i < 8; ++i) x[i] = osc * sigmoidf_(x[i]);
                    }
                    u32x4 w; w.x = pk2(x[0], x[1]); w.y = pk2(x[2], x[3]); w.z = pk2(x[4], x[5]); w.w = pk2(x[6], x[7]);
                    *(GAS u32x4*)(rowp + bj * 128) = w;
                    asm volatile("" ::: "memory"); }
        }
    }
};
template <bool R32> struct EpiResT {
    const float* resid32; const bf16* resid16; bf16* xb; unsigned long long* ss; unsigned char* x8;
    __device__ __forceinline__ void load(int row0, int col0, int st, f32x4 (&r)[4], u32x4 (&h)[2]) const {
        const size_t off = (size_t)(row0 + (st >> 2) * 128 + (st & 3) * 16) * D + col0;
        if constexpr (R32) { r[0] = *(const GAS f32x4*)(resid32 + off); r[1] = *(const GAS f32x4*)(resid32 + off + 4); r[2] = *(const GAS f32x4*)(resid32 + off + 128); r[3] = *(const GAS f32x4*)(resid32 + off + 132); }
        else { h[0] = *(const GAS u32x4*)(resid16 + off); h[1] = *(const GAS u32x4*)(resid16 + off + 128); }
    }
    __device__ __forceinline__ void operator()(const f32x4 (&acc)[2][2][4][2], const Unit& u, int wr, int wc, int fr, int fq) const {
        const int row0 = u.pm * 256 + wr * 64 + fr, col0 = u.pn * 256 + wc * 32 + 8 * fq;
        constexpr int DIST = R32 ? 1 : 3;
        f32x4 ring[4][4]; u32x4 ringh[4][2];
#pragma unroll
        for (int st = 0; st < DIST; ++st) load(row0, col0, st, ring[st], ringh[st]);
#pragma unroll
        for (int st = 0; st < 8; ++st) { const int ai = st >> 2, m = st & 3;
            if (st + DIST < 8) load(row0, col0, st + DIST, ring[(st + DIST) & 3], ringh[(st + DIST) & 3]);
            const int row = row0 + ai * 128 + m * 16; const size_t off = (size_t)row * D + col0; float sq = 0.f;
#pragma unroll
            for (int bj = 0; bj < 2; ++bj) {
                f32x4 r0, r1;
                if constexpr (R32) { r0 = ring[st & 3][2 * bj]; r1 = ring[st & 3][2 * bj + 1]; }
                else { const u32x4 rw = ringh[st & 3][bj]; r0 = (f32x4){bf_lo(rw.x), bf_hi(rw.x), bf_lo(rw.y), bf_hi(rw.y)}; r1 = (f32x4){bf_lo(rw.z), bf_hi(rw.z), bf_lo(rw.w), bf_hi(rw.w)}; }
                const f32x4 o0 = r0 + acc[ai][bj][m][0], o1 = r1 + acc[ai][bj][m][1];
                u32x4 w; w.x = pk2(o0[0], o0[1]); w.y = pk2(o0[2], o0[3]); w.z = pk2(o1[0], o1[1]); w.w = pk2(o1[2], o1[3]);
                *(GAS u32x4*)(xb + off + bj * 128) = w;
                if (x8) { u32x2 w8; w8.x = pk4_fp8(clamp_fp8(o0[0]), clamp_fp8(o0[1]), clamp_fp8(o0[2]), clamp_fp8(o0[3])); w8.y = pk4_fp8(clamp_fp8(o1[0]), clamp_fp8(o1[1]), clamp_fp8(o1[2]), clamp_fp8(o1[3])); *(GAS u32x2*)(x8 + off + bj * 128) = w8; }
                sq += (o0[0] * o0[0] + o0[1] * o0[1]) + (o0[2] * o0[2] + o0[3] * o0[3]) + (o1[0] * o1[0] + o1[1] * o1[1]) + (o1[2] * o1[2] + o1[3] * o1[3]); }
            sq += __shfl_xor(sq, 16); sq += __shfl_xor(sq, 32);
            if (fq == 0) atomicAdd(ss + row, (unsigned long long)(sq * SS_SCALE + 0.5f)); }
    }
};
template <bool HM> struct EpiSwigluT {
    bf16* hid; int ldc; const unsigned long long* ss; const float* srstd; int out8; const LAS float* rtab;
    __device__ __forceinline__ void operator()(const f32x4 (&acc)[2][2][4][2], const Unit& u, int wr, int wc, int fr, int fq) const {
        const int row0 = u.pm * 256 + wr * 64 + fr + (HM ? u.mh * 128 : 0), col0 = u.pn * 128 + wc * 32 + 8 * fq;
        float rsv[2][4];
#pragma unroll
        for (int ai = 0; ai < (HM ? 1 : 2); ++ai)
#pragma unroll
            for (int m = 0; m < 4; ++m) { const int row = row0 + ai * 128 + m * 16; rsv[ai][m] = rtab ? rtab[row & 2047] : (ss ? rstd_from_ss(ss, row) : (srstd ? srstd[row] : 1.0f)); }
#pragma unroll
        for (int ai = 0; ai < (HM ? 1 : 2); ++ai)
#pragma unroll
            for (int m = 0; m < 4; ++m) { const int row = row0 + ai * 128 + m * 16; const float rs = rsv[ai][m], rs2 = rs * rs, nrl = -1.4426950408889634f * rs; float x[8];
#pragma unroll
                for (int n = 0; n < 2; ++n)
#pragma unroll
                    for (int i = 0; i < 4; ++i) { const float a = acc[ai][0][m][n][i], b = acc[ai][1][m][n][i]; x[n * 4 + i] = (a * rs2) * b * __builtin_amdgcn_rcpf(1.0f + __builtin_amdgcn_exp2f(a * nrl)); if (out8) x[n * 4 + i] = clamp_fp8(x[n * 4 + i]); }
                if (out8) { u32x2 w; w.x = pk4_fp8(x[0], x[1], x[2], x[3]); w.y = pk4_fp8(x[4], x[5], x[6], x[7]); *(GAS u32x2*)((unsigned char*)hid + (size_t)row * ldc + col0) = w; }
                else { u32x4 w; w.x = pk2(x[0], x[1]); w.y = pk2(x[2], x[3]); w.z = pk2(x[4], x[5]); w.w = pk2(x[6], x[7]);
                    *(GAS u32x4*)(hid + (size_t)row * ldc + col0) = w; } }
    }
};
typedef EpiSwigluT<false> EpiSwiglu;
template <bool HM> struct EpiQKVT {
    bf16 *q; const unsigned long long* ss; const LAS float* rtab;
    __device__ __forceinline__ void operator()(const f32x4 (&acc)[2][2][4][2], const Unit& u, int wr, int wc, int fr, int fq) const {
        const int row0 = u.pm * 256 + wr * 64 + fr + (HM ? u.mh * 128 : 0), which = u.pn / 6, pnl = u.pn - which * 6, g = pnl >> 1, sh = 2 * g;
        const int h0 = (pnl & 1) * 4 + (wc >> 1), d0 = (wc & 1) * 32 + 8 * fq;
        bf16* base = q + (size_t)which * ((size_t)T * QD);
        float rsv[2][4];
#pragma unroll
        for (int ai = 0; ai < (HM ? 1 : 2); ++ai)
#pragma unroll
            for (int m = 0; m < 4; ++m) { const int row = row0 + ai * 128 + m * 16; rsv[ai][m] = rtab ? rtab[row & 2047] : rstd_from_ss(ss, row); }
#pragma unroll
        for (int ai = 0; ai < (HM ? 1 : 2); ++ai)
#pragma unroll
            for (int m = 0; m < 4; ++m) { const int row = row0 + ai * 128 + m * 16; const float rs = rsv[ai][m];
                const int b = row >> 11, sq = row & 2047, pos = ((sq & ((1 << sh) - 1)) << (11 - sh)) + (sq >> sh);
                bf16* rowp = base + ((size_t)((b * 3 + g) * 8 + h0) * 2048 + pos) * 64 + d0;
#pragma unroll
                for (int bj = 0; bj < 2; ++bj) { const f32x4 v0 = acc[ai][bj][m][0] * rs, v1 = acc[ai][bj][m][1] * rs;
                    u32x4 w; w.x = pk2(v0[0], v0[1]); w.y = pk2(v0[2], v0[3]); w.z = pk2(v1[0], v1[1]); w.w = pk2(v1[2], v1[3]);
                    *(GAS u32x4*)(rowp + bj * (2 * 2048 * 64)) = w; } }
    }
};
typedef EpiQKVT<false> EpiQKV;
struct EpiGate {
    bf16* c; bf16* slab; int MTf;
    __device__ __forceinline__ void operator()(const f32x4 (&acc)[2][2][4][2], const Unit& u, int wr, int wc, int fr, int fq) const {
        const int col0 = u.pn * 256 + wc * 32 + 8 * fq;
        bf16* base = u.slice < 0 ? c + (size_t)(u.pm * 256) * D : slab + ((size_t)u.slice * 2048 + (size_t)(u.pm - MTf) * 256) * D;
        const int row0 = wr * 64 + fr;
#pragma unroll
        for (int ai = 0; ai < 2; ++ai)
#pragma unroll
            for (int m = 0; m < 4; ++m) { const int row = row0 + ai * 128 + m * 16; bf16* rowp = base + (size_t)row * D + col0;
#pragma unroll
                for (int bj = 0; bj < 2; ++bj) { const f32x4 v0 = acc[ai][bj][m][0], v1 = acc[ai][bj][m][1];
                    u32x4 w; w.x = pk2(v0[0], v0[1]); w.y = pk2(v0[2], v0[3]); w.z = pk2(v1[0], v1[1]); w.w = pk2(v1[2], v1[3]);
                    *(GAS u32x4*)(rowp + bj * 128) = w; } }
    }
};

struct Frame { LAS unsigned char* lds; int tid, lane, wave, G, bid; };

__device__ __forceinline__ void run_jobs(const Args& a, Frame& F, int j0, int j1, int gw, int NGW) {
    LAS float* scr = (LAS float*)(F.lds) + F.wave * (64 * 68);
    int base = 0;
    for (int j = j0; j < j1; ++j) {
        const TrJob t = job0(a, j);
        const int ni = trjob_items(t);
        int first = (gw - (base % NGW) + NGW) % NGW;
        for (int it = first; it < ni; it += NGW) tr_item(t, it, scr, F.lane);
        base += ni;
    }
}
__device__ __forceinline__ void run_jobs_moe(const Args& a, Frame& F, int gw, int NGW, int lo, int hi) {
    LAS float* scr = (LAS float*)(F.lds) + F.wave * (64 * 68);
    constexpr int NMOE = 24 * 896, NQ = (1024 / 64) * (QD / 64), NKV = (1024 / 64) * (2 * QD / 64), NF2 = (FFD / 64) * (1024 / 64);
    static_assert((NMOE + NQ + NKV + NF2) % 32 == 0, "item count");
    const int wsh = hi - lo, total = ((NMOE + NQ + NKV + NF2) / 32) * wsh;
    for (int r = gw; r < total; r += NGW) {
        const int gi = (r / wsh) * 32 + lo + (r % wsh); int j, it;
        if (gi < NMOE) { j = gi / 896; it = gi - j * 896; } else if (gi < NMOE + NQ) { j = 24; it = gi - NMOE; } else if (gi < NMOE + NQ + NKV) { j = 25; it = gi - NMOE - NQ; } else { j = 26; it = gi - NMOE - NQ - NKV; }
        const TrJob8 t = job_moe(a, j);
        tr_item8(t, it, scr, F.lane);
    }
}
__device__ __forceinline__ void p0_zero(const Args& a, Frame& F) {
    const int gt = F.bid * (NWAVES * 64) + F.tid, NT = F.G * NWAVES * 64;
    GAS u32x4* z = (GAS u32x4*)(a.ws + CTL_SS1);
    for (int i = gt; i < (int)(3 * 131072 / 16); i += NT) z[i] = (u32x4){0u, 0u, 0u, 0u};
    if (gt < 2) ((GAS u32x4*)(a.ws + CTL_CNT))[gt] = (u32x4){0u, 0u, 0u, 0u};
    bf16* wlu = (bf16*)(a.ws + WS_WLU);
    for (int i = gt; i < 2048 * 8; i += NT) { const int row = i >> 3, ch = i & 7; *(GAS u32x4*)(wlu + (size_t)row * 128 + (row < 1024 ? 64 : 0) + 8 * ch) = (u32x4){0u, 0u, 0u, 0u}; }
}
__device__ __forceinline__ void p0_hcat(const Args& a, Frame& F) {
    const float* x = a.in[I_X]; const float* g = a.in[I_NG];
    bf16* hc = (bf16*)(a.ws + WS_HCAT); bf16* xr = (bf16*)(a.ws + WS_XR);
    const float* mu = a.in[I_MU];
    const int gw = F.bid * NWAVES + F.wave, NGW = F.G * NWAVES;
    constexpr int RPW = 8;
    f32x4 gv[4], m0v[4], m2v[4], m3v[4];
#pragma unroll
    for (int j = 0; j < 4; ++j) { const int c = 4 * F.lane + 256 * j; gv[j] = *(const GAS f32x4*)(g + c); m0v[j] = *(const GAS f32x4*)(mu + 0 * D + c); m2v[j] = *(const GAS f32x4*)(mu + 2 * D + c); m3v[j] = *(const GAS f32x4*)(mu + 3 * D + c); }
    for (int blk = gw; blk < T / RPW; blk += NGW) {
        const int m0 = blk * RPW;
        f32x4 hp[4], v[4], nv[4];
#pragma unroll
        for (int j = 0; j < 4; ++j) hp[j] = (f32x4){0.f, 0.f, 0.f, 0.f};
        const int mi0 = ((m0 & (SEQ - 1)) != 0 ? -1 : 0);
        { const GAS f32x4* xrw = (const GAS f32x4*)(x + (size_t)(m0 + mi0) * D) + F.lane;
#pragma unroll
          for (int j = 0; j < 4; ++j) v[j] = __builtin_nontemporal_load(xrw + 64 * j); }
        for (int mi = mi0; mi < RPW; ++mi) {
            const int m = m0 + mi;
            if (mi + 1 < RPW) { const GAS f32x4* xrw = (const GAS f32x4*)(x + (size_t)(m + 1) * D) + F.lane;
#pragma unroll
                for (int j = 0; j < 4; ++j) nv[j] = __builtin_nontemporal_load(xrw + 64 * j); }
            float s = 0.f;
#pragma unroll
            for (int j = 0; j < 4; ++j) s += (v[j].x * v[j].x + v[j].y * v[j].y) + (v[j].z * v[j].z + v[j].w * v[j].w);
            const float rstd = 1.f / sqrtf(wave_sum(s) * (1.f / D) + RMS_EPS);
#pragma unroll
            for (int j = 0; j < 4; ++j) { const int c = 4 * F.lane + 256 * j;
                const f32x4 h = v[j] * rstd * gv[j];
                if (mi >= 0) {
                    const f32x4 dlt = hp[j] - h;
                    u32x2 w; w.x = pk2(h.x, h.y); w.y = pk2(h.z, h.w);
                    *(GAS u32x2*)(hc + (size_t)m * 2048 + c) = w;
                    w.x = pk2(hp[j].x, hp[j].y); w.y = pk2(hp[j].z, hp[j].w);
                    *(GAS u32x2*)(hc + (size_t)m * 2048 + 1024 + c) = w;
                    const f32x4 r4 = h + dlt * m0v[j], k4 = h + dlt * m2v[j], v4 = h + dlt * m3v[j];
                    w.x = pk2(r4.x, r4.y); w.y = pk2(r4.z, r4.w); *(GAS u32x2*)(xr + (size_t)m * D + c) = w;
                    w.x = pk2(k4.x, k4.y); w.y = pk2(k4.z, k4.w); *(GAS u32x2*)(xr + ((size_t)T + m) * D + c) = w;
                    w.x = pk2(v4.x, v4.y); w.y = pk2(v4.z, v4.w); *(GAS u32x2*)(xr + ((size_t)2 * T + m) * D + c) = w;
                }
                hp[j] = h; }
#pragma unroll
            for (int j = 0; j < 4; ++j) v[j] = nv[j];
        }
    }
}

constexpr int CH_NS = 8;
constexpr int CH_RS = 72;
constexpr int CH_OFF_AT = 0, CH_OFF_RT = 2304, CH_OFF_BB = 4608, CH_OFF_KB = 4608 + 2304, CH_OFF_VV = 4608 + 2 * 2304, CH_OFF_MKA = 4608 + 3 * 2304, CH_OFF_TT = CH_OFF_MKA + 512,
              CH_OFF_NBR = CH_OFF_TT + 512, CH_OFF_NKR = CH_OFF_NBR + 512, CH_OFF_MF = CH_OFF_NKR + 512, CH_OFF_GC = CH_OFF_MF + 1024, CH_OFF_RK = CH_OFF_GC + 256, CH_SLOT = CH_OFF_RK + 64;
constexpr int CH_YBUF = CH_NS * CH_SLOT;
constexpr int CH_PAR = CH_YBUF + 8 * 4608;
static_assert(CH_PAR + 768 <= MISC_OFF && (CH_SLOT % 16) == 0 && (CH_PAR % 16) == 0, "chunked scan LDS map");
#define ROW_SHR_ADD(x, ctrl) x += __builtin_bit_cast(float, __builtin_amdgcn_update_dpp(0, __builtin_bit_cast(int, x), ctrl, 0xf, 0xf, true))
template <int PARTS = 7>
__device__ __forceinline__ void p3_scan_chunked(const Args& a, Frame& F, int pair) {
    typedef short bf16x8 __attribute__((ext_vector_type(8)));
    unsigned char* ws = a.ws;
    const bf16 *Rg = (const bf16*)(ws + WS_R), *Kg = (const bf16*)(ws + WS_K), *Vg = (const bf16*)(ws + WS_V), *LWg = (const bf16*)(ws + WS_LW), *AAg = (const bf16*)(ws + WS_AA), *GGg = (const bf16*)(ws + WS_GG);
    bf16* Z = (bf16*)(ws + WS_Z);
    const int b = pair >> 4, h = pair & 15, lane = F.lane, w = F.wave;
    const size_t tbase = (size_t)b * SEQ;
    LAS unsigned char* L = F.lds;
    LAS float* ybuf = (LAS float*)(L + CH_YBUF);
    const unsigned lbase = (unsigned)(size_t)L;
    const int t = lane & 15, chq = lane >> 4, ch0 = h * 64 + 16 * chq;
    const int n = lane & 15, hq = lane >> 4;
    f32x4 ST[4];
#pragma unroll
    for (int T4 = 0; T4 < 4; ++T4) ST[T4] = (f32x4){0.f, 0.f, 0.f, 0.f};
    { LAS float* par = (LAS float*)(L + CH_PAR);
      if (F.tid < 192) { const int pi = F.tid >> 6, cc = F.tid & 63; par[F.tid] = (pi == 0 ? a.in[I_KK] : (pi == 1 ? a.in[I_KA] : a.in[I_RK]))[h * 64 + cc]; } }
    __syncthreads();
    const f32x4 lnw = *(const GAS f32x4*)(a.in[I_LNW] + h * 64 + 4 * (F.tid & 15)), lnb = *(const GAS f32x4*)(a.in[I_LNB] + h * 64 + 4 * (F.tid & 15));
    u32x4 raw[5][2];
    { const size_t off = (tbase + 16 * w + t) * D + ch0;
#pragma unroll
      for (int hf = 0; hf < 2; ++hf) { raw[0][hf] = __builtin_nontemporal_load((const GAS u32x4*)(Rg + off + 8 * hf)); raw[1][hf] = __builtin_nontemporal_load((const GAS u32x4*)(Kg + off + 8 * hf)); raw[2][hf] = __builtin_nontemporal_load((const GAS u32x4*)(Vg + off + 8 * hf));
          raw[3][hf] = __builtin_nontemporal_load((const GAS u32x4*)(LWg + off + 8 * hf)); raw[4][hf] = __builtin_nontemporal_load((const GAS u32x4*)(AAg + off + 8 * hf)); } }
    for (int g = 0; g < SEQ / (16 * CH_NS); ++g) {
        {
            LAS unsigned char* sl = L + w * CH_SLOT;
            LAS bf16* BT = (LAS bf16*)(L + CH_YBUF + w * 4608); LAS bf16* KT = BT + 16 * CH_RS;
            float rr[16], kk_[16], lw[16], al[16];
#pragma unroll
            for (int hf = 0; hf < 2; ++hf) {
                const u32x4 q0 = raw[0][hf], q1 = raw[1][hf], q2 = raw[2][hf], q3 = raw[3][hf], q4 = raw[4][hf];
                rr[8 * hf + 0] = bf_lo(q0.x); rr[8 * hf + 1] = bf_hi(q0.x); rr[8 * hf + 2] = bf_lo(q0.y); rr[8 * hf + 3] = bf_hi(q0.y); rr[8 * hf + 4] = bf_lo(q0.z); rr[8 * hf + 5] = bf_hi(q0.z); rr[8 * hf + 6] = bf_lo(q0.w); rr[8 * hf + 7] = bf_hi(q0.w);
                kk_[8 * hf + 0] = bf_lo(q1.x); kk_[8 * hf + 1] = bf_hi(q1.x); kk_[8 * hf + 2] = bf_lo(q1.y); kk_[8 * hf + 3] = bf_hi(q1.y); kk_[8 * hf + 4] = bf_lo(q1.z); kk_[8 * hf + 5] = bf_hi(q1.z); kk_[8 * hf + 6] = bf_lo(q1.w); kk_[8 * hf + 7] = bf_hi(q1.w);
                lw[8 * hf + 0] = bf_lo(q3.x); lw[8 * hf + 1] = bf_hi(q3.x); lw[8 * hf + 2] = bf_lo(q3.y); lw[8 * hf + 3] = bf_hi(q3.y); lw[8 * hf + 4] = bf_lo(q3.z); lw[8 * hf + 5] = bf_hi(q3.z); lw[8 * hf + 6] = bf_lo(q3.w); lw[8 * hf + 7] = bf_hi(q3.w);
                al[8 * hf + 0] = bf_lo(q4.x); al[8 * hf + 1] = bf_hi(q4.x); al[8 * hf + 2] = bf_lo(q4.y); al[8 * hf + 3] = bf_hi(q4.y); al[8 * hf + 4] = bf_lo(q4.z); al[8 * hf + 5] = bf_hi(q4.z); al[8 * hf + 6] = bf_lo(q4.w); al[8 * hf + 7] = bf_hi(q4.w);
                *(LAS u32x4*)(sl + CH_OFF_VV + (t * CH_RS + 16 * chq + 8 * hf) * 2) = q2;
            }
            if (g + 1 < SEQ / (16 * CH_NS)) { const size_t off = (tbase + (size_t)(g + 1) * 128 + 16 * w + t) * D + ch0;
    #pragma unroll
                for (int hf = 0; hf < 2; ++hf) { raw[0][hf] = __builtin_nontemporal_load((const GAS u32x4*)(Rg + off + 8 * hf)); raw[1][hf] = __builtin_nontemporal_load((const GAS u32x4*)(Kg + off + 8 * hf)); raw[2][hf] = __builtin_nontemporal_load((const GAS u32x4*)(Vg + off + 8 * hf));
                    raw[3][hf] = __builtin_nontemporal_load((const GAS u32x4*)(LWg + off + 8 * hf)); raw[4][hf] = __builtin_nontemporal_load((const GAS u32x4*)(AAg + off + 8 * hf)); } }
            float ssq = 0.f, rks = 0.f; float av[16], bv[16];
#pragma unroll
            for (int c4 = 0; c4 < 4; ++c4) {
                const LAS float* par = (const LAS float*)(L + CH_PAR) + 16 * chq + 4 * c4;
                const f32x4 kkp = *(const LAS f32x4*)(par), kap = *(const LAS f32x4*)(par + 64), rkp = *(const LAS f32x4*)(par + 128);
#pragma unroll
                for (int i = 0; i < 4; ++i) { const int c = 4 * c4 + i; const float kr = kk_[c] * kkp[i]; ssq += kr * kr; av[c] = kr;
                    const float kp = kk_[c] * (1.0f + (al[c] - 1.0f) * kap[i]); rks += rr[c] * kp * rkp[i]; kk_[c] = kp; }
            }
            ssq += __shfl_xor(ssq, 16); ssq += __shfl_xor(ssq, 32); rks += __shfl_xor(rks, 16); rks += __shfl_xor(rks, 32);
            const float inv = __builtin_amdgcn_rsqf(fmaxf(ssq, 1e-24f));
#pragma unroll
            for (int c = 0; c < 16; ++c) { const float kkn = av[c] * inv; av[c] = -kkn; bv[c] = kkn * al[c]; }
            if (chq == 0) *(LAS float*)(sl + CH_OFF_RK + 4 * t) = rks;
            const int pbase = 32 * (chq >> 1) + 4 * (chq & 1);
            f32x4 gcs[4];
#pragma unroll
            for (int c4 = 0; c4 < 4; ++c4) {
                float at4[4], rt4[4], bt4[4], kt4[4], bb4[4], kb4[4];
#pragma unroll
                for (int i = 0; i < 4; ++i) { const int c = 4 * c4 + i;
                    float x = lw[c]; ROW_SHR_ADD(x, 0x111); ROW_SHR_ADD(x, 0x112); ROW_SHR_ADD(x, 0x114); ROW_SHR_ADD(x, 0x118);
                    const float e1 = __builtin_amdgcn_exp2f(x), i1 = __builtin_amdgcn_exp2f(-x);
                    const float em1 = __builtin_bit_cast(float, __builtin_amdgcn_update_dpp(0x3f800000, __builtin_bit_cast(int, e1), 0x111, 0xf, 0xf, false));
                    const float eC = i1 * __builtin_bit_cast(float, __builtin_amdgcn_update_dpp(0, __builtin_bit_cast(int, e1), 0x15F, 0xf, 0xf, false));
                    at4[i] = em1 * av[c]; rt4[i] = e1 * rr[c]; bt4[i] = bv[c] * i1; kt4[i] = kk_[c] * i1; bb4[i] = bv[c] * eC; kb4[i] = kk_[c] * eC;
                    gcs[c4][i] = e1; }
                *(LAS u32x2*)(sl + CH_OFF_AT + (t * CH_RS + pbase + 8 * c4) * 2) = (u32x2){pk2(at4[0], at4[1]), pk2(at4[2], at4[3])};
                *(LAS u32x2*)(sl + CH_OFF_RT + (t * CH_RS + pbase + 8 * c4) * 2) = (u32x2){pk2(rt4[0], rt4[1]), pk2(rt4[2], rt4[3])};
                *(LAS u32x2*)((LAS unsigned char*)BT + (t * CH_RS + pbase + 8 * c4) * 2) = (u32x2){pk2(bt4[0], bt4[1]), pk2(bt4[2], bt4[3])};
                *(LAS u32x2*)((LAS unsigned char*)KT + (t * CH_RS + pbase + 8 * c4) * 2) = (u32x2){pk2(kt4[0], kt4[1]), pk2(kt4[2], kt4[3])};
                *(LAS u32x2*)(sl + CH_OFF_BB + (t * CH_RS + 16 * chq + 4 * c4) * 2) = (u32x2){pk2(bb4[0], bb4[1]), pk2(bb4[2], bb4[3])};
                *(LAS u32x2*)(sl + CH_OFF_KB + (t * CH_RS + 16 * chq + 4 * c4) * 2) = (u32x2){pk2(kb4[0], kb4[1]), pk2(kb4[2], kb4[3])};
            }
            if (t == 15) {
#pragma unroll
                for (int c4 = 0; c4 < 4; ++c4) *(LAS f32x4*)(sl + CH_OFF_GC + 4 * (16 * chq + 4 * c4)) = gcs[c4]; }
            asm volatile("s_waitcnt lgkmcnt(0)" ::: "memory");
            if (!(PARTS & 16)) {
                const LAS bf16* pa = (const LAS bf16*)(sl + CH_OFF_AT) + n * CH_RS + 8 * hq; const LAS bf16* pr = (const LAS bf16*)(sl + CH_OFF_RT) + n * CH_RS + 8 * hq;
                const LAS bf16* pb = BT + n * CH_RS + 8 * hq; const LAS bf16* pk = KT + n * CH_RS + 8 * hq;
                const bf16x8 fa0 = *(const LAS bf16x8*)pa, fa1 = *(const LAS bf16x8*)(pa + 32), fr0 = *(const LAS bf16x8*)pr, fr1 = *(const LAS bf16x8*)(pr + 32);
                const bf16x8 fb0 = *(const LAS bf16x8*)pb, fb1 = *(const LAS bf16x8*)(pb + 32), fk0 = *(const LAS bf16x8*)pk, fk1 = *(const LAS bf16x8*)(pk + 32);
                const f32x4 z4 = (f32x4){0.f, 0.f, 0.f, 0.f};
                f32x4 mba = __builtin_amdgcn_mfma_f32_16x16x32_bf16(fb0, fa0, z4, 0, 0, 0); mba = __builtin_amdgcn_mfma_f32_16x16x32_bf16(fb1, fa1, mba, 0, 0, 0);
                f32x4 mka = __builtin_amdgcn_mfma_f32_16x16x32_bf16(fk0, fa0, z4, 0, 0, 0); mka = __builtin_amdgcn_mfma_f32_16x16x32_bf16(fk1, fa1, mka, 0, 0, 0);
                f32x4 nbr = __builtin_amdgcn_mfma_f32_16x16x32_bf16(fb0, fr0, z4, 0, 0, 0); nbr = __builtin_amdgcn_mfma_f32_16x16x32_bf16(fb1, fr1, nbr, 0, 0, 0);
                f32x4 nkr = __builtin_amdgcn_mfma_f32_16x16x32_bf16(fk0, fr0, z4, 0, 0, 0); nkr = __builtin_amdgcn_mfma_f32_16x16x32_bf16(fk1, fr1, nkr, 0, 0, 0);
                float m2[4], m3[4], m4[4]; f32x4 Mb, Ma;
                f32x4 mta = __builtin_amdgcn_mfma_f32_16x16x32_bf16(fa0, fb0, z4, 0, 0, 0); mta = __builtin_amdgcn_mfma_f32_16x16x32_bf16(fa1, fb1, mta, 0, 0, 0);
#pragma unroll
                for (int r = 0; r < 4; ++r) { const int sI = 4 * hq + r; const bool lt = sI < n, le = sI <= n;
                    Mb[r] = lt ? mba[r] : 0.f; Ma[r] = n < sI ? mta[r] : 0.f; m2[r] = lt ? mka[r] : 0.f; m3[r] = le ? nbr[r] : 0.f; m4[r] = le ? nkr[r] : 0.f; }
                *(LAS u32x2*)(sl + CH_OFF_MKA + lane * 8) = (u32x2){pk2(m2[0], m2[1]), pk2(m2[2], m2[3])};
                *(LAS u32x2*)(sl + CH_OFF_NBR + lane * 8) = (u32x2){pk2(m3[0], m3[1]), pk2(m3[2], m3[3])};
                *(LAS u32x2*)(sl + CH_OFF_NKR + lane * 8) = (u32x2){pk2(m4[0], m4[1]), pk2(m4[2], m4[3])};
                typedef short v4s __attribute__((ext_vector_type(4)));
#define PK4(v) __builtin_bit_cast(v4s, (u32x2){pk2((v)[0], (v)[1]), pk2((v)[2], (v)[3])})
#define MM16(A, B, C) __builtin_amdgcn_mfma_f32_16x16x16bf16_1k(A, B, C, 0, 0, 0)
                f32x4 idm;
#pragma unroll
                for (int r = 0; r < 4; ++r) idm[r] = (4 * hq + r == n) ? 1.0f : 0.0f;
                const v4s Mb16 = PK4(Mb), Ma16 = PK4(Ma);
                const f32x4 P1b = Mb + idm, P1a = Ma + idm; const v4s P1a16 = PK4(P1a);
                const f32x4 M2b = MM16(Ma16, Mb16, z4), M2a = MM16(Mb16, Ma16, z4); const v4s M2b16 = PK4(M2b), M2a16 = PK4(M2a);
                const f32x4 P2b = MM16(P1a16, M2b16, P1b), P2a = MM16(M2b16, P1a16, P1a); const v4s P2a16 = PK4(P2a);
                const f32x4 M4b = MM16(M2a16, M2b16, z4), M4a = MM16(M2b16, M2a16, z4); const v4s M4b16 = PK4(M4b), M4a16 = PK4(M4a);
                const f32x4 P3b = MM16(P2a16, M4b16, P2b), P3a = MM16(M4b16, P2a16, P2a);
                const f32x4 M8b = MM16(M4a16, M4b16, z4);
                const f32x4 Tb = MM16(PK4(P3a), PK4(M8b), P3b);
                *(LAS u32x2*)(sl + CH_OFF_TT + lane * 8) = (u32x2){pk2(Tb[0], Tb[1]), pk2(Tb[2], Tb[3])};
#undef PK4
#undef MM16
            }
        }
        __syncthreads();
        u32x2 graw4[4];
        { const int jj = F.tid & 15;
#pragma unroll
          for (int ps = 0; ps < 4; ++ps) graw4[ps] = *(const GAS u32x2*)(GGg + (tbase + (size_t)g * 128 + (F.tid >> 4) + 32 * ps) * D + h * 64 + 4 * jj); }
        if (w < 4 && (PARTS & 2)) {
            const int q = (lane & 15) >> 2, p = lane & 3;
            const int m16 = ((4 * hq + q) * 16 + 4 * p) * 2;
            const int m72 = ((4 * hq + q) * CH_RS + 4 * p) * 2;
            typedef short v4s __attribute__((ext_vector_type(4))); typedef LAS v4s* lv4;
#define CH_LOAD(CS, MKA, TTF, NBR, NKR, VF, BB0, BB1, BB2, BB3, KB0, KB1, KB2, KB3) do { LAS unsigned char* _sl = L + (CS) * CH_SLOT; \
            MKA = *(const LAS v4s*)(_sl + CH_OFF_MKA + lane * 8); TTF = *(const LAS v4s*)(_sl + CH_OFF_TT + lane * 8); \
            NBR = *(const LAS v4s*)(_sl + CH_OFF_NBR + lane * 8); NKR = *(const LAS v4s*)(_sl + CH_OFF_NKR + lane * 8); \
            VF = __builtin_amdgcn_ds_read_tr16_b64_v4i16((lv4)(_sl + CH_OFF_VV + m72 + 32 * w)); \
            BB0 = __builtin_amdgcn_ds_read_tr16_b64_v4i16((lv4)(_sl + CH_OFF_BB + m72)); BB1 = __builtin_amdgcn_ds_read_tr16_b64_v4i16((lv4)(_sl + CH_OFF_BB + m72 + 32)); \
            BB2 = __builtin_amdgcn_ds_read_tr16_b64_v4i16((lv4)(_sl + CH_OFF_BB + m72 + 64)); BB3 = __builtin_amdgcn_ds_read_tr16_b64_v4i16((lv4)(_sl + CH_OFF_BB + m72 + 96)); \
            KB0 = __builtin_amdgcn_ds_read_tr16_b64_v4i16((lv4)(_sl + CH_OFF_KB + m72)); KB1 = __builtin_amdgcn_ds_read_tr16_b64_v4i16((lv4)(_sl + CH_OFF_KB + m72 + 32)); \
            KB2 = __builtin_amdgcn_ds_read_tr16_b64_v4i16((lv4)(_sl + CH_OFF_KB + m72 + 64)); KB3 = __builtin_amdgcn_ds_read_tr16_b64_v4i16((lv4)(_sl + CH_OFF_KB + m72 + 96)); } while (0)
            v4s mka, ttv, nbr, nkr, vfv, bb0, bb1, bb2, bb3, kb0, kb1, kb2, kb3;
            CH_LOAD(0, mka, ttv, nbr, nkr, vfv, bb0, bb1, bb2, bb3, kb0, kb1, kb2, kb3);
#pragma unroll 1
            for (int cs = 0; cs < CH_NS; ++cs) {
                v4s nmka, nttv, nnbr, nnkr, nvfv, nbb0, nbb1, nbb2, nbb3, nkb0, nkb1, nkb2, nkb3;
                const LAS bf16* pa = (const LAS bf16*)(L + cs * CH_SLOT + CH_OFF_AT) + n * CH_RS + 8 * hq; const LAS bf16* pr = (const LAS bf16*)(L + cs * CH_SLOT + CH_OFF_RT) + n * CH_RS + 8 * hq;
                const bf16x8 at0 = *(const LAS bf16x8*)pa, at1 = *(const LAS bf16x8*)(pa + 32), rt0 = *(const LAS bf16x8*)pr, rt1 = *(const LAS bf16x8*)(pr + 32);
                { const int csn = cs + 1 < CH_NS ? cs + 1 : cs;
                  CH_LOAD(csn, nmka, nttv, nnbr, nnkr, nvfv, nbb0, nbb1, nbb2, nbb3, nkb0, nkb1, nkb2, nkb3); }
                f32x4 gcv[4];
#pragma unroll
                for (int T4 = 0; T4 < 4; ++T4) gcv[T4] = *(const LAS f32x4*)(L + cs * CH_SLOT + CH_OFF_GC + (16 * T4 + 4 * hq) * 4);
                u32x4 b0w, b1w;
                b0w.x = pk2(ST[0][0], ST[0][1]); b0w.y = pk2(ST[0][2], ST[0][3]); b0w.z = pk2(ST[1][0], ST[1][1]); b0w.w = pk2(ST[1][2], ST[1][3]);
                b1w.x = pk2(ST[2][0], ST[2][1]); b1w.y = pk2(ST[2][2], ST[2][3]); b1w.z = pk2(ST[3][0], ST[3][1]); b1w.w = pk2(ST[3][2], ST[3][3]);
                const bf16x8 bop0 = __builtin_bit_cast(bf16x8, b0w), bop1 = __builtin_bit_cast(bf16x8, b1w);
                const u32x2 mkaf = __builtin_bit_cast(u32x2, mka), ttf = __builtin_bit_cast(u32x2, ttv), nbrf = __builtin_bit_cast(u32x2, nbr), nkrf = __builtin_bit_cast(u32x2, nkr), vf = __builtin_bit_cast(u32x2, vfv);
                const u32x2 bbf[4] = {__builtin_bit_cast(u32x2, bb0), __builtin_bit_cast(u32x2, bb1), __builtin_bit_cast(u32x2, bb2), __builtin_bit_cast(u32x2, bb3)};
                const u32x2 kbf[4] = {__builtin_bit_cast(u32x2, kb0), __builtin_bit_cast(u32x2, kb1), __builtin_bit_cast(u32x2, kb2), __builtin_bit_cast(u32x2, kb3)};
                const f32x4 z4 = (f32x4){0.f, 0.f, 0.f, 0.f};
                f32x4 XT = __builtin_amdgcn_mfma_f32_16x16x32_bf16(at0, bop0, z4, 0, 0, 0); XT = __builtin_amdgcn_mfma_f32_16x16x32_bf16(at1, bop1, XT, 0, 0, 0);
                XT = __builtin_amdgcn_mfma_f32_16x16x32_bf16(__builtin_bit_cast(bf16x8, (u32x4){mkaf.x, mkaf.y, 0u, 0u}), __builtin_bit_cast(bf16x8, (u32x4){vf.x, vf.y, 0u, 0u}), XT, 0, 0, 0);
                const f32x4 UT = __builtin_amdgcn_mfma_f32_16x16x32_bf16(__builtin_bit_cast(bf16x8, (u32x4){ttf.x, ttf.y, 0u, 0u}), __builtin_bit_cast(bf16x8, (u32x4){pk2(XT[0], XT[1]), pk2(XT[2], XT[3]), 0u, 0u}), z4, 0, 0, 0);
                const bf16x8 uvop = __builtin_bit_cast(bf16x8, (u32x4){pk2(UT[0], UT[1]), pk2(UT[2], UT[3]), vf.x, vf.y});
                f32x4 YT = __builtin_amdgcn_mfma_f32_16x16x32_bf16(rt0, bop0, z4, 0, 0, 0); YT = __builtin_amdgcn_mfma_f32_16x16x32_bf16(rt1, bop1, YT, 0, 0, 0);
                YT = __builtin_amdgcn_mfma_f32_16x16x32_bf16(__builtin_bit_cast(bf16x8, (u32x4){nbrf.x, nbrf.y, nkrf.x, nkrf.y}), uvop, YT, 0, 0, 0);
#pragma unroll
                for (int r = 0; r < 4; ++r) ybuf[(cs * 16 + 4 * hq + r) * 64 + 16 * w + n] = YT[r];
#pragma unroll
                for (int T4 = 0; T4 < 4; ++T4)
                    ST[T4] = __builtin_amdgcn_mfma_f32_16x16x32_bf16(__builtin_bit_cast(bf16x8, (u32x4){bbf[T4].x, bbf[T4].y, kbf[T4].x, kbf[T4].y}), uvop, ST[T4] * gcv[T4], 0, 0, 0);
                mka = nmka; ttv = nttv; nbr = nnbr; nkr = nnkr; vfv = nvfv;
                bb0 = nbb0; bb1 = nbb1; bb2 = nbb2; bb3 = nbb3; kb0 = nkb0; kb1 = nkb1; kb2 = nkb2; kb3 = nkb3;
            }
#undef CH_LOAD
        }
        __syncthreads();
        if (PARTS & 4) {
            const int j = F.tid & 15, ch = h * 64 + 4 * j;
#pragma unroll
            for (int ps = 0; ps < 4; ++ps) {
                const int tk = (F.tid >> 4) + 32 * ps, cs = tk >> 4, tl = tk & 15;
                const size_t gofs = (tbase + (size_t)g * 128 + tk) * D + ch;
                const u32x2 graw = graw4[ps];
                const f32x4 y4 = *(const LAS f32x4*)(ybuf + tk * 64 + 4 * j);
                const float mean = row16_sum((y4.x + y4.y) + (y4.z + y4.w)) * (1.0f / 64.0f);
                const f32x4 d4 = y4 - mean;
                const float var = row16_sum((d4.x * d4.x + d4.y * d4.y) + (d4.z * d4.z + d4.w * d4.w)) * (1.0f / 64.0f);
                const float rs = __builtin_amdgcn_rsqf(var + GN_EPS);
                const u32x2 vraw = *(const LAS u32x2*)(L + cs * CH_SLOT + CH_OFF_VV + (tl * CH_RS + 4 * j) * 2);
                const float rk = *(const LAS float*)(L + cs * CH_SLOT + CH_OFF_RK + 4 * tl);
                const f32x4 vt = (f32x4){bf_lo(vraw.x), bf_hi(vraw.x), bf_lo(vraw.y), bf_hi(vraw.y)}, g4 = (f32x4){bf_lo(graw.x), bf_hi(graw.x), bf_lo(graw.y), bf_hi(graw.y)};
                const f32x4 o = (d4 * rs * lnw + lnb + rk * vt) * g4;
                u32x2 wv; wv.x = pk2(o.x, o.y); wv.y = pk2(o.z, o.w);
                *(GAS u32x2*)(Z + gofs) = wv;
            }
        }
        __syncthreads();
    }
}

constexpr int AT_KS = 72;
struct AtUnit { int b, g, h, rho, jb, dil; };
__device__ __forceinline__ AtUnit at_decode(int u) { AtUnit a; const int sub = u & 15; int r = u >> 4; a.h = r & 7; r >>= 3; a.g = r % 3; a.b = r / 3;
    a.dil = a.g == 0 ? 1 : (a.g == 1 ? 4 : 16); a.rho = a.g == 0 ? 0 : (a.g == 1 ? (sub & 3) : sub); a.jb = a.g == 0 ? sub : (a.g == 1 ? (sub >> 2) : 0); return a; }
__device__ __forceinline__ void at_issue(int u, int tid, int w, int lane, const bf16* Q, const bf16* KK, const bf16* VV, u32x4 (&kr)[4], u32x4 (&vr)[4], u32x4 (&qr)[2]) {
    const int hq = lane >> 4, n = lane & 15;
    const AtUnit at = at_decode(u);
    const size_t cb = ((size_t)((at.b * 3 + at.g) * 8 + at.h) * 2048 + (size_t)at.rho * (2048 >> (2 * at.g))) * 64;
#pragma unroll
    for (int i = 0; i < 4; ++i) {
        const int p = tid + 512 * i, key = p >> 3, dp = p & 7, jp = at.jb * 128 - 128 + key;
        kr[i] = (u32x4){0u, 0u, 0u, 0u};
        if (jp >= 0) kr[i] = *(const GAS u32x4*)(KK + cb + (size_t)jp * 64 + dp * 8);
    }
#pragma unroll
    for (int i = 0; i < 4; ++i) {
        const int p = tid + 512 * i, key = p >> 3, dp = p & 7, jp = at.jb * 128 - 128 + key;
        vr[i] = (u32x4){0u, 0u, 0u, 0u};
        if (jp >= 0) vr[i] = *(const GAS u32x4*)(VV + cb + (size_t)jp * 64 + dp * 8);
    }
    const int jqq = at.jb * 128 + 16 * w + n;
#pragma unroll
    for (int s2 = 0; s2 < 2; ++s2) qr[s2] = *(const GAS u32x4*)(Q + cb + (size_t)jqq * 64 + 32 * s2 + 8 * hq);
}
__device__ __forceinline__ void p8_attn_mfma(const Args& a, Frame& F) {
    typedef short bf16x8 __attribute__((ext_vector_type(8)));
    unsigned char* ws = a.ws;
    const bf16 *Q = (const bf16*)(ws + WS_Q), *KK = (const bf16*)(ws + WS_KK), *VV = (const bf16*)(ws + WS_VV); bf16* OG = (bf16*)(ws + WS_OG); float* LSE = (float*)(ws + WS_LSE);
    LAS bf16* Ks = (LAS bf16*)F.lds; LAS bf16* Vt = Ks + 256 * AT_KS;
    const int lane = F.lane, w = F.wave, hq = lane >> 4, n = lane & 15;
    const int NU = NB * 3 * 8 * 16;
    u32x4 kr[4], vr[4], qr[2];
    int u = (F.G % 8 == 0) ? (F.bid % 8) * (F.G / 8) + F.bid / 8 : F.bid;
    if (u < NU) at_issue(u, F.tid, w, lane, Q, KK, VV, kr, vr, qr);
    for (; u < NU; u += F.G) {
        const AtUnit at = at_decode(u);
#pragma unroll
        for (int i = 0; i < 4; ++i) { const int p = F.tid + 512 * i, key = p >> 3, dp = p & 7; *(LAS u32x4*)(Ks + key * AT_KS + dp * 8) = kr[i]; }
#pragma unroll
        for (int i = 0; i < 4; ++i) { const int p = F.tid + 512 * i, key = p >> 3, dp = p & 7; *(LAS u32x4*)(Vt + key * AT_KS + dp * 8) = vr[i]; }
        const bf16x8 qf0 = __builtin_bit_cast(bf16x8, qr[0]), qf1 = __builtin_bit_cast(bf16x8, qr[1]);
        __syncthreads();
        if (u + F.G < NU) at_issue(u + F.G, F.tid, w, lane, Q, KK, VV, kr, vr, qr);
        const int ilo = at.jb == 0 ? (8 - w) : 0;
        f32x4 sc[9];
#pragma unroll
        for (int i = 0; i < 9; ++i) { sc[i] = (f32x4){0.f, 0.f, 0.f, 0.f};
            if (i >= ilo) {
                const LAS bf16* kp = Ks + (16 * (w + i) + n) * AT_KS + 8 * hq;
                const bf16x8 k0 = *(const LAS bf16x8*)(kp), k1 = *(const LAS bf16x8*)(kp + 32);
                sc[i] = __builtin_amdgcn_mfma_f32_16x16x32_bf16(k0, qf0, sc[i], 0, 0, 0);
                sc[i] = __builtin_amdgcn_mfma_f32_16x16x32_bf16(k1, qf1, sc[i], 0, 0, 0); } }
        const float slope = exp2f(-8.0f * (float)(at.g * 8 + at.h + 1) / 24.0f);
        const float c1 = 0.125f * 1.4426950408889634f, c2 = slope * (float)at.dil * 1.4426950408889634f;
        int nq = n; asm volatile("" : "+v"(nq));
        const int jq = 16 * w + nq;
        const int dq = nq - 4 * hq;
        const float cj = c2 * (float)(dq + 128), c2r1 = c2, c2r2 = 2.f * c2, c2r3 = 3.f * c2;
        float mx = -1e30f;
#pragma unroll
        for (int i = 0; i < 9; ++i) {
            const float b0 = (i >= ilo) ? (c2 * (float)(16 * i) - cj) : -1e30f;
            float v0 = sc[i][0] * c1 + b0, v1 = sc[i][1] * c1 + (b0 + c2r1), v2 = sc[i][2] * c1 + (b0 + c2r2), v3 = sc[i][3] * c1 + (b0 + c2r3);
            if (i == 0) { v0 = dq <= 0 ? v0 : -1e30f; v1 = dq <= 1 ? v1 : -1e30f; v2 = dq <= 2 ? v2 : -1e30f; v3 = dq <= 3 ? v3 : -1e30f; }
            if (i == 8) { v0 = dq >= 0 ? v0 : -1e30f; v1 = dq >= 1 ? v1 : -1e30f; v2 = dq >= 2 ? v2 : -1e30f; v3 = dq >= 3 ? v3 : -1e30f; }
            sc[i][0] = v0; sc[i][1] = v1; sc[i][2] = v2; sc[i][3] = v3;
            mx = fmaxf(mx, fmaxf(fmaxf(v0, v1), fmaxf(v2, v3)));
        }
        mx = fmaxf(mx, __shfl_xor(mx, 16)); mx = fmaxf(mx, __shfl_xor(mx, 32));
        float l = 0.f;
#pragma unroll
        for (int i = 0; i < 9; ++i)
#pragma unroll
            for (int r = 0; r < 4; ++r) { const float p = __builtin_amdgcn_exp2f(sc[i][r] - mx); sc[i][r] = p; l += p; }
        l += __shfl_xor(l, 16); l += __shfl_xor(l, 32);
        const int vboff = (4 * hq + ((lane & 15) >> 2)) * (AT_KS * 2) + 8 * (lane & 3);
        typedef short v4s __attribute__((ext_vector_type(4))); typedef LAS v4s* lv4;
        f32x4 o[4];
#pragma unroll
        for (int dt = 0; dt < 4; ++dt) o[dt] = (f32x4){0.f, 0.f, 0.f, 0.f};
#pragma unroll
        for (int ks = 0; ks < 4; ++ks) {
            if (2 * ks + 1 >= ilo) {
                u32x4 pw; pw.x = pk2(sc[2 * ks][0], sc[2 * ks][1]); pw.y = pk2(sc[2 * ks][2], sc[2 * ks][3]); pw.z = pk2(sc[2 * ks + 1][0], sc[2 * ks + 1][1]); pw.w = pk2(sc[2 * ks + 1][2], sc[2 * ks + 1][3]);
                const bf16x8 pb = __builtin_bit_cast(bf16x8, pw);
                LAS unsigned char* va = (LAS unsigned char*)Vt + vboff + (16 * (w + 2 * ks)) * (AT_KS * 2);
                u32x2 a0[4], a1[4];
#pragma unroll
                for (int dt = 0; dt < 4; ++dt) { a0[dt] = __builtin_bit_cast(u32x2, __builtin_amdgcn_ds_read_tr16_b64_v4i16((lv4)(va + 32 * dt))); a1[dt] = __builtin_bit_cast(u32x2, __builtin_amdgcn_ds_read_tr16_b64_v4i16((lv4)(va + 2304 + 32 * dt))); }
#pragma unroll
                for (int dt = 0; dt < 4; ++dt) {
                    const bf16x8 av = __builtin_bit_cast(bf16x8, (u32x4){a0[dt].x, a0[dt].y, a1[dt].x, a1[dt].y});
                    o[dt] = __builtin_amdgcn_mfma_f32_16x16x32_bf16(av, pb, o[dt], 0, 0, 0); } } }
        {
            const u32x2 pw = (u32x2){pk2(sc[8][0], sc[8][1]), pk2(sc[8][2], sc[8][3])};
            LAS unsigned char* va = (LAS unsigned char*)Vt + vboff + (16 * (w + 8)) * (AT_KS * 2);
            v4s a8[4];
#pragma unroll
            for (int dt = 0; dt < 4; ++dt) a8[dt] = __builtin_amdgcn_ds_read_tr16_b64_v4i16((lv4)(va + 32 * dt));
#pragma unroll
            for (int dt = 0; dt < 4; ++dt) o[dt] = __builtin_amdgcn_mfma_f32_16x16x16bf16_1k(a8[dt], __builtin_bit_cast(v4s, pw), o[dt], 0, 0, 0);
        }
        const float inv = 1.0f / l; const int tq = at.rho + at.dil * (at.jb * 128 + jq); const size_t tg = (size_t)at.b * SEQ + tq;
        bf16* op = OG + ((size_t)at.g * T + tg) * 512 + at.h * 64 + 4 * hq;
#pragma unroll
        for (int dt = 0; dt < 4; ++dt) { u32x2 wv; wv.x = pk2(o[dt][0] * inv, o[dt][1] * inv); wv.y = pk2(o[dt][2] * inv, o[dt][3] * inv); *(GAS u32x2*)(op + 16 * dt) = wv; }
        if (hq == 0) LSE[((size_t)at.g * T + tg) * 8 + at.h] = (mx + __builtin_amdgcn_logf(l)) * 0.6931471805599453f;
        __syncthreads();
    }
}
__device__ __forceinline__ void p9_merge(const Args& a, Frame& F) {
    unsigned char* ws = a.ws; const bf16* OG = (const bf16*)(ws + WS_OG); const float* LSE = (const float*)(ws + WS_LSE); bf16* OM = (bf16*)(ws + WS_OM);
    const int gw = F.bid * NWAVES + F.wave, NGW = F.G * NWAVES, hh = F.lane >> 3;
    for (int t = gw; t < T; t += NGW) {
        const float l0 = LSE[((size_t)0 * T + t) * 8 + hh], l1 = LSE[((size_t)1 * T + t) * 8 + hh], l2 = LSE[((size_t)2 * T + t) * 8 + hh];
        const float m = fmaxf(l0, fmaxf(l1, l2)); const float e0 = __expf(l0 - m), e1 = __expf(l1 - m), e2 = __expf(l2 - m); const float inv = 1.0f / (e0 + e1 + e2);
        const float w0 = e0 * inv, w1 = e1 * inv, w2 = e2 * inv;
        const u32x4 a0 = __builtin_nontemporal_load((const GAS u32x4*)(OG + ((size_t)0 * T + t) * 512 + 8 * F.lane)), a1 = __builtin_nontemporal_load((const GAS u32x4*)(OG + ((size_t)1 * T + t) * 512 + 8 * F.lane)), a2 = __builtin_nontemporal_load((const GAS u32x4*)(OG + ((size_t)2 * T + t) * 512 + 8 * F.lane));
        u32x4 r;
        r.x = pk2(w0 * bf_lo(a0.x) + w1 * bf_lo(a1.x) + w2 * bf_lo(a2.x), w0 * bf_hi(a0.x) + w1 * bf_hi(a1.x) + w2 * bf_hi(a2.x));
        r.y = pk2(w0 * bf_lo(a0.y) + w1 * bf_lo(a1.y) + w2 * bf_lo(a2.y), w0 * bf_hi(a0.y) + w1 * bf_hi(a1.y) + w2 * bf_hi(a2.y));
        r.z = pk2(w0 * bf_lo(a0.z) + w1 * bf_lo(a1.z) + w2 * bf_lo(a2.z), w0 * bf_hi(a0.z) + w1 * bf_hi(a1.z) + w2 * bf_hi(a2.z));
        r.w = pk2(w0 * bf_lo(a0.w) + w1 * bf_lo(a1.w) + w2 * bf_lo(a2.w), w0 * bf_hi(a0.w) + w1 * bf_hi(a1.w) + w2 * bf_hi(a2.w));
        *(GAS u32x4*)(OM + (size_t)t * 512 + 8 * F.lane) = r;
    }
}

__device__ __forceinline__ void p10_router(const Args& a, Frame& F) {
    unsigned char* ws = a.ws;
    const bf16* x3 = (const bf16*)(ws + WS_X3B); const unsigned long long* ss3 = (const unsigned long long*)(ws + CTL_SS3);
    unsigned* gcnt = (unsigned*)(ws + CTL_CNT); float* tgate = (float*)(ws + WS_TGATE); int* tokep = (int*)(ws + WS_TOKEP); unsigned char* xg = ws + WS_XG;
    LAS float* rw = (LAS float*)F.lds;
    LAS int* lcnt = (LAS int*)(rw + 8192);
    LAS int* lbase = lcnt + 8;
    LAS int* te = lbase + 8;
    LAS int* tp = te + 128;
    LAS float* tgt = (LAS float*)(tp + 128);
    const float* g = a.in[I_NG] + 3 * D; const float* rt = a.in[I_ROUTER]; const float* rb = a.in[I_RBIAS];
    for (int i = F.tid; i < 8192; i += 512) { const int k = i >> 3; rw[(((k & 3) << 8) + (k >> 2)) * 8 + (i & 7)] = rt[i] * g[k]; }
    for (int cb = F.bid; cb < T / 64; cb += F.G) {
        if (F.tid < 8) lcnt[F.tid] = 0;
        __syncthreads();
        {
            float v[64];
#pragma unroll
            for (int i = 0; i < 64; ++i) v[i] = 0.f;
            const bf16* xrow = x3 + (size_t)(cb * 64 + F.wave * 8) * D + 4 * F.lane;
#pragma unroll
            for (int jq = 0; jq < 4; ++jq) {
                u32x2 xw[8];
#pragma unroll
                for (int tt = 0; tt < 8; ++tt) xw[tt] = *(const GAS u32x2*)(xrow + (size_t)tt * D + 256 * jq);
#pragma unroll
                for (int i = 0; i < 4; ++i) { const LAS float* wp = rw + ((i << 8) + F.lane + 64 * jq) * 8; const f32x4 w0 = *(const LAS f32x4*)(wp), w1 = *(const LAS f32x4*)(wp + 4);
#pragma unroll
                    for (int tt = 0; tt < 8; ++tt) { const unsigned xu = (i < 2) ? xw[tt].x : xw[tt].y; const float xv = (i & 1) ? bf_hi(xu) : bf_lo(xu);
                        v[tt * 8 + 0] += xv * w0.x; v[tt * 8 + 1] += xv * w0.y; v[tt * 8 + 2] += xv * w0.z; v[tt * 8 + 3] += xv * w0.w;
                        v[tt * 8 + 4] += xv * w1.x; v[tt * 8 + 5] += xv * w1.y; v[tt * 8 + 6] += xv * w1.z; v[tt * 8 + 7] += xv * w1.w; } }
            }
#pragma unroll
            for (int d = 32, n = 64; d >= 1; d >>= 1, n >>= 1) { const bool up = (F.lane & d) != 0;
#pragma unroll
                for (int i = 0; i < n / 2; ++i) { const float send = up ? v[i] : v[i + n / 2], keep = up ? v[i + n / 2] : v[i]; v[i] = keep + __shfl_xor(send, d); } }
            const int tt = F.lane >> 3, e = F.lane & 7, tl = F.wave * 8 + tt, tok = cb * 64 + tl;
            const float lg = v[0] * rstd_from_ss(ss3, tok) + rb[e];
            float v0 = lg; int e0 = e;
#pragma unroll
            for (int d = 1; d < 8; d <<= 1) { const float ov = __shfl_xor(v0, d); const int oi = __shfl_xor(e0, d); const bool take = (ov > v0) || (ov == v0 && oi < e0); v0 = take ? ov : v0; e0 = take ? oi : e0; }
            float v1 = (e == e0) ? -3.0e38f : lg; int e1 = e;
#pragma unroll
            for (int d = 1; d < 8; d <<= 1) { const float ov = __shfl_xor(v1, d); const int oi = __shfl_xor(e1, d); const bool take = (ov > v1) || (ov == v1 && oi < e1); v1 = take ? ov : v1; e1 = take ? oi : e1; }
            if (e == 0) {
                const float p1 = __expf(v1 - v0), g0 = 1.0f / (1.0f + p1), g1 = p1 * g0;
                te[tl * 2] = e0; te[tl * 2 + 1] = e1; tgt[tl * 2] = g0; tgt[tl * 2 + 1] = g1;
                tp[tl * 2] = __hip_atomic_fetch_add(&lcnt[e0], 1, __ATOMIC_RELAXED, __HIP_MEMORY_SCOPE_WORKGROUP); tp[tl * 2 + 1] = __hip_atomic_fetch_add(&lcnt[e1], 1, __ATOMIC_RELAXED, __HIP_MEMORY_SCOPE_WORKGROUP);
            }
        }
        __syncthreads();
        if (F.tid < 8) lbase[F.tid] = (int)__hip_atomic_fetch_add(gcnt + F.tid, (unsigned)lcnt[F.tid], __ATOMIC_RELAXED, __HIP_MEMORY_SCOPE_AGENT);
        __syncthreads();
        if (F.tid < 128) { const int tl = F.tid >> 1, s = F.tid & 1, e = te[tl * 2 + s], pos = lbase[e] + tp[tl * 2 + s];
            tgate[(cb * 64 + tl) * 2 + s] = tgt[tl * 2 + s]; tokep[(cb * 64 + tl) * 2 + s] = (e << 16) | pos; }
        for (int k = 0; k < 16; ++k) {
            const int pi = F.wave * 16 + k, tl = pi >> 1, e = te[pi], pos = lbase[e] + tp[pi], tok = cb * 64 + tl;
            const GAS u32x4* src = (const GAS u32x4*)(x3 + (size_t)tok * D) + 2 * F.lane;
            const u32x4 p0 = src[0], p1 = src[1]; const float rs = rstd_from_ss(ss3, tok);
            u32x4 o; o.x = pk4_fp8(bf_lo(p0.x) * rs, bf_hi(p0.x) * rs, bf_lo(p0.y) * rs, bf_hi(p0.y) * rs); o.y = pk4_fp8(bf_lo(p0.z) * rs, bf_hi(p0.z) * rs, bf_lo(p0.w) * rs, bf_hi(p0.w) * rs);
            o.z = pk4_fp8(bf_lo(p1.x) * rs, bf_hi(p1.x) * rs, bf_lo(p1.y) * rs, bf_hi(p1.y) * rs); o.w = pk4_fp8(bf_lo(p1.z) * rs, bf_hi(p1.z) * rs, bf_lo(p1.w) * rs, bf_hi(p1.w) * rs);
            *(GAS u32x4*)(xg + ((size_t)e * T + pos) * D + 16 * F.lane) = o;
        }
        __syncthreads();
    }
}
__device__ __forceinline__ void p11_gather(const Args& a, Frame& F) {
    unsigned char* ws = a.ws;
    const unsigned* gcnt = (const unsigned*)(ws + CTL_CNT); const int* list = (const int*)(ws + WS_LIST);
    const bf16* x3 = (const bf16*)(ws + WS_X3B); unsigned char* xg = ws + WS_XG;
    const unsigned long long* ss3 = (const unsigned long long*)(ws + CTL_SS3);
    int cnt[8], up[9], pp[8]; { int s = 0, p = 0;
_Pragma("unroll")
        for (int e = 0; e < 8; ++e) { cnt[e] = (int)gcnt[e]; up[e] = s; pp[e] = p; s += cnt[e]; p += ((cnt[e] + 255) >> 8) << 8; } up[8] = s; }
    const int gw = F.bid * NWAVES + F.wave, NGW = F.G * NWAVES, total = up[8];
    for (int i = gw; i < total; i += NGW) {
        int e = 0;
#pragma unroll
        for (int k = 1; k < 8; ++k) e += (i >= up[k]) ? 1 : 0;
        int pos = i, pbase = 0;
#pragma unroll
        for (int k = 0; k < 8; ++k) if (k == e) { pos = i - up[k]; pbase = pp[k]; }
        const int tok = list[e * T + pos], slot = pbase + pos;
        const GAS u32x4* src = (const GAS u32x4*)(x3 + (size_t)tok * D) + 2 * F.lane;
        const u32x4 p0 = src[0], p1 = src[1]; const float rs = rstd_from_ss(ss3, tok);
        u32x4 o; o.x = pk4_fp8(bf_lo(p0.x) * rs, bf_hi(p0.x) * rs, bf_lo(p0.y) * rs, bf_hi(p0.y) * rs); o.y = pk4_fp8(bf_lo(p0.z) * rs, bf_hi(p0.z) * rs, bf_lo(p0.w) * rs, bf_hi(p0.w) * rs);
        o.z = pk4_fp8(bf_lo(p1.x) * rs, bf_hi(p1.x) * rs, bf_lo(p1.y) * rs, bf_hi(p1.y) * rs); o.w = pk4_fp8(bf_lo(p1.z) * rs, bf_hi(p1.z) * rs, bf_lo(p1.w) * rs, bf_hi(p1.w) * rs);
        *(GAS u32x4*)(xg + (size_t)slot * D + 16 * F.lane) = o;
    }
}
__device__ __forceinline__ void fin_rows(const bf16* cb, const bf16* slab, int s, int rowf, int lane, u32x2 (&r)[4]) {
    if (s < rowf) { const GAS u32x2* c = (const GAS u32x2*)(cb + (size_t)s * D) + lane;
#pragma unroll
        for (int j = 0; j < 4; ++j) r[j] = __builtin_nontemporal_load(c + 64 * j); }
    else {
#pragma unroll
        for (int j = 0; j < 4; ++j) { f32x4 e = (f32x4){0.f, 0.f, 0.f, 0.f};
#pragma unroll
            for (int sl = 0; sl < 7; ++sl) { const u32x2 p = *((const GAS u32x2*)(slab + ((size_t)sl * 2048 + (s - rowf)) * D) + lane + 64 * j); e += (f32x4){bf_lo(p.x), bf_hi(p.x), bf_lo(p.y), bf_hi(p.y)}; }
            r[j].x = pk2(e.x, e.y); r[j].y = pk2(e.z, e.w); }
    }
}
__device__ __forceinline__ void p15_final(const Args& a, Frame& F) {
    unsigned char* ws = a.ws;
    const unsigned* gcnt = (const unsigned*)(ws + CTL_CNT); const int* tokep = (const int*)(ws + WS_TOKEP); const bf16* cb = (const bf16*)(ws + WS_CONTRIB); const float* tgate = (const float*)(ws + WS_TGATE);
    const float* fg = a.in[I_FG]; float* out = a.out; const bf16* x3b = (const bf16*)(ws + WS_X3B);
    int pp[8]; int ptot; { int p = 0;
_Pragma("unroll")
        for (int e = 0; e < 8; ++e) { pp[e] = p; p += (((int)gcnt[e] + 255) >> 8) << 8; } ptot = p; }
    const int MT = ptot >> 8, rowf = (MT - pg8::moe_tail_tiles(MT)) << 8;
    const bf16* slab = (const bf16*)(ws + WS_SLAB);
    const int gw = F.bid * NWAVES + F.wave, NGW = F.G * NWAVES;
    f32x4 gv[4];
#pragma unroll
    for (int j = 0; j < 4; ++j) gv[j] = *(const GAS f32x4*)(fg + 4 * F.lane + 256 * j);
    for (int blk = gw; blk < T / 8; blk += NGW) {
        const int m0 = blk * 8;
        int tk = 0; float tg = 0.f;
        if (F.lane < 16) { tk = tokep[m0 * 2 + F.lane]; tg = tgate[m0 * 2 + F.lane]; }
        u32x2 cx[4], ca[4], cc[4], nx[4], na[4], nc[4];
#define FIN_LOAD(X, A, C, i) do { const int _e0 = __builtin_amdgcn_readlane(tk, 2 * (i)), _e1 = __builtin_amdgcn_readlane(tk, 2 * (i) + 1); int _s0 = _e0 & 0xffff, _s1 = _e1 & 0xffff; \
            _Pragma("unroll") for (int k = 0; k < 8; ++k) { if ((_e0 >> 16) == k) _s0 += pp[k]; if ((_e1 >> 16) == k) _s1 += pp[k]; } \
            const GAS u32x2* _x = (const GAS u32x2*)(x3b + (size_t)(m0 + (i)) * D) + F.lane; \
            _Pragma("unroll") for (int j = 0; j < 4; ++j) X[j] = __builtin_nontemporal_load(_x + 64 * j); \
            fin_rows(cb, slab, _s0, rowf, F.lane, A); fin_rows(cb, slab, _s1, rowf, F.lane, C); } while (0)
        FIN_LOAD(cx, ca, cc, 0);
#pragma unroll
        for (int i = 0; i < 8; ++i) {
            if (i + 1 < 8) FIN_LOAD(nx, na, nc, i + 1);
            const float g0 = __builtin_bit_cast(float, __builtin_amdgcn_readlane(__builtin_bit_cast(int, tg), 2 * i)), g1 = __builtin_bit_cast(float, __builtin_amdgcn_readlane(__builtin_bit_cast(int, tg), 2 * i + 1));
            f32x4 v[4]; float sq = 0.f;
#pragma unroll
            for (int j = 0; j < 4; ++j) {
                v[j].x = bf_lo(cx[j].x) + g0 * bf_lo(ca[j].x) + g1 * bf_lo(cc[j].x); v[j].y = bf_hi(cx[j].x) + g0 * bf_hi(ca[j].x) + g1 * bf_hi(cc[j].x);
                v[j].z = bf_lo(cx[j].y) + g0 * bf_lo(ca[j].y) + g1 * bf_lo(cc[j].y); v[j].w = bf_hi(cx[j].y) + g0 * bf_hi(ca[j].y) + g1 * bf_hi(cc[j].y);
                sq += (v[j].x * v[j].x + v[j].y * v[j].y) + (v[j].z * v[j].z + v[j].w * v[j].w); }
            const float rstd = 1.f / sqrtf(wave_sum(sq) * (1.f / D) + RMS_EPS);
            GAS f32x4* xr = (GAS f32x4*)(out + (size_t)(m0 + i) * D) + F.lane;
#pragma unroll
            for (int j = 0; j < 4; ++j) __builtin_nontemporal_store(v[j] * rstd * gv[j], xr + 64 * j);
#pragma unroll
            for (int j = 0; j < 4; ++j) { cx[j] = nx[j]; ca[j] = na[j]; cc[j] = nc[j]; }
        }
#undef FIN_LOAD
    }
}

__device__ __forceinline__ const LAS float* row_scale_table(Frame& F, const unsigned long long* ss) {
    if ((F.G & 7) != 0) return nullptr;
    LAS float* rtab = (LAS float*)(F.lds + 131072);
    const int r0 = 2048 * (F.bid & 7);
    for (int i = F.tid; i < 2048; i += NWAVES * 64) rtab[i] = rstd_from_ss(ss, r0 + i);
    __syncthreads();
    return rtab;
}
constexpr int NPHASE = 17;
__global__ void __launch_bounds__(NWAVES * 64, 2) fwd(Args args) {
    extern __shared__ __attribute__((aligned(16))) unsigned char lds[];
    Frame F; F.lds = (LAS unsigned char*)lds; F.tid = threadIdx.x; F.lane = F.tid & 63; F.wave = __builtin_amdgcn_readfirstlane(F.tid >> 6); F.G = gridDim.x; F.bid = blockIdx.x;
    volatile LAS unsigned* MISC = (volatile LAS unsigned*)(F.lds + MISC_OFF);
    unsigned char* ws = args.ws;
    if (F.tid < 64) MISC[F.tid] = 0u;
    __syncthreads();
    const int lo = args.ph_lo, hi = args.ph_hi;
    XcdBarrier bar; bar.bar = (unsigned*)(ws + CTL_BAR); bar.x = 0; bar.st = nullptr;
    if (hi - lo > 1) bar = xcd_barrier_post((unsigned*)(ws + CTL_BAR), MISC + 8);
#ifdef ONLY_PHASE
#define IN(k) ((k) == ONLY_PHASE && lo <= (k) && (k) < hi)
#else
#define IN(k) (lo <= (k) && (k) < hi)
#endif
#define SEAM(k) do { if (IN(k) && IN((k) + 1)) xcd_barrier(bar); } while (0)
    LAS unsigned char* ring = F.lds + RING_OFF;
    unsigned long long* ss1 = (unsigned long long*)(ws + CTL_SS1); unsigned long long* ss2 = (unsigned long long*)(ws + CTL_SS2); unsigned long long* ss3 = (unsigned long long*)(ws + CTL_SS3);

    if (IN(0)) { p0_zero(args, F); run_jobs(args, F, 0, NJ_EARLY, F.bid * NWAVES + F.wave, F.G * NWAVES); p0_hcat(args, F); }
#if defined(REPEAT_PHASE) && REPEAT_PHASE == 0
    if (IN(0)) { run_jobs(args, F, 0, NJ_EARLY, F.bid * NWAVES + F.wave, F.G * NWAVES); p0_hcat(args, F); }
#endif
    SEAM(0);
    if (IN(1)) {
        pg8::Gemm2 g{{(const bf16*)(ws + WS_XR), (const bf16*)(ws + WS_HCAT)}, {(const bf16*)(ws + WS_WRKV), (const bf16*)(ws + WS_WLORA)}, {1024, 2048}, {1024, 2048}};
        G1Order S{F.G, F.bid};
        EpiG1 E{(bf16*)(ws + WS_R), (bf16*)(ws + WS_LH)};
        pg8::gemm_phase2<EpiG1, G1Order>(ring, g, S, E, (unsigned*)(ws + CTL_LORA_DONE)); }
    if (IN(1) && IN(2)) {
        if (F.tid == 0) { unsigned* sigp = (unsigned*)(ws + CTL_LORA_DONE); unsigned sp = 0;
            while (__hip_atomic_load(sigp, __ATOMIC_RELAXED, __HIP_MEMORY_SCOPE_AGENT) < 64u) { __builtin_amdgcn_s_sleep(1); if (++sp > (1u << 22)) break; }
            __builtin_amdgcn_fence(__ATOMIC_ACQUIRE, "agent"); }
        __syncthreads(); }
    if (IN(2)) {
        pg8::Gemm2 g{{(const bf16*)(ws + WS_LH), (const bf16*)(ws + WS_LH)}, {(const bf16*)(ws + WS_WLU), (const bf16*)(ws + WS_WLU)}, {256, 256}, {128, 128}};
        G2Order S; S.so.init(T / 256, 3072 / 256, F.G, F.bid);
        EpiG2 E{(bf16*)(ws + WS_LW), args.in[I_W0], args.in[I_A0]};
        pg8::gemm_phase2<EpiG2, G2Order>(ring, g, S, E); }
    SEAM(2);
    if (IN(3)) {
        const int nscan = F.G > 128 ? 128 : F.G, nconv = F.G - nscan;
        constexpr int CONV_SPLIT = 32;
        if (F.bid < nscan) { for (int pair = F.bid; pair < 128; pair += nscan) { p3_scan_chunked(args, F, pair); __syncthreads(); }
#if defined(SCAN_TWICE)
            for (int pair = F.bid; pair < 128; pair += nscan) { p3_scan_chunked<SCAN_TWICE>(args, F, pair); __syncthreads(); }
#endif
            if (nconv > 0) run_jobs_moe(args, F, F.bid * NWAVES + F.wave, nscan * NWAVES, CONV_SPLIT, 32); else { run_jobs(args, F, NJ_EARLY, NJ0, F.bid * NWAVES + F.wave, F.G * NWAVES); run_jobs_moe(args, F, F.bid * NWAVES + F.wave, F.G * NWAVES, 0, 32); } }
        else { run_jobs(args, F, NJ_EARLY, NJ0, (F.bid - nscan) * NWAVES + F.wave, nconv * NWAVES); run_jobs_moe(args, F, (F.bid - nscan) * NWAVES + F.wave, nconv * NWAVES, 0, CONV_SPLIT); }
#if defined(CONV_TWICE)
        if (F.bid >= nscan) { __syncthreads(); run_jobs_moe(args, F, (F.bid - nscan) * NWAVES + F.wave, nconv * NWAVES, 0, CONV_SPLIT); }
#endif
    }
    SEAM(3);
    if (IN(4)) {
        pg8::Gemm g{(const bf16*)(ws + WS_Z), (const bf16*)(ws + WS_WO), 1024, 1024, 0}; pg8::StaticOrder S; S.init(T / 256, 4, F.G, F.bid);
        EpiResT<true> E{args.in[I_X], nullptr, (bf16*)(ws + WS_X1B), ss1};
        pg8::gemm_phase<EpiResT<true>, pg8::StaticOrder>(ring, g, S, E); }
    SEAM(4);
    if (IN(5)) {
        pg8::Gemm g{(const bf16*)(ws + WS_X1B), (const bf16*)(ws + WS_W13F), 1024, 1024, 0}; pg8::StaticOrder S; S.init(T / 256, 2 * FFD / 256, F.G, F.bid, true);
        const bool early = ((F.bid >> 3) & 1) != 0;
        pg8::TailHalfOrder TS0, TS1; TS0.init(T / 256, 2 * FFD / 256, F.G, F.bid, early); TS1.init(T / 256, 2 * FFD / 256, F.G, F.bid, !early);
        const LAS float* rtab = row_scale_table(F, ss1);
        EpiSwiglu E{(bf16*)(ws + WS_FH), FFD, ss1, nullptr, 1, rtab}; EpiSwigluT<true> EH{(bf16*)(ws + WS_FH), FFD, ss1, nullptr, 1, rtab};
        pg8::gemm_phase<EpiSwigluT<true>, pg8::TailHalfOrder, false, false, true, false, true>(ring, g, TS0, EH);
        __syncthreads();
        pg8::gemm_phase<EpiSwiglu, pg8::StaticOrder>(ring, g, S, E);
        __syncthreads();
        pg8::gemm_phase<EpiSwigluT<true>, pg8::TailHalfOrder, false, false, true, false, true>(ring, g, TS1, EH); }
    SEAM(5);
    if (IN(6)) {
        pg8::Gemm g{(const bf16*)(ws + WS_FH), (const bf16*)(ws + WS_W2F), FFD / 2, FFD / 2, 0}; pg8::StaticOrder S; S.init(T / 256, 4, F.G, F.bid);
        EpiResT<false> E{nullptr, (const bf16*)(ws + WS_X1B), (bf16*)(ws + WS_X2B), ss2, ws + WS_X2F8};
        pg8::gemm_phase<EpiResT<false>, pg8::StaticOrder, true>(ring, g, S, E, MW2_SCALE_BYTE * 0x01010101, 0x7F7F7F7F); }
    SEAM(6);
    if (IN(7)) {
        pg8::Gemm g{(const bf16*)(ws + WS_X2F8), (const bf16*)(ws + WS_WQKV), 512, 512, 0}; pg8::StaticOrder S; S.init(T / 256, 18, F.G, F.bid, true);
        const bool early = ((F.bid >> 3) & 1) != 0;
        pg8::TailHalfOrder TS0, TS1; TS0.init(T / 256, 18, F.G, F.bid, early); TS1.init(T / 256, 18, F.G, F.bid, !early);
        const LAS float* rtab = row_scale_table(F, ss2);
        EpiQKV E{(bf16*)(ws + WS_Q), ss2, rtab}; EpiQKVT<true> EH{(bf16*)(ws + WS_Q), ss2, rtab};
        pg8::gemm_phase<EpiQKVT<true>, pg8::TailHalfOrder, true, false, true, false, true>(ring, g, TS0, EH, WQKV_SCALE_BYTE * 0x01010101, 0x7F7F7F7F);
        __syncthreads();
        pg8::gemm_phase<EpiQKV, pg8::StaticOrder, true>(ring, g, S, E, WQKV_SCALE_BYTE * 0x01010101, 0x7F7F7F7F);
        __syncthreads();
        pg8::gemm_phase<EpiQKVT<true>, pg8::TailHalfOrder, true, false, true, false, true>(ring, g, TS1, EH, WQKV_SCALE_BYTE * 0x01010101, 0x7F7F7F7F); }
    SEAM(7);
    if (IN(8)) p8_attn_mfma(args, F);
#if defined(REPEAT_PHASE) && REPEAT_PHASE == 8
    if (IN(8)) p8_attn_mfma(args, F);
#endif
    SEAM(8);
    if (IN(9)) p9_merge(args, F);
    SEAM(9);
    if (IN(10)) {
        pg8::Gemm g{(const bf16*)(ws + WS_OM), (const bf16*)(ws + WS_WAO), 512, 512, 0}; pg8::StaticOrder S; S.init(T / 256, 4, F.G, F.bid);
        EpiResT<false> E{nullptr, (const bf16*)(ws + WS_X2B), (bf16*)(ws + WS_X3B), ss3};
        pg8::gemm_phase<EpiResT<false>, pg8::StaticOrder>(ring, g, S, E); }
    SEAM(10);
    if (IN(11)) p10_router(args, F);
    SEAM(11);
    if (IN(13)) {
        int cnt[8];
_Pragma("unroll")
        for (int e = 0; e < 8; ++e) cnt[e] = (int)((const unsigned*)(ws + CTL_CNT))[e];
        pg8::Gemm g{(const bf16*)(ws + WS_XG), (const bf16*)(ws + WS_MW13), 512, 512, (size_t)7168 * 512}; pg8::MoeOrder S; S.init(cnt, 28, F.G, F.bid);
        EpiSwiglu E{(bf16*)(ws + WS_MH), FFE, nullptr, nullptr, 1, nullptr};
        pg8::gemm_phase<EpiSwiglu, pg8::MoeOrder, true, false, MOEUP_ALIGN, true>(ring, g, S, E, MW13_SCALE_BYTE * 0x01010101, 0x7F7F7F7F); }
    SEAM(13);
    if (IN(15)) {
        int cnt[8];
_Pragma("unroll")
        for (int e = 0; e < 8; ++e) cnt[e] = (int)((const unsigned*)(ws + CTL_CNT))[e];
        pg8::Gemm g{(const bf16*)(ws + WS_MH), (const bf16*)(ws + WS_MW2), FFE / 2, FFE / 2, (size_t)1024 * (FFE / 2)}; pg8::MoeDownOrder S; S.init(cnt, FFE / 128, F.G, F.bid);
        EpiGate E{(bf16*)(ws + WS_CONTRIB), (bf16*)(ws + WS_SLAB), S.MTf};
        pg8::gemm_phase<EpiGate, pg8::MoeDownOrder, true, true>(ring, g, S, E, MW2_SCALE_BYTE * 0x01010101, 0x7F7F7F7F); }
    SEAM(15);
    if (IN(16)) p15_final(args, F);
#undef IN
#undef SEAM
}

extern "C" void kernel_launch(void* const* d_in, const int* in_sizes, int n_in, void* d_out, int out_size, void* d_ws, size_t ws_size, hipStream_t stream) {
    static int grid = 0;
    if (grid == 0) {
        if (n_in != 33 || in_sizes[0] != T * D || out_size != T * D || ws_size < WS_END) { fprintf(stderr, "kernel_launch: unexpected shapes: n_in %d in0 %d out %d ws %zu (need %zu)\n", n_in, n_in > 0 ? in_sizes[0] : -1, out_size, ws_size, (size_t)WS_END); grid = -1; return; }
        int dev = 0, cus = 0, per_cu = 0;
        if (hipGetDevice(&dev) != hipSuccess || hipDeviceGetAttribute(&cus, hipDeviceAttributeMultiprocessorCount, dev) != hipSuccess) { grid = -1; return; }
        if (hipFuncSetAttribute((const void*)fwd, hipFuncAttributeMaxDynamicSharedMemorySize, LDS_BYTES) != hipSuccess) { fprintf(stderr, "kernel_launch: hipFuncSetAttribute failed\n"); grid = -1; return; }
        if (hipOccupancyMaxActiveBlocksPerMultiprocessor(&per_cu, (const void*)fwd, NWAVES * 64, LDS_BYTES) != hipSuccess || per_cu < 1) fprintf(stderr, "kernel_launch: occupancy query says %d\n", per_cu);
        (void)hipGetLastError();
        grid = cus;
    }
    if (grid < 0) return;
    (void)hipMemsetAsync((char*)d_ws + WS_CTL, 0, CTL_ZERO_BYTES, stream);
    Args a{};
    for (int i = 0; i < 33; ++i) a.in[i] = (const float*)d_in[i];
    a.out = (float*)d_out; a.ws = (unsigned char*)d_ws;
#if MK_ONE_LAUNCH
    a.ph_lo = 0; a.ph_hi = NPHASE;
    hipLaunchKernelGGL(fwd, dim3(grid), dim3(NWAVES * 64), LDS_BYTES, stream, a);
#else
    for (int p = 0; p < NPHASE; ++p) { a.ph_lo = p; a.ph_hi = p + 1; hipLaunchKernelGGL(fwd, dim3(grid), dim3(NWAVES * 64), LDS_BYTES, stream, a); }
#endif
}
```

```cpp
#include <hip/hip_runtime.h>
#include <cstdio>
#include <cstdint>

#ifndef MOEUP_ALIGN
#define MOEUP_ALIGN true
#endif
#ifndef MK_ONE_LAUNCH
#define MK_ONE_LAUNCH 1
#endif

namespace pg8 {
#define PG8_LAS __attribute__((address_space(3)))
typedef unsigned short bf16_t;
typedef short bf16x8 __attribute__((ext_vector_type(8)));
typedef float f32x4 __attribute__((ext_vector_type(4)));
typedef unsigned u32x4 __attribute__((ext_vector_type(4)));
typedef unsigned u32x2 __attribute__((ext_vector_type(2)));
typedef int i32x8 __attribute__((ext_vector_type(8)));
constexpr int BM = 256, BK = 64, HALF = 128, HTB = HALF * BK * 2, STAGE_BYTES = 8 * HTB, NXCD = 8, WGM = 8;

__host__ __device__ __forceinline__ int lds_byte(int r, int c) { const int st = (r >> 4) * 2 + (c >> 5), rr = r & 15, cc = c & 31, ob = rr * 64 + cc * 2; return st * 1024 + (ob ^ (((ob >> 9) & 1) << 5)); }
__host__ __device__ __forceinline__ void stage_rc(int b, int& R, int& C) { const int st = b / 1024, sb = b % 1024, swz = sb ^ (((sb >> 9) & 1) << 5); R = (st >> 1) * 16 + swz / 64; C = (st & 1) * 32 + (swz % 64) / 2; }
__host__ __device__ __forceinline__ int perm32(int rho) { const int n = rho >> 4, i = rho & 15; return 8 * (i >> 2) + 4 * n + (i & 3); }

struct Unit { int pm, pn, e, acol, k0, ntu, slice, mh; };
struct Gemm { const bf16_t* A; const bf16_t* Bt; int lda, K; size_t bstride_e; };
struct Gemm2 { const bf16_t* A[2]; const bf16_t* Bt[2]; int lda[2], K[2]; };

__device__ __forceinline__ void static_map(int L, int nM, int nN, int nwg, Unit& u) {
    int wgid = L; { const int q = nwg / NXCD, r = nwg % NXCD, xcd = wgid % NXCD, off = wgid / NXCD; wgid = (xcd < r ? xcd * (q + 1) : r * (q + 1) + (xcd - r) * q) + off; }
    const int nig = WGM * nN, gid = wgid / nig, fm = gid * WGM, gsz = (nM - fm) < WGM ? (nM - fm) : WGM;
    u.pm = fm + ((wgid % nig) % gsz); u.pn = (wgid % nig) / gsz; u.e = 0; u.acol = 0;
}
__device__ __forceinline__ int tail_tiles(int nwg, int G) { const int rem = nwg % G; return 2 * rem > G ? 0 : rem; }
struct StaticOrder {
    int nM, nN, nwg, G, c, lim;
    __device__ __forceinline__ void init(int nM_, int nN_, int G_, int c_, bool whole = false) { nM = nM_; nN = nN_; nwg = nM * nN; G = G_; c = c_; lim = whole ? nwg - tail_tiles(nwg, G) : nwg; }
    __device__ __forceinline__ bool next(int i, Unit& u) const { const long L = (long)i * G + c; if (L >= lim) return false; static_map((int)L, nM, nN, nwg, u); return true; }
};
struct TailHalfOrder {
    int nM, nN, nwg, G, c, Lbase, rem;
    __device__ __forceinline__ void init(int nM_, int nN_, int G_, int c_, bool active = true) { nM = nM_; nN = nN_; nwg = nM * nN; G = G_; c = c_; rem = active ? tail_tiles(nwg, G) : 0; Lbase = nwg - tail_tiles(nwg, G); }
    __device__ __forceinline__ bool next(int i, Unit& u) const { const long v = (long)i * G + c; if (v >= 2 * rem) return false; const int mh = (int)v / rem; static_map(Lbase + ((int)v - mh * rem), nM, nN, nwg, u); u.mh = mh; return true; }
};
struct MoeOrder {
    int nM, nN, nwg, G, c; int tp[9];
    __device__ void init(const int* cnt, int nN_, int G_, int c_) { int s = 0;
_Pragma("unroll")
        for (int e = 0; e < 8; ++e) { tp[e] = s; s += (cnt[e] + 255) >> 8; } tp[8] = s; nM = s; nN = nN_; nwg = nM * nN; G = G_; c = c_; }
    __device__ bool next(int i, Unit& u) const {
        const long L = (long)i * G + c; if (L >= nwg) return false;
        int wgid = (int)L; { const int q = nwg / NXCD, r = nwg % NXCD, xcd = wgid % NXCD, off = wgid / NXCD; wgid = (xcd < r ? xcd * (q + 1) : r * (q + 1) + (xcd - r) * q) + off; }
        const int nig = WGM * nN, gid = wgid / nig, fm = gid * WGM, gsz = (nM - fm) < WGM ? (nM - fm) : WGM;
        u.pm = fm + ((wgid % nig) % gsz); u.pn = (wgid % nig) / gsz;
        int e = 0;
#pragma unroll
        for (int k = 1; k < 8; ++k) e += (u.pm >= tp[k]) ? 1 : 0;
        u.e = e; u.acol = e * 64 - tp_of(e) + u.pm; return true;
    }
    __device__ int tp_of(int e) const { int r = 0;
_Pragma("unroll")
        for (int k = 0; k < 8; ++k) r = (k == e) ? tp[k] : r; return r; }
};

__device__ __forceinline__ unsigned cvt_pk_bf16(float lo, float hi) { unsigned r; asm volatile("v_cvt_pk_bf16_f32 %0, %1, %2" : "=v"(r) : "v"(lo), "v"(hi)); return r; }

#if defined(FORCE_SLICE)
__host__ __device__ __forceinline__ int moe_tail_tiles(int MT) { return (MT & 63) ? (MT & 63) : 8; }
#else
__host__ __device__ __forceinline__ int moe_tail_tiles(int MT) { return MT & 63; }
#endif
struct MoeDownOrder {
    int MT, MTf, nfull, nwg, G, c, ntK; int tp[9];
    __device__ void init(const int* cnt, int ntK_, int G_, int c_) { int s = 0;
_Pragma("unroll")
        for (int e = 0; e < 8; ++e) { tp[e] = s; s += (cnt[e] + 255) >> 8; } tp[8] = s; MT = s; MTf = MT - moe_tail_tiles(MT); nfull = MTf * 4; nwg = nfull + (MT - MTf) * 4 * 7; G = G_; c = c_; ntK = ntK_; }
    __device__ bool next(int i, Unit& u) const {
        const long L = (long)i * G + c; if (L >= nwg) return false;
        if (L < nfull) {
            int wgid = (int)L; { const int q = nfull / NXCD, xcd = wgid % NXCD, off = wgid / NXCD; wgid = xcd * q + off; }
            const int nig = WGM * 4, gid = wgid / nig, fm = gid * WGM;
            u.pm = fm + ((wgid % nig) % WGM); u.pn = (wgid % nig) / WGM; u.k0 = 0; u.ntu = ntK; u.slice = -1;
        } else { const int r = (int)L - nfull, q = r / 7; u.slice = r - 7 * q; u.pn = q & 3; u.pm = MTf + (q >> 2); u.k0 = 4 * u.slice; u.ntu = 4; }
        int e = 0;
#pragma unroll
        for (int k = 1; k < 8; ++k) e += (u.pm >= tp[k]) ? 1 : 0;
        u.e = e; u.acol = 0; return true;
    }
};
template <class Epi, class Sched, bool FP8 = false, bool KS = false, bool ALIGN = true, bool PA = false, bool HM = false>
__device__ __forceinline__ void gemm_phase(PG8_LAS unsigned char* lds, const Gemm g, const Sched& S, const Epi& E, int scale_w = 0x7F7F7F7F, int scale_x = 0x7F7F7F7F) {
    const int tid = threadIdx.x, wid = __builtin_amdgcn_readfirstlane(tid >> 6), lane = tid & 63, wr = wid >> 2, wc = wid & 3, fr = lane & 15, fq = lane >> 4;
    int K = g.K; asm volatile("" : "+s"(K));
    const int nt = K / BK, lda = g.lda;
    unsigned voffA[2], voffB[2];
#pragma unroll
    for (int i = 0; i < 2; ++i) { int R, C; stage_rc(tid * 16 + i * 8192, R, C); const int Rb = (R & ~31) + perm32(R & 31);
        voffA[i] = (unsigned)(R * lda + C) * 2u; voffB[i] = (unsigned)(Rb * K + C) * 2u; }
    const size_t kstep = (size_t)(BK * 2);
    const size_t hstepA = (size_t)HALF * lda * 2, hstepB = (size_t)HALF * K * 2;
    const size_t tstepA = 2 * hstepA, tstepB = 2 * hstepB;
    const unsigned ldsw = (unsigned)wid * 1024u;
    const int aoff = lds_byte(wr * 64 + fr, fq * 8), boff = lds_byte(wc * 32 + fr, fq * 8);
#define PG8_SA(b, h) (((b) * 2 + (h)) * HTB)
#define PG8_SB(b, h) ((4 + (b) * 2 + (h)) * HTB)
#define PG8_STAGE(bufoff, gbase, voff) do { _Pragma("unroll") for (int _i = 0; _i < 2; ++_i) \
        __builtin_amdgcn_global_load_lds((const unsigned*)((const char*)(gbase) + (voff)[_i]), (PG8_LAS unsigned*)(lds + (bufoff) + ldsw + _i * 8192), 16, 0, 0); } while (0)
#define PG8_LDA(dst, b, h) do { _Pragma("unroll") for (int m = 0; m < 4; ++m) { const u32x4 _l = *(const PG8_LAS u32x4*)(lds + PG8_SA(b, h) + aoff + m * 2048), _h = *(const PG8_LAS u32x4*)(lds + PG8_SA(b, h) + aoff + m * 2048 + 1024); \
        dst[m] = (i32x8){(int)_l.x, (int)_l.y, (int)_l.z, (int)_l.w, (int)_h.x, (int)_h.y, (int)_h.z, (int)_h.w}; } } while (0)
#define PG8_LDB(dst, b, h) do { _Pragma("unroll") for (int n = 0; n < 2; ++n) { const u32x4 _l = *(const PG8_LAS u32x4*)(lds + PG8_SB(b, h) + boff + n * 2048), _h = *(const PG8_LAS u32x4*)(lds + PG8_SB(b, h) + boff + n * 2048 + 1024); \
        dst[n] = (i32x8){(int)_l.x, (int)_l.y, (int)_l.z, (int)_l.w, (int)_h.x, (int)_h.y, (int)_h.z, (int)_h.w}; } } while (0)
#define PG8_MMA(ai, bj, At, Bt) do { __builtin_amdgcn_s_setprio(1); \
        if constexpr (FP8) { _Pragma("unroll") for (int m = 0; m < 4; ++m) _Pragma("unroll") for (int n = 0; n < 2; ++n) \
            asm volatile("v_mfma_scale_f32_16x16x128_f8f6f4 %0, %1, %2, %0, %3, %4 op_sel_hi:[0,0,0]" : "+v"(acc[ai][bj][m][n]) : "v"(Bt[n]), "v"(At[m]), "v"(scale_w), "v"(scale_x)); } \
        else { _Pragma("unroll") for (int m = 0; m < 4; ++m) _Pragma("unroll") for (int n = 0; n < 2; ++n) { \
            const i32x8 _a = At[m], _b = Bt[n]; \
            const bf16x8 _a0 = __builtin_bit_cast(bf16x8, (u32x4){(unsigned)_a[0], (unsigned)_a[1], (unsigned)_a[2], (unsigned)_a[3]}), _a1 = __builtin_bit_cast(bf16x8, (u32x4){(unsigned)_a[4], (unsigned)_a[5], (unsigned)_a[6], (unsigned)_a[7]}); \
            const bf16x8 _b0 = __builtin_bit_cast(bf16x8, (u32x4){(unsigned)_b[0], (unsigned)_b[1], (unsigned)_b[2], (unsigned)_b[3]}), _b1 = __builtin_bit_cast(bf16x8, (u32x4){(unsigned)_b[4], (unsigned)_b[5], (unsigned)_b[6], (unsigned)_b[7]}); \
            acc[ai][bj][m][n] = __builtin_amdgcn_mfma_f32_16x16x32_bf16(_b0, _a0, acc[ai][bj][m][n], 0, 0, 0); \
            acc[ai][bj][m][n] = __builtin_amdgcn_mfma_f32_16x16x32_bf16(_b1, _a1, acc[ai][bj][m][n], 0, 0, 0); } } \
        __builtin_amdgcn_s_setprio(0); } while (0)
#define PG8_WAIT_V(n) asm volatile("s_waitcnt vmcnt(" #n ")" ::: "memory")
#define PG8_WAIT_L(n) asm volatile("s_waitcnt lgkmcnt(" #n ")" ::: "memory")
#define PG8_BAR __builtin_amdgcn_s_barrier()
#define PG8_SCHED __builtin_amdgcn_sched_barrier(0)
    Unit cur, nxt; int ui = 0;
    if (!S.next(0, cur)) return;
    f32x4 acc[2][2][4][2];
#pragma unroll
    for (int a = 0; a < 2; ++a)
#pragma unroll
        for (int b = 0; b < 2; ++b)
#pragma unroll
            for (int m = 0; m < 4; ++m)
#pragma unroll
                for (int n = 0; n < 2; ++n) acc[a][b][m][n] = (f32x4){0.f, 0.f, 0.f, 0.f};
    i32x8 At[4], B0[2], B1[2];
    const char* cA = (const char*)g.A + (size_t)(PA ? cur.acol : cur.pm) * tstepA + (HM ? (size_t)cur.mh * hstepA : 0); const char* cB = (const char*)(g.Bt + (size_t)cur.e * g.bstride_e) + (size_t)cur.pn * tstepB;
    if constexpr (KS) { cA += (size_t)cur.k0 * kstep; cB += (size_t)cur.k0 * kstep; }
    int ntc = KS ? cur.ntu : nt;
    PG8_STAGE(PG8_SB(0, 0), cB, voffB); PG8_STAGE(PG8_SB(0, 1), cB + hstepB, voffB); PG8_STAGE(PG8_SA(0, 0), cA, voffA); PG8_STAGE(PG8_SA(0, 1), cA + hstepA, voffA);
    if (wr == 1) PG8_BAR;
    PG8_WAIT_V(2); PG8_BAR;
    PG8_STAGE(PG8_SB(1, 0), cB + kstep, voffB); PG8_STAGE(PG8_SA(1, 0), cA + kstep, voffA); PG8_STAGE(PG8_SB(1, 1), cB + hstepB + kstep, voffB);
    PG8_WAIT_V(6); PG8_BAR;
    for (;;) {
        const bool has_next = S.next(ui + 1, nxt);
        const char* nA = has_next ? (const char*)g.A + (size_t)(PA ? nxt.acol : nxt.pm) * tstepA + (KS ? (size_t)nxt.k0 * kstep : 0) + (HM ? (size_t)nxt.mh * hstepA : 0) : cA;
        const char* nB = has_next ? (const char*)(g.Bt + (size_t)nxt.e * g.bstride_e) + (size_t)nxt.pn * tstepB + (KS ? (size_t)nxt.k0 * kstep : 0) : cB;
        for (int t = 0; t < ntc; t += 2) {
            const bool last = (t == ntc - 2);
            const char* a1 = cA + (size_t)(t + 1) * kstep;
            const char* a2 = last ? nA : cA + (size_t)(t + 2) * kstep; const char* b2 = last ? nB : cB + (size_t)(t + 2) * kstep;
            const char* a3 = a2 + kstep; const char* b3 = b2 + kstep;
            PG8_LDB(B0, 0, 0); PG8_LDB(B1, 0, 1); PG8_SCHED; PG8_LDA(At, 0, 0); PG8_STAGE(PG8_SA(1, 1), a1 + hstepA, voffA);
            PG8_WAIT_V(8); PG8_WAIT_L(0); PG8_BAR; PG8_MMA(0, 0, At, B0); PG8_MMA(0, 1, At, B1); PG8_BAR; PG8_SCHED;
            PG8_LDA(At, 0, 1); PG8_STAGE(PG8_SB(0, 0), b2, voffB); PG8_STAGE(PG8_SB(0, 1), b2 + hstepB, voffB); PG8_STAGE(PG8_SA(0, 0), a2, voffA);
            PG8_WAIT_V(8); PG8_WAIT_L(0); PG8_BAR; if constexpr (!HM) { PG8_MMA(1, 0, At, B0); PG8_MMA(1, 1, At, B1); } PG8_BAR; PG8_SCHED;
            PG8_LDB(B0, 1, 0); PG8_LDB(B1, 1, 1); PG8_SCHED; PG8_LDA(At, 1, 0); PG8_STAGE(PG8_SA(0, 1), a2 + hstepA, voffA);
            PG8_WAIT_V(8); PG8_WAIT_L(0); PG8_BAR; PG8_MMA(0, 0, At, B0); PG8_MMA(0, 1, At, B1); PG8_BAR; PG8_SCHED;
            PG8_LDA(At, 1, 1); PG8_STAGE(PG8_SB(1, 0), b3, voffB); PG8_STAGE(PG8_SB(1, 1), b3 + hstepB, voffB); PG8_STAGE(PG8_SA(1, 0), a3, voffA);
            PG8_WAIT_V(8); PG8_WAIT_L(0); PG8_BAR; if constexpr (!HM) { PG8_MMA(1, 0, At, B0); PG8_MMA(1, 1, At, B1); } PG8_BAR; PG8_SCHED;
        }
        if constexpr (ALIGN) { if (wr == 0) PG8_BAR; }
        if constexpr (FP8) asm volatile("s_nop 15\n\ts_nop 15" ::: "memory");
        E(acc, cur, wr, wc, fr, fq);
        if (!has_next) break;
#pragma unroll
        for (int a = 0; a < 2; ++a)
#pragma unroll
            for (int b = 0; b < 2; ++b)
#pragma unroll
                for (int m = 0; m < 4; ++m)
#pragma unroll
                    for (int n = 0; n < 2; ++n) acc[a][b][m][n] = (f32x4){0.f, 0.f, 0.f, 0.f};
        cur = nxt; cA = nA; cB = nB; ++ui; if constexpr (KS) ntc = cur.ntu;
        if constexpr (ALIGN) { if (wr == 1) PG8_BAR; }
    }
    PG8_WAIT_V(0);
    if constexpr (!ALIGN) { if (wr == 0) PG8_BAR; }
    PG8_BAR;
#undef PG8_SA
#undef PG8_SB
#undef PG8_STAGE
#undef PG8_LDA
#undef PG8_LDB
#undef PG8_MMA
#undef PG8_WAIT_V
#undef PG8_WAIT_L
#undef PG8_BAR
#undef PG8_SCHED
}
template <class Epi, class Sched>
__device__ __forceinline__ void gemm_phase2(PG8_LAS unsigned char* lds, const Gemm2 g, const Sched& S, const Epi& E, unsigned* sig = nullptr) {
    const int tid = threadIdx.x, wid = __builtin_amdgcn_readfirstlane(tid >> 6), lane = tid & 63, wr = wid >> 2, wc = wid & 3, fr = lane & 15, fq = lane >> 4;
    int K0 = g.K[0], K1 = g.K[1]; asm volatile("" : "+s"(K0), "+s"(K1));
    unsigned voffA0[2], voffA1[2], voffB0[2], voffB1[2];
#pragma unroll
    for (int i = 0; i < 2; ++i) { int R, C; stage_rc(tid * 16 + i * 8192, R, C); const int Rb = (R & ~31) + perm32(R & 31);
        voffA0[i] = (unsigned)(R * g.lda[0] + C) * 2u; voffB0[i] = (unsigned)(Rb * K0 + C) * 2u; voffA1[i] = (unsigned)(R * g.lda[1] + C) * 2u; voffB1[i] = (unsigned)(Rb * K1 + C) * 2u; }
    const size_t kstep = (size_t)(BK * 2);
    const unsigned ldsw = (unsigned)wid * 1024u;
    const int aoff = lds_byte(wr * 64 + fr, fq * 8), boff = lds_byte(wc * 32 + fr, fq * 8);
#define PG8_SA(b, h) (((b) * 2 + (h)) * HTB)
#define PG8_SB(b, h) ((4 + (b) * 2 + (h)) * HTB)
#define PG8_STAGE(bufoff, gbase, v0, v1) do { \
        __builtin_amdgcn_global_load_lds((const unsigned*)((const char*)(gbase) + (v0)), (PG8_LAS unsigned*)(lds + (bufoff) + ldsw), 16, 0, 0); \
        __builtin_amdgcn_global_load_lds((const unsigned*)((const char*)(gbase) + (v1)), (PG8_LAS unsigned*)(lds + (bufoff) + ldsw + 8192), 16, 0, 0); } while (0)
#define PG8_LDA(dst, b, h) do { _Pragma("unroll") for (int m = 0; m < 4; ++m) _Pragma("unroll") for (int k = 0; k < 2; ++k) dst[m][k] = *(const PG8_LAS bf16x8*)(lds + PG8_SA(b, h) + aoff + m * 2048 + k * 1024); } while (0)
#define PG8_LDB(dst, b, h) do { _Pragma("unroll") for (int n = 0; n < 2; ++n) _Pragma("unroll") for (int k = 0; k < 2; ++k) dst[n][k] = *(const PG8_LAS bf16x8*)(lds + PG8_SB(b, h) + boff + n * 2048 + k * 1024); } while (0)
#define PG8_MMA(ai, bj, At, Bt) do { __builtin_amdgcn_s_setprio(1); _Pragma("unroll") for (int m = 0; m < 4; ++m) _Pragma("unroll") for (int n = 0; n < 2; ++n) _Pragma("unroll") for (int k = 0; k < 2; ++k) \
        acc[ai][bj][m][n] = __builtin_amdgcn_mfma_f32_16x16x32_bf16(Bt[n][k], At[m][k], acc[ai][bj][m][n], 0, 0, 0); __builtin_amdgcn_s_setprio(0); } while (0)
#define PG8_WAIT_V(n) asm volatile("s_waitcnt vmcnt(" #n ")" ::: "memory")
#define PG8_WAIT_L(n) asm volatile("s_waitcnt lgkmcnt(" #n ")" ::: "memory")
#define PG8_BAR __builtin_amdgcn_s_barrier()
#define PG8_SCHED __builtin_amdgcn_sched_barrier(0)
    Unit cur, nxt; int ui = 0;
    if (!S.next(0, cur)) return;
    f32x4 acc[2][2][4][2];
#pragma unroll
    for (int a = 0; a < 2; ++a)
#pragma unroll
        for (int b = 0; b < 2; ++b)
#pragma unroll
            for (int m = 0; m < 4; ++m)
#pragma unroll
                for (int n = 0; n < 2; ++n) acc[a][b][m][n] = (f32x4){0.f, 0.f, 0.f, 0.f};
    bf16x8 At[4][2], B0[2][2], B1[2][2];
#define PG8_CFG(u, cA_, cB_, hA_, hB_, vA0_, vA1_, vB0_, vB1_, nt_) do { const int _k = (u).e; const int _K = _k ? K1 : K0; const int _lda = _k ? g.lda[1] : g.lda[0]; \
        hA_ = (size_t)HALF * _lda * 2; hB_ = (size_t)HALF * _K * 2; nt_ = _K / BK; \
        cA_ = (const char*)(_k ? g.A[1] : g.A[0]) + (size_t)(u).pm * 2 * hA_ + (size_t)(u).acol * 2; cB_ = (const char*)(_k ? g.Bt[1] : g.Bt[0]) + (size_t)(u).pn * 2 * hB_; \
        vA0_ = _k ? voffA1[0] : voffA0[0]; vA1_ = _k ? voffA1[1] : voffA0[1]; vB0_ = _k ? voffB1[0] : voffB0[0]; vB1_ = _k ? voffB1[1] : voffB0[1]; } while (0)
    const char *cA, *cB, *nA, *nB; size_t chA, chB, nhA, nhB; unsigned cvA0, cvA1, cvB0, cvB1, nvA0, nvA1, nvB0, nvB1; int nt, nnt;
    PG8_CFG(cur, cA, cB, chA, chB, cvA0, cvA1, cvB0, cvB1, nt);
    PG8_STAGE(PG8_SB(0, 0), cB, cvB0, cvB1); PG8_STAGE(PG8_SB(0, 1), cB + chB, cvB0, cvB1); PG8_STAGE(PG8_SA(0, 0), cA, cvA0, cvA1); PG8_STAGE(PG8_SA(0, 1), cA + chA, cvA0, cvA1);
    if (wr == 1) PG8_BAR;
    PG8_WAIT_V(2); PG8_BAR;
    PG8_STAGE(PG8_SB(1, 0), cB + kstep, cvB0, cvB1); PG8_STAGE(PG8_SA(1, 0), cA + kstep, cvA0, cvA1); PG8_STAGE(PG8_SB(1, 1), cB + chB + kstep, cvB0, cvB1);
    PG8_WAIT_V(6); PG8_BAR;
    for (;;) {
        const bool has_next = S.next(ui + 1, nxt);
        if (has_next) { PG8_CFG(nxt, nA, nB, nhA, nhB, nvA0, nvA1, nvB0, nvB1, nnt); }
        else { nA = cA; nB = cB; nhA = chA; nhB = chB; nvA0 = cvA0; nvA1 = cvA1; nvB0 = cvB0; nvB1 = cvB1; nnt = nt; }
        for (int t = 0; t < nt; t += 2) {
            const bool last = (t == nt - 2);
            const char* a1 = cA + (size_t)(t + 1) * kstep;
            const char* a2 = last ? nA : cA + (size_t)(t + 2) * kstep; const char* b2 = last ? nB : cB + (size_t)(t + 2) * kstep;
            const char* a3 = a2 + kstep; const char* b3 = b2 + kstep;
            const size_t hA2 = last ? nhA : chA, hB2 = last ? nhB : chB;
            const unsigned xA0 = last ? nvA0 : cvA0, xA1 = last ? nvA1 : cvA1, xB0 = last ? nvB0 : cvB0, xB1 = last ? nvB1 : cvB1;
            PG8_LDB(B0, 0, 0); PG8_LDB(B1, 0, 1); PG8_SCHED; PG8_LDA(At, 0, 0); PG8_STAGE(PG8_SA(1, 1), a1 + chA, cvA0, cvA1);
            PG8_WAIT_V(8); PG8_WAIT_L(0); PG8_BAR; PG8_MMA(0, 0, At, B0); PG8_MMA(0, 1, At, B1); PG8_BAR; PG8_SCHED;
            PG8_LDA(At, 0, 1); PG8_STAGE(PG8_SB(0, 0), b2, xB0, xB1); PG8_STAGE(PG8_SB(0, 1), b2 + hB2, xB0, xB1); PG8_STAGE(PG8_SA(0, 0), a2, xA0, xA1);
            PG8_WAIT_V(8); PG8_WAIT_L(0); PG8_BAR; PG8_MMA(1, 0, At, B0); PG8_MMA(1, 1, At, B1); PG8_BAR; PG8_SCHED;
            PG8_LDB(B0, 1, 0); PG8_LDB(B1, 1, 1); PG8_SCHED; PG8_LDA(At, 1, 0); PG8_STAGE(PG8_SA(0, 1), a2 + hA2, xA0, xA1);
            PG8_WAIT_V(8); PG8_WAIT_L(0); PG8_BAR; PG8_MMA(0, 0, At, B0); PG8_MMA(0, 1, At, B1); PG8_BAR; PG8_SCHED;
            PG8_LDA(At, 1, 1); PG8_STAGE(PG8_SB(1, 0), b3, xB0, xB1); PG8_STAGE(PG8_SB(1, 1), b3 + hB2, xB0, xB1); PG8_STAGE(PG8_SA(1, 0), a3, xA0, xA1);
            PG8_WAIT_V(8); PG8_WAIT_L(0); PG8_BAR; PG8_MMA(1, 0, At, B0); PG8_MMA(1, 1, At, B1); PG8_BAR; PG8_SCHED;
        }
        if (wr == 0) PG8_BAR;
        E(acc, cur, wr, wc, fr, fq);
        if (sig != nullptr && cur.e == 1) {
            PG8_WAIT_V(0); PG8_BAR;
            if (tid == 0) { __builtin_amdgcn_fence(__ATOMIC_RELEASE, "agent"); __hip_atomic_fetch_add(sig, 1u, __ATOMIC_RELAXED, __HIP_MEMORY_SCOPE_AGENT); } }
        if (!has_next) break;
#pragma unroll
        for (int a = 0; a < 2; ++a)
#pragma unroll
            for (int b = 0; b < 2; ++b)
#pragma unroll
                for (int m = 0; m < 4; ++m)
#pragma unroll
                    for (int n = 0; n < 2; ++n) acc[a][b][m][n] = (f32x4){0.f, 0.f, 0.f, 0.f};
        cur = nxt; cA = nA; cB = nB; chA = nhA; chB = nhB; cvA0 = nvA0; cvA1 = nvA1; cvB0 = nvB0; cvB1 = nvB1; nt = nnt; ++ui;
        if (wr == 1) PG8_BAR;
    }
    PG8_WAIT_V(0);
    PG8_BAR;
#undef PG8_CFG
#undef PG8_SA
#undef PG8_SB
#undef PG8_STAGE
#undef PG8_LDA
#undef PG8_LDB
#undef PG8_MMA
#undef PG8_WAIT_V
#undef PG8_WAIT_L
#undef PG8_BAR
#undef PG8_SCHED
}
}

constexpr int NB = 8, SEQ = 2048, D = 1024, T = NB * SEQ;
constexpr int NH = 16, HS = 64;
constexpr int FFD = 2816, FFE = 3584, NE = 8;
constexpr int QD = 1536;
constexpr int NCAT = 3328;
constexpr int MOE_ROWS = 34816;
constexpr float RMS_EPS = 1e-5f, GN_EPS = 64e-5f;
constexpr float SS_SCALE = 1048576.0f;

constexpr size_t MiB = 1u << 20;
constexpr size_t WS_CTL = 0, CTL_ZERO_BYTES = 32768;
constexpr size_t CTL_LORA_DONE = 1024;
constexpr size_t CTL_BAR = 16384;
constexpr size_t CTL_SS1 = 65536, CTL_SS2 = CTL_SS1 + 131072, CTL_SS3 = CTL_SS2 + 131072;
constexpr size_t CTL_CNT = 524288;
constexpr size_t WS_LIST = 1 * MiB;
constexpr size_t WS_LGATE = WS_LIST + 512 * 1024;
constexpr size_t WS_TOKEP = 2 * MiB;
constexpr size_t WS_TGATE = WS_TOKEP + 128 * 1024;
constexpr size_t WS_SRSTD = WS_TGATE + 128 * 1024;
constexpr size_t WS_SGATE = WS_SRSTD + 160 * 1024;
constexpr size_t WS_WRKV = 3 * MiB;
constexpr size_t WS_WLORA = 9 * MiB;
constexpr size_t WS_WLU = 16 * MiB;
constexpr size_t WS_WO = 18 * MiB;
constexpr size_t WS_W13F = 20 * MiB;
constexpr size_t WS_W2F = 31 * MiB;
constexpr size_t WS_WQKV = 37 * MiB;
constexpr size_t WS_WAO = 46 * MiB;
constexpr size_t WS_R = 47 * MiB, WS_K = 79 * MiB, WS_V = 111 * MiB, WS_LW = 143 * MiB, WS_AA = 175 * MiB, WS_GG = 207 * MiB;
constexpr size_t WS_MH = 3 * MiB;
constexpr size_t WS_MW13 = 241 * MiB;
constexpr size_t WS_MW2 = 297 * MiB;
constexpr size_t WS_HCAT = 353 * MiB;
constexpr size_t WS_XR = 241 * MiB;
constexpr size_t WS_Z = 353 * MiB;
constexpr size_t WS_LH = 417 * MiB;
constexpr size_t WS_X1B = 47 * MiB;
constexpr size_t WS_FH = 79 * MiB;
constexpr size_t WS_X2B = 207 * MiB;
constexpr size_t WS_Q = 47 * MiB, WS_KK = 95 * MiB, WS_VV = 143 * MiB;
constexpr size_t WS_OM = 191 * MiB;
constexpr size_t WS_X3B = 207 * MiB;
constexpr size_t WS_X2F8 = 425 * MiB;
constexpr size_t WS_XG = 325 * MiB;
constexpr size_t WS_CONTRIB = 122 * MiB;
constexpr size_t WS_SLAB = 325 * MiB;
constexpr size_t WS_OG = 353 * MiB;
constexpr size_t WS_LSE = 401 * MiB;
constexpr size_t WS_END = 453 * MiB;

constexpr int NWAVES = 8;
constexpr int LDS_BYTES = 163840;
constexpr int RING_OFF = 0;
constexpr int MISC_OFF = 163840 - 256;

#define GAS __attribute__((address_space(1)))
#define LAS __attribute__((address_space(3)))
typedef unsigned short bf16;
typedef float f32x4 __attribute__((ext_vector_type(4)));
typedef float f32x2 __attribute__((ext_vector_type(2)));
typedef unsigned u32x4 __attribute__((ext_vector_type(4)));
typedef unsigned u32x2 __attribute__((ext_vector_type(2)));

typedef __bf16 bf16x2_t __attribute__((ext_vector_type(2)));
__device__ __forceinline__ unsigned pk2(float lo, float hi) { bf16x2_t v; v.x = (__bf16)lo; v.y = (__bf16)hi; return __builtin_bit_cast(unsigned, v); }
__device__ __forceinline__ float bf_lo(unsigned u) { return __uint_as_float(u << 16); }
__device__ __forceinline__ float bf_hi(unsigned u) { return __uint_as_float(u & 0xffff0000u); }
__device__ __forceinline__ float bf1(bf16 b) { return __uint_as_float(((unsigned)b) << 16); }
__device__ __forceinline__ float fast_rcp(float x) { return __builtin_amdgcn_rcpf(x); }
__device__ __forceinline__ float sigmoidf_(float x) { return __builtin_amdgcn_rcpf(1.0f + __expf(-x)); }

#define XB_TMO      128
#define XB_XCNT(j)  (256  + 64 * (j))
#define XB_XSUB(j)  (1280 + 64 * (j))
#define XB_XGEN(j)  (2304 + 64 * (j))
#define XB_TOP      3328
#define XB_TOPGEN   3392
#define XCD_BAR_WORDS 3456
#define XB_SPIN_CAP (1u << 18)

__device__ __forceinline__ unsigned xb_ld(unsigned* p)              { return __hip_atomic_load(p, __ATOMIC_RELAXED, __HIP_MEMORY_SCOPE_AGENT); }
__device__ __forceinline__ unsigned xb_add(unsigned* p, unsigned v) { return __hip_atomic_fetch_add(p, v, __ATOMIC_RELAXED, __HIP_MEMORY_SCOPE_AGENT); }
__device__ __forceinline__ unsigned xb_xcc_id() { return (unsigned)__builtin_amdgcn_s_getreg((3 << 11) | 20) & 0xFu; }
#define XB_SPIN(cond, bar) do { unsigned _sp = 0; while (cond) { __builtin_amdgcn_s_sleep(1); \
    if ((++_sp & 255u) == 0u) { if (xb_ld(&(bar)[XB_TMO])) break; if (_sp > XB_SPIN_CAP) { atomicAdd(&(bar)[XB_TMO], 1u); break; } } } } while (0)

struct XcdBarrier { unsigned* bar; unsigned x; volatile LAS unsigned* st; };

__device__ __forceinline__ XcdBarrier xcd_barrier_post(unsigned* bar, volatile LAS unsigned* st) {
    XcdBarrier b; b.bar = bar; b.x = xb_xcc_id(); b.st = st;
    if (threadIdx.x == 0) (void)xb_add(&bar[XB_XCNT(b.x)], 1u);
    return b;
}
__device__ __forceinline__ void xcd_barrier_complete(unsigned* bar, unsigned x, unsigned& nloc, unsigned& nx) {
    const unsigned G = gridDim.x * gridDim.y * gridDim.z;
    unsigned sum, cnt, mine, sp = 0u;
    for (;;) {
        sum = 0u; cnt = 0u; mine = 0u;
#pragma unroll
        for (unsigned j = 0; j < 16; ++j) { const unsigned c = xb_ld(&bar[XB_XCNT(j)]); sum += c; cnt += (c > 0u) ? 1u : 0u; mine = (j == x) ? c : mine; }
        if (sum == G) break;
        __builtin_amdgcn_s_sleep(1);
        if ((++sp & 255u) == 0u) { if (xb_ld(&bar[XB_TMO])) break; if (sp > XB_SPIN_CAP) { atomicAdd(&bar[XB_TMO], 1u); break; } }
    }
    nloc = mine > 0u ? mine : 1u; nx = cnt > 0u ? cnt : 1u;
}
__device__ __forceinline__ void xcd_barrier(const XcdBarrier& b) {
    asm volatile("s_waitcnt vmcnt(0)" ::: "memory");
    __syncthreads();
    if (threadIdx.x == 0) {
        unsigned* bar = b.bar;
        __builtin_amdgcn_s_waitcnt(0);
        unsigned nloc = b.st[0], nx = b.st[1];
        if (nloc == 0u) { xcd_barrier_complete(bar, b.x, nloc, nx); b.st[0] = nloc; b.st[1] = nx; }
        const unsigned old = xb_add(&bar[XB_XSUB(b.x)], 1u);
        const unsigned gen = old / nloc;
        if (old + 1u == (gen + 1u) * nloc) {
            __builtin_amdgcn_fence(__ATOMIC_RELEASE, "agent");
            asm volatile("s_waitcnt vmcnt(0)" ::: "memory");
            const unsigned og = xb_add(&bar[XB_TOP], 1u);
            const unsigned tg = og / nx;
            if (og + 1u == (tg + 1u) * nx) xb_add(&bar[XB_TOPGEN], 1u);
            else XB_SPIN(xb_ld(&bar[XB_TOPGEN]) == tg, bar);
            __builtin_amdgcn_fence(__ATOMIC_ACQUIRE, "agent");
            xb_add(&bar[XB_XGEN(b.x)], 1u);
            asm volatile("s_waitcnt vmcnt(0)" ::: "memory");
        } else {
            XB_SPIN(xb_ld(&bar[XB_XGEN(b.x)]) == gen, bar);
            __builtin_amdgcn_fence(__ATOMIC_ACQUIRE, "agent");
            asm volatile("s_waitcnt vmcnt(0)" ::: "memory");
        }
    }
    __syncthreads();
}

struct Args { const float* in[33]; float* out; unsigned char* ws; int ph_lo, ph_hi; };
enum { I_X = 0, I_NG, I_MU, I_WR, I_WK, I_WV, I_W0, I_W1, I_W2, I_A0, I_A1, I_A2, I_G1, I_G2, I_KK, I_KA, I_RK, I_LNW, I_LNB, I_WO, I_KVG, I_WKV, I_WQ, I_AWO,
       I_F1, I_F3, I_F2, I_ROUTER, I_RBIAS, I_M1, I_M3, I_M2, I_FG };

struct TrJob { const float* src; int K, N; bf16* dst; int ldd, drow, dcol; const float* sc; int mode  , ileave  ; };
__device__ __forceinline__ int trjob_items(const TrJob& j) { return (j.K >> 6) * (j.N >> 6); }
__device__ __forceinline__ void tr_item(const TrJob& j, int item, LAS float* scr, int lane) {
    const int nblk = j.N >> 6, kb = item / nblk, nb = item - kb * nblk, k0 = kb << 6, n0 = nb << 6;
    const int lr = lane >> 4, n4 = (lane & 15) * 4;
#pragma unroll
    for (int half = 0; half < 2; ++half) {
        f32x4 v[8];
#pragma unroll
        for (int i = 0; i < 8; ++i) { const int kk = half * 32 + i * 4 + lr; v[i] = __builtin_nontemporal_load((const GAS f32x4*)(j.src + (size_t)(k0 + kk) * j.N + n0 + n4)); }
#pragma unroll
        for (int i = 0; i < 8; ++i) { const int kk = half * 32 + i * 4 + lr; float s = 1.0f;
            if (j.mode == 1) s = j.sc[k0 + kk]; else if (j.mode == 2) s = 1.0f - j.sc[k0 + kk];
            *(LAS f32x4*)(scr + kk * 68 + ((n4 + 4 * (kk >> 3)) & 63)) = v[i] * s; }
    }
    asm volatile("s_waitcnt lgkmcnt(0)" ::: "memory");
    const int c8 = lane & 7;
#pragma unroll
    for (int it = 0; it < 8; ++it) {
        const int n = it * 8 + (lane >> 3); const int col = (n + 4 * c8) & 63;
        const LAS float* s = scr + (8 * c8) * 68 + col;
        u32x4 o; o.x = pk2(s[0 * 68], s[1 * 68]); o.y = pk2(s[2 * 68], s[3 * 68]); o.z = pk2(s[4 * 68], s[5 * 68]); o.w = pk2(s[6 * 68], s[7 * 68]);
        const int ng = n0 + n; int row = j.drow + ng;
        if (j.ileave) row = j.drow + (ng >> 7) * 256 + (j.ileave - 1) * 128 + (ng & 127);
        *(GAS u32x4*)(j.dst + (size_t)row * j.ldd + j.dcol + k0 + 8 * c8) = o;
    }
    asm volatile("s_waitcnt lgkmcnt(0)" ::: "memory");
}

__device__ __forceinline__ unsigned pk4_fp8(float a, float b, float c, float d) { int w = 0; w = __builtin_amdgcn_cvt_pk_fp8_f32(a, b, w, false); w = __builtin_amdgcn_cvt_pk_fp8_f32(c, d, w, true); return (unsigned)w; }
__device__ __forceinline__ float clamp_fp8(float x) { return __builtin_amdgcn_fmed3f(x, -448.0f, 448.0f); }
struct TrJob8 { const float* src; int K, N; unsigned char* dst; int ldd; const float* sc; float mul; int ileave; };
__device__ __forceinline__ void tr_item8(const TrJob8& j, int item, LAS float* scr, int lane) {
    const int nblk = j.N >> 6, kb = item / nblk, nb = item - kb * nblk, k0 = kb << 6, n0 = nb << 6;
    const int lr = lane >> 4, n4 = (lane & 15) * 4;
#pragma unroll
    for (int half = 0; half < 2; ++half) {
        f32x4 v[8];
#pragma unroll
        for (int i = 0; i < 8; ++i) { const int kk = half * 32 + i * 4 + lr; v[i] = __builtin_nontemporal_load((const GAS f32x4*)(j.src + (size_t)(k0 + kk) * j.N + n0 + n4)); }
#pragma unroll
        for (int i = 0; i < 8; ++i) { const int kk = half * 32 + i * 4 + lr; const float s = j.sc ? j.sc[k0 + kk] * j.mul : j.mul;
            *(LAS f32x4*)(scr + kk * 68 + ((n4 + 4 * (kk >> 3)) & 63)) = v[i] * s; }
    }
    asm volatile("s_waitcnt lgkmcnt(0)" ::: "memory");
    const int c16 = lane & 3;
#pragma unroll
    for (int it = 0; it < 4; ++it) {
        const int n = it * 16 + (lane >> 2);
        u32x4 o; unsigned wv[4];
#pragma unroll
        for (int q = 0; q < 4; ++q) { const int c8 = 2 * c16 + (q >> 1), kb8 = 8 * c8 + 4 * (q & 1); const LAS float* sp = scr + kb8 * 68 + ((n + 4 * c8) & 63);
            wv[q] = pk4_fp8(sp[0], sp[68], sp[2 * 68], sp[3 * 68]); }
        o.x = wv[0]; o.y = wv[1]; o.z = wv[2]; o.w = wv[3];
        const int ng = n0 + n; int row = ng;
        if (j.ileave) row = (ng >> 7) * 256 + (j.ileave - 1) * 128 + (ng & 127);
        *(GAS u32x4*)(j.dst + (size_t)row * j.ldd + k0 + 16 * c16) = o;
    }
    asm volatile("s_waitcnt lgkmcnt(0)" ::: "memory");
}
constexpr int NJ0 = 3 + 6 + 3 + 1 + 2 + 1;
constexpr int NJ_EARLY = 12;
__device__ __forceinline__ TrJob job0(const Args& a, int j) {
    unsigned char* ws = a.ws; TrJob t; t.ileave = 0; t.mode = 0; t.sc = nullptr; t.dcol = 0; t.drow = 0;
    if (j < 3) { t.src = j == 0 ? a.in[I_WR] : (j == 1 ? a.in[I_WK] : a.in[I_WV]); t.K = 1024; t.N = 1024; t.dst = (bf16*)(ws + WS_WRKV); t.ldd = 1024; t.drow = 1024 * j; return t; }
    j -= 3;
    if (j < 6) {
        const int w = j >> 1, hi = j & 1;
        t.src = w == 0 ? a.in[I_W1] : (w == 1 ? a.in[I_A1] : a.in[I_G1]); const int mu = w == 0 ? 1 : (w == 1 ? 4 : 5);
        t.K = 1024; t.N = w == 2 ? 128 : 64; t.dst = (bf16*)(ws + WS_WLORA); t.ldd = 2048; t.drow = 64 * w; t.dcol = hi * 1024; t.sc = a.in[I_MU] + mu * D; t.mode = hi ? 2 : 1;
        return t; }
    j -= 6;
    if (j < 3) {
        t.src = j == 0 ? a.in[I_W2] : (j == 1 ? a.in[I_A2] : a.in[I_G2]); t.K = j == 2 ? 128 : 64; t.N = 1024; t.dst = (bf16*)(ws + WS_WLU); t.ldd = 128; t.drow = 1024 * j; t.dcol = j == 1 ? 64 : 0; return t; }
    j -= 3;
    if (j < 1) { t.src = a.in[I_WO]; t.K = 1024; t.N = 1024; t.dst = (bf16*)(ws + WS_WO); t.ldd = 1024; return t; }
    j -= 1;
    if (j < 2) { t.src = a.in[j ? I_F3 : I_F1]; t.K = 1024; t.N = FFD; t.dst = (bf16*)(ws + WS_W13F); t.ldd = 1024; t.sc = a.in[I_NG] + 1 * D; t.mode = 1; t.ileave = 1 + j; return t; }
    j -= 2;
    t.src = a.in[I_AWO]; t.K = 512; t.N = 1024; t.dst = (bf16*)(ws + WS_WAO); t.ldd = 512; return t;
}
constexpr float MW13_MUL = 64.0f, MW2_MUL = 128.0f, WQKV_MUL = 64.0f; constexpr int MW13_SCALE_BYTE = 127 - 6, MW2_SCALE_BYTE = 127 - 7, WQKV_SCALE_BYTE = 127 - 6;
__device__ __forceinline__ TrJob8 job_moe(const Args& a, int j) {
    TrJob8 t;
    if (j < 16) { const int e = j >> 1, w = j & 1;
        t.src = a.in[w ? I_M3 : I_M1] + (size_t)e * D * FFE; t.K = 1024; t.N = FFE; t.dst = a.ws + WS_MW13 + (size_t)e * 7168 * 1024; t.ldd = 1024; t.sc = a.in[I_NG] + 3 * D; t.mul = MW13_MUL; t.ileave = 1 + w; }
    else if (j == 26) { t.src = a.in[I_F2]; t.K = FFD; t.N = 1024; t.dst = a.ws + WS_W2F; t.ldd = FFD; t.sc = nullptr; t.mul = MW2_MUL; t.ileave = 0; }
    else if (j == 24) { t.src = a.in[I_WQ]; t.K = 1024; t.N = QD; t.dst = a.ws + WS_WQKV; t.ldd = 1024; t.sc = a.in[I_NG] + 2 * D; t.mul = WQKV_MUL; t.ileave = 0; }
    else if (j == 25) { t.src = a.in[I_WKV]; t.K = 1024; t.N = 2 * QD; t.dst = a.ws + WS_WQKV + (size_t)QD * 1024; t.ldd = 1024; t.sc = a.in[I_KVG]; t.mul = WQKV_MUL; t.ileave = 0; }
    else { const int e = j - 16;
        t.src = a.in[I_M2] + (size_t)e * FFE * D; t.K = FFE; t.N = 1024; t.dst = a.ws + WS_MW2 + (size_t)e * 1024 * FFE; t.ldd = FFE; t.sc = nullptr; t.mul = MW2_MUL; t.ileave = 0; }
    return t;
}
__device__ __forceinline__ float wave_sum(float v) {
#pragma unroll
    for (int o = 1; o < 64; o <<= 1) v += __shfl_xor(v, o);
    return v;
}
__device__ __forceinline__ float row16_sum(float v) {
    v += __builtin_bit_cast(float, __builtin_amdgcn_update_dpp(0, __builtin_bit_cast(int, v), 0xB1, 0xf, 0xf, false));
    v += __builtin_bit_cast(float, __builtin_amdgcn_update_dpp(0, __builtin_bit_cast(int, v), 0x4E, 0xf, 0xf, false));
    v += __builtin_bit_cast(float, __builtin_amdgcn_update_dpp(0, __builtin_bit_cast(int, v), 0x141, 0xf, 0xf, false));
    v += __builtin_bit_cast(float, __builtin_amdgcn_update_dpp(0, __builtin_bit_cast(int, v), 0x140, 0xf, 0xf, false));
    return v;
}


using pg8::Unit;
__device__ __forceinline__ float rstd_from_ss(const unsigned long long* ss, int row) {
    const float s = (float)ss[row] * (1.0f / SS_SCALE);
    return __builtin_amdgcn_rsqf(s * (1.0f / D) + RMS_EPS);
}
struct G1Order {
    int G, c;
    __device__ bool next(int i, Unit& u) const {
        int L;
        if (c < 64) { if (i == 0) { u.pm = c; u.pn = 0; u.e = 1; u.acol = (c >> 3) * 1024; return true; }
        if (i > 2) return false; L = (i - 1) * 64 + c; }
        else { L = 128 + (c - 64) + (G - 64) * i; if (L >= 768) return false; }
        const int xcd = L % 8, off = L / 8, wgid = xcd * 96 + off;
        const int gid = wgid / 32, fm = gid * 8;
        u.pm = fm + ((wgid % 32) % 8); u.pn = (u.pm >> 6) * 4 + (wgid % 32) / 8; u.e = 0; u.acol = 0; return true;
    }
};
struct EpiG1 {
    bf16 *r, *lh;
    __device__ __forceinline__ void operator()(const f32x4 (&acc)[2][2][4][2], const Unit& u, int wr, int wc, int fr, int fq) const {
        const int cw = wc * 32 + 8 * fq;
        if (u.e == 0) {
            const int which = u.pn >> 2, row0 = (u.pm - 64 * which) * 256 + wr * 64 + fr;
            bf16* base = r + (size_t)which * ((size_t)T * D); const int colt = (u.pn & 3) * 256 + cw;
#pragma unroll
            for (int ai = 0; ai < 2; ++ai)
#pragma unroll
                for (int m = 0; m < 4; ++m) { bf16* rowp = base + (size_t)(row0 + ai * 128 + m * 16) * D + colt;
#pragma unroll
                    for (int bj = 0; bj < 2; ++bj) { const f32x4 v0 = acc[ai][bj][m][0], v1 = acc[ai][bj][m][1];
                        u32x4 w; w.x = pk2(v0[0], v0[1]); w.y = pk2(v0[2], v0[3]); w.z = pk2(v1[0], v1[1]); w.w = pk2(v1[2], v1[3]);
                        *(GAS u32x4*)(rowp + bj * 128) = w; } }
        } else {
            const int row0 = u.pm * 256 + wr * 64 + fr;
#pragma unroll
            for (int ai = 0; ai < 2; ++ai)
#pragma unroll
                for (int m = 0; m < 4; ++m) { bf16* rowp = lh + (size_t)(row0 + ai * 128 + m * 16) * 256 + cw;
#pragma unroll
                    for (int bj = 0; bj < 2; ++bj) { const int c = cw + bj * 128; float x[8];
#pragma unroll
                        for (int i = 0; i < 4; ++i) { x[i] = acc[ai][bj][m][0][i]; x[4 + i] = acc[ai][bj][m][1][i]; }
#pragma unroll
                        for (int i = 0; i < 8; ++i) { if (c < 64) x[i] = 1.0f - 2.0f * __builtin_amdgcn_rcpf(1.0f + __expf(2.0f * x[i])); else if (c >= 128) x[i] = sigmoidf_(x[i]); }
                        u32x4 w; w.x = pk2(x[0], x[1]); w.y = pk2(x[2], x[3]); w.z = pk2(x[4], x[5]); w.w = pk2(x[6], x[7]);
                        *(GAS u32x4*)(rowp + bj * 128) = w; } }
        }
    }
};
struct G2Order { pg8::StaticOrder so;
    __device__ bool next(int i, Unit& u) const {
        if (so.G == 256) { int L; if (so.c >= 128) { if (i >= 4) return false; L = i * 128 + so.c - 128; } else { if (i >= 2) return false; L = 512 + i * 128 + so.c; }
            pg8::static_map(L, so.nM, so.nN, so.nwg, u); }
        else if (!so.next(i, u)) return false;
        u.acol = u.pn >= 8 ? 128 : 0; return true; } };
struct EpiG2 {
    bf16 *lw; const float *w0, *a0;
    __device__ __forceinline__ void operator()(const f32x4 (&acc)[2][2][4][2], const Unit& u, int wr, int wc, int fr, int fq) const {
        const int row0 = u.pm * 256 + wr * 64 + fr, which = u.pn >> 2, colt = (u.pn & 3) * 256 + wc * 32 + 8 * fq;
        bf16* base = lw + (size_t)which * ((size_t)T * D);
        const float* bp = which == 0 ? w0 : a0; const float bsc = which == 2 ? 0.f : 1.f, osc = which == 0 ? -0.6065306597f * 1.4426950408889634f : 1.0f;
#pragma unroll
        for (int bj = 0; bj < 2; ++bj) {
            const f32x4 b0 = *(const GAS f32x4*)(bp + colt + bj * 128) * bsc, b1 = *(const GAS f32x4*)(bp + colt + bj * 128 + 4) * bsc;
#pragma unroll
            for (int ai = 0; ai < 2; ++ai)
#pragma unroll
                for (int m = 0; m < 4; ++m) { bf16* rowp = base + (size_t)(row0 + ai * 128 + m * 16) * D + colt; float x[8];
#pragma unroll
                    for (int i = 0; i < 4; ++i) { x[i] = acc[ai][bj][m][0][i] + b0[i]; x[4 + i] = acc[ai][bj][m][1][i] + b1[i]; }
                    if (which != 2) {
#pragma unroll
                        for (int i = 0; i < 8; ++i) x[i] = osc * sigmoidf_(x[i]);
                    }
                    u32x4 w; w.x = pk2(x[0], x[1]); w.y = pk2(x[2], x[3]); w.z = pk2(x[4], x[5]); w.w = pk2(x[6], x[7]);
                    *(GAS u32x4*)(rowp + bj * 128) = w;
                    asm volatile("" ::: "memory"); }
        }
    }
};
template <bool R32> struct EpiResT {
    const float* resid32; const bf16* resid16; bf16* xb; unsigned long long* ss; unsigned char* x8;
    __device__ __forceinline__ void load(int row0, int col0, int st, f32x4 (&r)[4], u32x4 (&h)[2]) const {
        const size_t off = (size_t)(row0 + (st >> 2) * 128 + (st & 3) * 16) * D + col0;
        if constexpr (R32) { r[0] = *(const GAS f32x4*)(resid32 + off); r[1] = *(const GAS f32x4*)(resid32 + off + 4); r[2] = *(const GAS f32x4*)(resid32 + off + 128); r[3] = *(const GAS f32x4*)(resid32 + off + 132); }
        else { h[0] = *(const GAS u32x4*)(resid16 + off); h[1] = *(const GAS u32x4*)(resid16 + off + 128); }
    }
    __device__ __forceinline__ void operator()(const f32x4 (&acc)[2][2][4][2], const Unit& u, int wr, int wc, int fr, int fq) const {
        const int row0 = u.pm * 256 + wr * 64 + fr, col0 = u.pn * 256 + wc * 32 + 8 * fq;
        constexpr int DIST = R32 ? 1 : 3;
        f32x4 ring[4][4]; u32x4 ringh[4][2];
#pragma unroll
        for (int st = 0; st < DIST; ++st) load(row0, col0, st, ring[st], ringh[st]);
#pragma unroll
        for (int st = 0; st < 8; ++st) { const int ai = st >> 2, m = st & 3;
            if (st + DIST < 8) load(row0, col0, st + DIST, ring[(st + DIST) & 3], ringh[(st + DIST) & 3]);
            const int row = row0 + ai * 128 + m * 16; const size_t off = (size_t)row * D + col0; float sq = 0.f;
#pragma unroll
            for (int bj = 0; bj < 2; ++bj) {
                f32x4 r0, r1;
                if constexpr (R32) { r0 = ring[st & 3][2 * bj]; r1 = ring[st & 3][2 * bj + 1]; }
                else { const u32x4 rw = ringh[st & 3][bj]; r0 = (f32x4){bf_lo(rw.x), bf_hi(rw.x), bf_lo(rw.y), bf_hi(rw.y)}; r1 = (f32x4){bf_lo(rw.z), bf_hi(rw.z), bf_lo(rw.w), bf_hi(rw.w)}; }
                const f32x4 o0 = r0 + acc[ai][bj][m][0], o1 = r1 + acc[ai][bj][m][1];
                u32x4 w; w.x = pk2(o0[0], o0[1]); w.y = pk2(o0[2], o0[3]); w.z = pk2(o1[0], o1[1]); w.w = pk2(o1[2], o1[3]);
                *(GAS u32x4*)(xb + off + bj * 128) = w;
                if (x8) { u32x2 w8; w8.x = pk4_fp8(clamp_fp8(o0[0]), clamp_fp8(o0[1]), clamp_fp8(o0[2]), clamp_fp8(o0[3])); w8.y = pk4_fp8(clamp_fp8(o1[0]), clamp_fp8(o1[1]), clamp_fp8(o1[2]), clamp_fp8(o1[3])); *(GAS u32x2*)(x8 + off + bj * 128) = w8; }
                sq += (o0[0] * o0[0] + o0[1] * o0[1]) + (o0[2] * o0[2] + o0[3] * o0[3]) + (o1[0] * o1[0] + o1[1] * o1[1]) + (o1[2] * o1[2] + o1[3] * o1[3]); }
            sq += __shfl_xor(sq, 16); sq += __shfl_xor(sq, 32);
            if (fq == 0) atomicAdd(ss + row, (unsigned long long)(sq * SS_SCALE + 0.5f)); }
    }
};
template <bool HM> struct EpiSwigluT {
    bf16* hid; int ldc; const unsigned long long* ss; const float* srstd; int out8; const LAS float* rtab;
    __device__ __forceinline__ void operator()(const f32x4 (&acc)[2][2][4][2], const Unit& u, int wr, int wc, int fr, int fq) const {
        const int row0 = u.pm * 256 + wr * 64 + fr + (HM ? u.mh * 128 : 0), col0 = u.pn * 128 + wc * 32 + 8 * fq;
        float rsv[2][4];
#pragma unroll
        for (int ai = 0; ai < (HM ? 1 : 2); ++ai)
#pragma unroll
            for (int m = 0; m < 4; ++m) { const int row = row0 + ai * 128 + m * 16; rsv[ai][m] = rtab ? rtab[row & 2047] : (ss ? rstd_from_ss(ss, row) : (srstd ? srstd[row] : 1.0f)); }
#pragma unroll
        for (int ai = 0; ai < (HM ? 1 : 2); ++ai)
#pragma unroll
            for (int m = 0; m < 4; ++m) { const int row = row0 + ai * 128 + m * 16; const float rs = rsv[ai][m], rs2 = rs * rs, nrl = -1.4426950408889634f * rs; float x[8];
#pragma unroll
                for (int n = 0; n < 2; ++n)
#pragma unroll
                    for (int i = 0; i < 4; ++i) { const float a = acc[ai][0][m][n][i], b = acc[ai][1][m][n][i]; x[n * 4 + i] = (a * rs2) * b * __builtin_amdgcn_rcpf(1.0f + __builtin_amdgcn_exp2f(a * nrl)); if (out8) x[n * 4 + i] = clamp_fp8(x[n * 4 + i]); }
                if (out8) { u32x2 w; w.x = pk4_fp8(x[0], x[1], x[2], x[3]); w.y = pk4_fp8(x[4], x[5], x[6], x[7]); *(GAS u32x2*)((unsigned char*)hid + (size_t)row * ldc + col0) = w; }
                else { u32x4 w; w.x = pk2(x[0], x[1]); w.y = pk2(x[2], x[3]); w.z = pk2(x[4], x[5]); w.w = pk2(x[6], x[7]);
                    *(GAS u32x4*)(hid + (size_t)row * ldc + col0) = w; } }
    }
};
typedef EpiSwigluT<false> EpiSwiglu;
template <bool HM> struct EpiQKVT {
    bf16 *q; const unsigned long long* ss; const LAS float* rtab;
    __device__ __forceinline__ void operator()(const f32x4 (&acc)[2][2][4][2], const Unit& u, int wr, int wc, int fr, int fq) const {
        const int row0 = u.pm * 256 + wr * 64 + fr + (HM ? u.mh * 128 : 0), which = u.pn / 6, pnl = u.pn - which * 6, g = pnl >> 1, sh = 2 * g;
        const int h0 = (pnl & 1) * 4 + (wc >> 1), d0 = (wc & 1) * 32 + 8 * fq;
        bf16* base = q + (size_t)which * ((size_t)T * QD);
        float rsv[2][4];
#pragma unroll
        for (int ai = 0; ai < (HM ? 1 : 2); ++ai)
#pragma unroll
            for (int m = 0; m < 4; ++m) { const int row = row0 + ai * 128 + m * 16; rsv[ai][m] = rtab ? rtab[row & 2047] : rstd_from_ss(ss, row); }
#pragma unroll
        for (int ai = 0; ai < (HM ? 1 : 2); ++ai)
#pragma unroll
            for (int m = 0; m < 4; ++m) { const int row = row0 + ai * 128 + m * 16; const float rs = rsv[ai][m];
                const int b = row >> 11, sq = row & 2047, pos = ((sq & ((1 << sh) - 1)) << (11 - sh)) + (sq >> sh);
                bf16* rowp = base + ((size_t)((b * 3 + g) * 8 + h0) * 2048 + pos) * 64 + d0;
#pragma unroll
                for (int bj = 0; bj < 2; ++bj) { const f32x4 v0 = acc[ai][bj][m][0] * rs, v1 = acc[ai][bj][m][1] * rs;
                    u32x4 w; w.x = pk2(v0[0], v0[1]); w.y = pk2(v0[2], v0[3]); w.z = pk2(v1[0], v1[1]); w.w = pk2(v1[2], v1[3]);
                    *(GAS u32x4*)(rowp + bj * (2 * 2048 * 64)) = w; } }
    }
};
typedef EpiQKVT<false> EpiQKV;
struct EpiGate {
    bf16* c; bf16* slab; int MTf;
    __device__ __forceinline__ void operator()(const f32x4 (&acc)[2][2][4][2], const Unit& u, int wr, int wc, int fr, int fq) const {
        const int col0 = u.pn * 256 + wc * 32 + 8 * fq;
        bf16* base = u.slice < 0 ? c + (size_t)(u.pm * 256) * D : slab + ((size_t)u.slice * 2048 + (size_t)(u.pm - MTf) * 256) * D;
        const int row0 = wr * 64 + fr;
#pragma unroll
        for (int ai = 0; ai < 2; ++ai)
#pragma unroll
            for (int m = 0; m < 4; ++m) { const int row = row0 + ai * 128 + m * 16; bf16* rowp = base + (size_t)row * D + col0;
#pragma unroll
                for (int bj = 0; bj < 2; ++bj) { const f32x4 v0 = acc[ai][bj][m][0], v1 = acc[ai][bj][m][1];
                    u32x4 w; w.x = pk2(v0[0], v0[1]); w.y = pk2(v0[2], v0[3]); w.z = pk2(v1[0], v1[1]); w.w = pk2(v1[2], v1[3]);
                    *(GAS u32x4*)(rowp + bj * 128) = w; } }
    }
};

struct Frame { LAS unsigned char* lds; int tid, lane, wave, G, bid; };

__device__ __forceinline__ void run_jobs(const Args& a, Frame& F, int j0, int j1, int gw, int NGW) {
    LAS float* scr = (LAS float*)(F.lds) + F.wave * (64 * 68);
    int base = 0;
    for (int j = j0; j < j1; ++j) {
        const TrJob t = job0(a, j);
        const int ni = trjob_items(t);
        int first = (gw - (base % NGW) + NGW) % NGW;
        for (int it = first; it < ni; it += NGW) tr_item(t, it, scr, F.lane);
        base += ni;
    }
}
__device__ __forceinline__ void run_jobs_moe(const Args& a, Frame& F, int gw, int NGW, int lo, int hi) {
    LAS float* scr = (LAS float*)(F.lds) + F.wave * (64 * 68);
    constexpr int NMOE = 24 * 896, NQ = (1024 / 64) * (QD / 64), NKV = (1024 / 64) * (2 * QD / 64), NF2 = (FFD / 64) * (1024 / 64);
    static_assert((NMOE + NQ + NKV + NF2) % 32 == 0, "item count");
    const int wsh = hi - lo, total = ((NMOE + NQ + NKV + NF2) / 32) * wsh;
    for (int r = gw; r < total; r += NGW) {
        const int gi = (r / wsh) * 32 + lo + (r % wsh); int j, it;
        if (gi < NMOE) { j = gi / 896; it = gi - j * 896; } else if (gi < NMOE + NQ) { j = 24; it = gi - NMOE; } else if (gi < NMOE + NQ + NKV) { j = 25; it = gi - NMOE - NQ; } else { j = 26; it = gi - NMOE - NQ - NKV; }
        const TrJob8 t = job_moe(a, j);
        tr_item8(t, it, scr, F.lane);
    }
}
__device__ __forceinline__ void p0_zero(const Args& a, Frame& F) {
    const int gt = F.bid * (NWAVES * 64) + F.tid, NT = F.G * NWAVES * 64;
    GAS u32x4* z = (GAS u32x4*)(a.ws + CTL_SS1);
    for (int i = gt; i < (int)(3 * 131072 / 16); i += NT) z[i] = (u32x4){0u, 0u, 0u, 0u};
    if (gt < 2) ((GAS u32x4*)(a.ws + CTL_CNT))[gt] = (u32x4){0u, 0u, 0u, 0u};
    if (gt < 8 * 128) *(GAS u32x4*)((bf16*)(a.ws + WS_HCAT) + (size_t)(gt >> 7) * 2049 * 1024 + 8 * (gt & 127)) = (u32x4){0u, 0u, 0u, 0u};
    bf16* wlu = (bf16*)(a.ws + WS_WLU);
    for (int i = gt; i < 2048 * 8; i += NT) { const int row = i >> 3, ch = i & 7; *(GAS u32x4*)(wlu + (size_t)row * 128 + (row < 1024 ? 64 : 0) + 8 * ch) = (u32x4){0u, 0u, 0u, 0u}; }
}
__device__ __forceinline__ void p0_hcat(const Args& a, Frame& F) {
    const float* x = a.in[I_X]; const float* g = a.in[I_NG];
    bf16* hc = (bf16*)(a.ws + WS_HCAT); bf16* xr = (bf16*)(a.ws + WS_XR);
    const float* mu = a.in[I_MU];
    const int gw = F.bid * NWAVES + F.wave, NGW = F.G * NWAVES;
    constexpr int RPW = 8;
    f32x4 gv[4], m0v[4], m2v[4], m3v[4];
#pragma unroll
    for (int j = 0; j < 4; ++j) { const int c = 4 * F.lane + 256 * j; gv[j] = *(const GAS f32x4*)(g + c); m0v[j] = *(const GAS f32x4*)(mu + 0 * D + c); m2v[j] = *(const GAS f32x4*)(mu + 2 * D + c); m3v[j] = *(const GAS f32x4*)(mu + 3 * D + c); }
    for (int blk = gw; blk < T / RPW; blk += NGW) {
        const int m0 = blk * RPW;
        f32x4 hp[4], v[4], nv[4];
#pragma unroll
        for (int j = 0; j < 4; ++j) hp[j] = (f32x4){0.f, 0.f, 0.f, 0.f};
        const int mi0 = ((m0 & (SEQ - 1)) != 0 ? -1 : 0);
        { const GAS f32x4* xrw = (const GAS f32x4*)(x + (size_t)(m0 + mi0) * D) + F.lane;
#pragma unroll
          for (int j = 0; j < 4; ++j) v[j] = __builtin_nontemporal_load(xrw + 64 * j); }
        for (int mi = mi0; mi < RPW; ++mi) {
            const int m = m0 + mi;
            if (mi + 1 < RPW) { const GAS f32x4* xrw = (const GAS f32x4*)(x + (size_t)(m + 1) * D) + F.lane;
#pragma unroll
                for (int j = 0; j < 4; ++j) nv[j] = __builtin_nontemporal_load(xrw + 64 * j); }
            float s = 0.f;
#pragma unroll
            for (int j = 0; j < 4; ++j) s += (v[j].x * v[j].x + v[j].y * v[j].y) + (v[j].z * v[j].z + v[j].w * v[j].w);
            const float rstd = 1.f / sqrtf(wave_sum(s) * (1.f / D) + RMS_EPS);
#pragma unroll
            for (int j = 0; j < 4; ++j) { const int c = 4 * F.lane + 256 * j;
                const f32x4 h = v[j] * rstd * gv[j];
                if (mi >= 0) {
                    const f32x4 dlt = hp[j] - h;
                    u32x2 w; w.x = pk2(h.x, h.y); w.y = pk2(h.z, h.w);
                    *(GAS u32x2*)(hc + ((size_t)m + (m >> 11) + 1) * 1024 + c) = w;
                    const f32x4 r4 = h + dlt * m0v[j], k4 = h + dlt * m2v[j], v4 = h + dlt * m3v[j];
                    w.x = pk2(r4.x, r4.y); w.y = pk2(r4.z, r4.w); *(GAS u32x2*)(xr + (size_t)m * D + c) = w;
                    w.x = pk2(k4.x, k4.y); w.y = pk2(k4.z, k4.w); *(GAS u32x2*)(xr + ((size_t)T + m) * D + c) = w;
                    w.x = pk2(v4.x, v4.y); w.y = pk2(v4.z, v4.w); *(GAS u32x2*)(xr + ((size_t)2 * T + m) * D + c) = w;
                }
                hp[j] = h; }
#pragma unroll
            for (int j = 0; j < 4; ++j) v[j] = nv[j];
        }
    }
}

constexpr int CH_NS = 8;
constexpr int CH_RS = 72;
constexpr int CH_OFF_AT = 0, CH_OFF_RT = 2304, CH_OFF_BB = 4608, CH_OFF_KB = 4608 + 2304, CH_OFF_VV = 4608 + 2 * 2304, CH_OFF_MKA = 4608 + 3 * 2304, CH_OFF_TT = CH_OFF_MKA + 512,
              CH_OFF_NBR = CH_OFF_TT + 512, CH_OFF_NKR = CH_OFF_NBR + 512, CH_OFF_MF = CH_OFF_NKR + 512, CH_OFF_GC = CH_OFF_MF + 1024, CH_OFF_RK = CH_OFF_GC + 256, CH_SLOT = CH_OFF_RK + 64;
constexpr int CH_YBUF = CH_NS * CH_SLOT;
constexpr int CH_PAR = CH_YBUF + 8 * 4608;
static_assert(CH_PAR + 768 <= MISC_OFF && (CH_SLOT % 16) == 0 && (CH_PAR % 16) == 0, "chunked scan LDS map");
#define ROW_SHR_ADD(x, ctrl) x += __builtin_bit_cast(float, __builtin_amdgcn_update_dpp(0, __builtin_bit_cast(int, x), ctrl, 0xf, 0xf, true))
template <int PARTS = 7>
__device__ __forceinline__ void p3_scan_chunked(const Args& a, Frame& F, int pair) {
    typedef short bf16x8 __attribute__((ext_vector_type(8)));
    unsigned char* ws = a.ws;
    const bf16 *Rg = (const bf16*)(ws + WS_R), *Kg = (const bf16*)(ws + WS_K), *Vg = (const bf16*)(ws + WS_V), *LWg = (const bf16*)(ws + WS_LW), *AAg = (const bf16*)(ws + WS_AA), *GGg = (const bf16*)(ws + WS_GG);
    bf16* Z = (bf16*)(ws + WS_Z);
    const int b = pair >> 4, h = pair & 15, lane = F.lane, w = F.wave;
    const size_t tbase = (size_t)b * SEQ;
    LAS unsigned char* L = F.lds;
    LAS float* ybuf = (LAS float*)(L + CH_YBUF);
    const unsigned lbase = (unsigned)(size_t)L;
    const int t = lane & 15, chq = lane >> 4, ch0 = h * 64 + 16 * chq;
    const int n = lane & 15, hq = lane >> 4;
    f32x4 ST[4];
#pragma unroll
    for (int T4 = 0; T4 < 4; ++T4) ST[T4] = (f32x4){0.f, 0.f, 0.f, 0.f};
    { LAS float* par = (LAS float*)(L + CH_PAR);
      if (F.tid < 192) { const int pi = F.tid >> 6, cc = F.tid & 63; par[F.tid] = (pi == 0 ? a.in[I_KK] : (pi == 1 ? a.in[I_KA] : a.in[I_RK]))[h * 64 + cc]; } }
    __syncthreads();
    const f32x4 lnw = *(const GAS f32x4*)(a.in[I_LNW] + h * 64 + 4 * (F.tid & 15)), lnb = *(const GAS f32x4*)(a.in[I_LNB] + h * 64 + 4 * (F.tid & 15));
    u32x4 raw[5][2];
    { const size_t off = (tbase + 16 * w + t) * D + ch0;
#pragma unroll
      for (int hf = 0; hf < 2; ++hf) { raw[0][hf] = __builtin_nontemporal_load((const GAS u32x4*)(Rg + off + 8 * hf)); raw[1][hf] = __builtin_nontemporal_load((const GAS u32x4*)(Kg + off + 8 * hf)); raw[2][hf] = __builtin_nontemporal_load((const GAS u32x4*)(Vg + off + 8 * hf));
          raw[3][hf] = __builtin_nontemporal_load((const GAS u32x4*)(LWg + off + 8 * hf)); raw[4][hf] = __builtin_nontemporal_load((const GAS u32x4*)(AAg + off + 8 * hf)); } }
    for (int g = 0; g < SEQ / (16 * CH_NS); ++g) {
        {
            LAS unsigned char* sl = L + w * CH_SLOT;
            LAS bf16* BT = (LAS bf16*)(L + CH_YBUF + w * 4608); LAS bf16* KT = BT + 16 * CH_RS;
            float rr[16], kk_[16], lw[16], al[16];
#pragma unroll
            for (int hf = 0; hf < 2; ++hf) {
                const u32x4 q0 = raw[0][hf], q1 = raw[1][hf], q2 = raw[2][hf], q3 = raw[3][hf], q4 = raw[4][hf];
                rr[8 * hf + 0] = bf_lo(q0.x); rr[8 * hf + 1] = bf_hi(q0.x); rr[8 * hf + 2] = bf_lo(q0.y); rr[8 * hf + 3] = bf_hi(q0.y); rr[8 * hf + 4] = bf_lo(q0.z); rr[8 * hf + 5] = bf_hi(q0.z); rr[8 * hf + 6] = bf_lo(q0.w); rr[8 * hf + 7] = bf_hi(q0.w);
                kk_[8 * hf + 0] = bf_lo(q1.x); kk_[8 * hf + 1] = bf_hi(q1.x); kk_[8 * hf + 2] = bf_lo(q1.y); kk_[8 * hf + 3] = bf_hi(q1.y); kk_[8 * hf + 4] = bf_lo(q1.z); kk_[8 * hf + 5] = bf_hi(q1.z); kk_[8 * hf + 6] = bf_lo(q1.w); kk_[8 * hf + 7] = bf_hi(q1.w);
                lw[8 * hf + 0] = bf_lo(q3.x); lw[8 * hf + 1] = bf_hi(q3.x); lw[8 * hf + 2] = bf_lo(q3.y); lw[8 * hf + 3] = bf_hi(q3.y); lw[8 * hf + 4] = bf_lo(q3.z); lw[8 * hf + 5] = bf_hi(q3.z); lw[8 * hf + 6] = bf_lo(q3.w); lw[8 * hf + 7] = bf_hi(q3.w);
                al[8 * hf + 0] = bf_lo(q4.x); al[8 * hf + 1] = bf_hi(q4.x); al[8 * hf + 2] = bf_lo(q4.y); al[8 * hf + 3] = bf_hi(q4.y); al[8 * hf + 4] = bf_lo(q4.z); al[8 * hf + 5] = bf_hi(q4.z); al[8 * hf + 6] = bf_lo(q4.w); al[8 * hf + 7] = bf_hi(q4.w);
                *(LAS u32x4*)(sl + CH_OFF_VV + (t * CH_RS + 16 * chq + 8 * hf) * 2) = q2;
            }
            if (g + 1 < SEQ / (16 * CH_NS)) { const size_t off = (tbase + (size_t)(g + 1) * 128 + 16 * w + t) * D + ch0;
    #pragma unroll
                for (int hf = 0; hf < 2; ++hf) { raw[0][hf] = __builtin_nontemporal_load((const GAS u32x4*)(Rg + off + 8 * hf)); raw[1][hf] = __builtin_nontemporal_load((const GAS u32x4*)(Kg + off + 8 * hf)); raw[2][hf] = __builtin_nontemporal_load((const GAS u32x4*)(Vg + off + 8 * hf));
                    raw[3][hf] = __builtin_nontemporal_load((const GAS u32x4*)(LWg + off + 8 * hf)); raw[4][hf] = __builtin_nontemporal_load((const GAS u32x4*)(AAg + off + 8 * hf)); } }
            float ssq = 0.f, rks = 0.f; float av[16], bv[16];
#pragma unroll
            for (int c4 = 0; c4 < 4; ++c4) {
                const LAS float* par = (const LAS float*)(L + CH_PAR) + 16 * chq + 4 * c4;
                const f32x4 kkp = *(const LAS f32x4*)(par), kap = *(const LAS f32x4*)(par + 64), rkp = *(const LAS f32x4*)(par + 128);
#pragma unroll
                for (int i = 0; i < 4; ++i) { const int c = 4 * c4 + i; const float kr = kk_[c] * kkp[i]; ssq += kr * kr; av[c] = kr;
                    const float kp = kk_[c] * (1.0f + (al[c] - 1.0f) * kap[i]); rks += rr[c] * kp * rkp[i]; kk_[c] = kp; }
            }
            ssq += __shfl_xor(ssq, 16); ssq += __shfl_xor(ssq, 32); rks += __shfl_xor(rks, 16); rks += __shfl_xor(rks, 32);
            const float inv = __builtin_amdgcn_rsqf(fmaxf(ssq, 1e-24f));
#pragma unroll
            for (int c = 0; c < 16; ++c) { const float kkn = av[c] * inv; av[c] = -kkn; bv[c] = kkn * al[c]; }
            if (chq == 0) *(LAS float*)(sl + CH_OFF_RK + 4 * t) = rks;
            const int pbase = 32 * (chq >> 1) + 4 * (chq & 1);
            f32x4 gcs[4];
#pragma unroll
            for (int c4 = 0; c4 < 4; ++c4) {
                float at4[4], rt4[4], bt4[4], kt4[4], bb4[4], kb4[4];
#pragma unroll
                for (int i = 0; i < 4; ++i) { const int c = 4 * c4 + i;
                    float x = lw[c]; ROW_SHR_ADD(x, 0x111); ROW_SHR_ADD(x, 0x112); ROW_SHR_ADD(x, 0x114); ROW_SHR_ADD(x, 0x118);
                    const float e1 = __builtin_amdgcn_exp2f(x), i1 = __builtin_amdgcn_exp2f(-x);
                    const float em1 = __builtin_bit_cast(float, __builtin_amdgcn_update_dpp(0x3f800000, __builtin_bit_cast(int, e1), 0x111, 0xf, 0xf, false));
                    const float eC = i1 * __builtin_bit_cast(float, __builtin_amdgcn_update_dpp(0, __builtin_bit_cast(int, e1), 0x15F, 0xf, 0xf, false));
                    at4[i] = em1 * av[c]; rt4[i] = e1 * rr[c]; bt4[i] = bv[c] * i1; kt4[i] = kk_[c] * i1; bb4[i] = bv[c] * eC; kb4[i] = kk_[c] * eC;
                    gcs[c4][i] = e1; }
                *(LAS u32x2*)(sl + CH_OFF_AT + (t * CH_RS + pbase + 8 * c4) * 2) = (u32x2){pk2(at4[0], at4[1]), pk2(at4[2], at4[3])};
                *(LAS u32x2*)(sl + CH_OFF_RT + (t * CH_RS + pbase + 8 * c4) * 2) = (u32x2){pk2(rt4[0], rt4[1]), pk2(rt4[2], rt4[3])};
                *(LAS u32x2*)((LAS unsigned char*)BT + (t * CH_RS + pbase + 8 * c4) * 2) = (u32x2){pk2(bt4[0], bt4[1]), pk2(bt4[2], bt4[3])};
                *(LAS u32x2*)((LAS unsigned char*)KT + (t * CH_RS + pbase + 8 * c4) * 2) = (u32x2){pk2(kt4[0], kt4[1]), pk2(kt4[2], kt4[3])};
                *(LAS u32x2*)(sl + CH_OFF_BB + (t * CH_RS + 16 * chq + 4 * c4) * 2) = (u32x2){pk2(bb4[0], bb4[1]), pk2(bb4[2], bb4[3])};
                *(LAS u32x2*)(sl + CH_OFF_KB + (t * CH_RS + 16 * chq + 4 * c4) * 2) = (u32x2){pk2(kb4[0], kb4[1]), pk2(kb4[2], kb4[3])};
            }
            if (t == 15) {
#pragma unroll
                for (int c4 = 0; c4 < 4; ++c4) *(LAS f32x4*)(sl + CH_OFF_GC + 4 * (16 * chq + 4 * c4)) = gcs[c4]; }
            asm volatile("s_waitcnt lgkmcnt(0)" ::: "memory");
            if (!(PARTS & 16)) {
                const LAS bf16* pa = (const LAS bf16*)(sl + CH_OFF_AT) + n * CH_RS + 8 * hq; const LAS bf16* pr = (const LAS bf16*)(sl + CH_OFF_RT) + n * CH_RS + 8 * hq;
                const LAS bf16* pb = BT + n * CH_RS + 8 * hq; const LAS bf16* pk = KT + n * CH_RS + 8 * hq;
                const bf16x8 fa0 = *(const LAS bf16x8*)pa, fa1 = *(const LAS bf16x8*)(pa + 32), fr0 = *(const LAS bf16x8*)pr, fr1 = *(const LAS bf16x8*)(pr + 32);
                const bf16x8 fb0 = *(const LAS bf16x8*)pb, fb1 = *(const LAS bf16x8*)(pb + 32), fk0 = *(const LAS bf16x8*)pk, fk1 = *(const LAS bf16x8*)(pk + 32);
                const f32x4 z4 = (f32x4){0.f, 0.f, 0.f, 0.f};
                f32x4 mba = __builtin_amdgcn_mfma_f32_16x16x32_bf16(fb0, fa0, z4, 0, 0, 0); mba = __builtin_amdgcn_mfma_f32_16x16x32_bf16(fb1, fa1, mba, 0, 0, 0);
                f32x4 mka = __builtin_amdgcn_mfma_f32_16x16x32_bf16(fk0, fa0, z4, 0, 0, 0); mka = __builtin_amdgcn_mfma_f32_16x16x32_bf16(fk1, fa1, mka, 0, 0, 0);
                f32x4 nbr = __builtin_amdgcn_mfma_f32_16x16x32_bf16(fb0, fr0, z4, 0, 0, 0); nbr = __builtin_amdgcn_mfma_f32_16x16x32_bf16(fb1, fr1, nbr, 0, 0, 0);
                f32x4 nkr = __builtin_amdgcn_mfma_f32_16x16x32_bf16(fk0, fr0, z4, 0, 0, 0); nkr = __builtin_amdgcn_mfma_f32_16x16x32_bf16(fk1, fr1, nkr, 0, 0, 0);
                float m2[4], m3[4], m4[4]; f32x4 Mb, Ma;
                f32x4 mta = __builtin_amdgcn_mfma_f32_16x16x32_bf16(fa0, fb0, z4, 0, 0, 0); mta = __builtin_amdgcn_mfma_f32_16x16x32_bf16(fa1, fb1, mta, 0, 0, 0);
#pragma unroll
                for (int r = 0; r < 4; ++r) { const int sI = 4 * hq + r; const bool lt = sI < n, le = sI <= n;
                    Mb[r] = lt ? mba[r] : 0.f; Ma[r] = n < sI ? mta[r] : 0.f; m2[r] = lt ? mka[r] : 0.f; m3[r] = le ? nbr[r] : 0.f; m4[r] = le ? nkr[r] : 0.f; }
                *(LAS u32x2*)(sl + CH_OFF_MKA + lane * 8) = (u32x2){pk2(m2[0], m2[1]), pk2(m2[2], m2[3])};
                *(LAS u32x2*)(sl + CH_OFF_NBR + lane * 8) = (u32x2){pk2(m3[0], m3[1]), pk2(m3[2], m3[3])};
                *(LAS u32x2*)(sl + CH_OFF_NKR + lane * 8) = (u32x2){pk2(m4[0], m4[1]), pk2(m4[2], m4[3])};
                typedef short v4s __attribute__((ext_vector_type(4)));
#define PK4(v) __builtin_bit_cast(v4s, (u32x2){pk2((v)[0], (v)[1]), pk2((v)[2], (v)[3])})
#define MM16(A, B, C) __builtin_amdgcn_mfma_f32_16x16x16bf16_1k(A, B, C, 0, 0, 0)
                f32x4 idm;
#pragma unroll
                for (int r = 0; r < 4; ++r) idm[r] = (4 * hq + r == n) ? 1.0f : 0.0f;
                const v4s Mb16 = PK4(Mb), Ma16 = PK4(Ma);
                const f32x4 P1b = Mb + idm, P1a = Ma + idm; const v4s P1a16 = PK4(P1a);
                const f32x4 M2b = MM16(Ma16, Mb16, z4), M2a = MM16(Mb16, Ma16, z4); const v4s M2b16 = PK4(M2b), M2a16 = PK4(M2a);
                const f32x4 P2b = MM16(P1a16, M2b16, P1b), P2a = MM16(M2b16, P1a16, P1a); const v4s P2a16 = PK4(P2a);
                const f32x4 M4b = MM16(M2a16, M2b16, z4), M4a = MM16(M2b16, M2a16, z4); const v4s M4b16 = PK4(M4b), M4a16 = PK4(M4a);
                const f32x4 P3b = MM16(P2a16, M4b16, P2b), P3a = MM16(M4b16, P2a16, P2a);
                const f32x4 M8b = MM16(M4a16, M4b16, z4);
                const f32x4 Tb = MM16(PK4(P3a), PK4(M8b), P3b);
                *(LAS u32x2*)(sl + CH_OFF_TT + lane * 8) = (u32x2){pk2(Tb[0], Tb[1]), pk2(Tb[2], Tb[3])};
#undef PK4
#undef MM16
            }
        }
        __syncthreads();
        u32x2 graw4[4];
        { const int jj = F.tid & 15;
#pragma unroll
          for (int ps = 0; ps < 4; ++ps) graw4[ps] = *(const GAS u32x2*)(GGg + (tbase + (size_t)g * 128 + (F.tid >> 4) + 32 * ps) * D + h * 64 + 4 * jj); }
        if (w < 4 && (PARTS & 2)) {
            const int q = (lane & 15) >> 2, p = lane & 3;
            const int m16 = ((4 * hq + q) * 16 + 4 * p) * 2;
            const int m72 = ((4 * hq + q) * CH_RS + 4 * p) * 2;
            typedef short v4s __attribute__((ext_vector_type(4))); typedef LAS v4s* lv4;
#define CH_LOAD(CS, MKA, TTF, NBR, NKR, VF, BB0, BB1, BB2, BB3, KB0, KB1, KB2, KB3) do { LAS unsigned char* _sl = L + (CS) * CH_SLOT; \
            MKA = *(const LAS v4s*)(_sl + CH_OFF_MKA + lane * 8); TTF = *(const LAS v4s*)(_sl + CH_OFF_TT + lane * 8); \
            NBR = *(const LAS v4s*)(_sl + CH_OFF_NBR + lane * 8); NKR = *(const LAS v4s*)(_sl + CH_OFF_NKR + lane * 8); \
            VF = __builtin_amdgcn_ds_read_tr16_b64_v4i16((lv4)(_sl + CH_OFF_VV + m72 + 32 * w)); \
            BB0 = __builtin_amdgcn_ds_read_tr16_b64_v4i16((lv4)(_sl + CH_OFF_BB + m72)); BB1 = __builtin_amdgcn_ds_read_tr16_b64_v4i16((lv4)(_sl + CH_OFF_BB + m72 + 32)); \
            BB2 = __builtin_amdgcn_ds_read_tr16_b64_v4i16((lv4)(_sl + CH_OFF_BB + m72 + 64)); BB3 = __builtin_amdgcn_ds_read_tr16_b64_v4i16((lv4)(_sl + CH_OFF_BB + m72 + 96)); \
            KB0 = __builtin_amdgcn_ds_read_tr16_b64_v4i16((lv4)(_sl + CH_OFF_KB + m72)); KB1 = __builtin_amdgcn_ds_read_tr16_b64_v4i16((lv4)(_sl + CH_OFF_KB + m72 + 32)); \
            KB2 = __builtin_amdgcn_ds_read_tr16_b64_v4i16((lv4)(_sl + CH_OFF_KB + m72 + 64)); KB3 = __builtin_amdgcn_ds_read_tr16_b64_v4i16((lv4)(_sl + CH_OFF_KB + m72 + 96)); } while (0)
            v4s mka, ttv, nbr, nkr, vfv, bb0, bb1, bb2, bb3, kb0, kb1, kb2, kb3;
            CH_LOAD(0, mka, ttv, nbr, nkr, vfv, bb0, bb1, bb2, bb3, kb0, kb1, kb2, kb3);
#pragma unroll 1
            for (int cs = 0; cs < CH_NS; ++cs) {
                v4s nmka, nttv, nnbr, nnkr, nvfv, nbb0, nbb1, nbb2, nbb3, nkb0, nkb1, nkb2, nkb3;
                const LAS bf16* pa = (const LAS bf16*)(L + cs * CH_SLOT + CH_OFF_AT) + n * CH_RS + 8 * hq; const LAS bf16* pr = (const LAS bf16*)(L + cs * CH_SLOT + CH_OFF_RT) + n * CH_RS + 8 * hq;
                const bf16x8 at0 = *(const LAS bf16x8*)pa, at1 = *(const LAS bf16x8*)(pa + 32), rt0 = *(const LAS bf16x8*)pr, rt1 = *(const LAS bf16x8*)(pr + 32);
                { const int csn = cs + 1 < CH_NS ? cs + 1 : cs;
                  CH_LOAD(csn, nmka, nttv, nnbr, nnkr, nvfv, nbb0, nbb1, nbb2, nbb3, nkb0, nkb1, nkb2, nkb3); }
                f32x4 gcv[4];
#pragma unroll
                for (int T4 = 0; T4 < 4; ++T4) gcv[T4] = *(const LAS f32x4*)(L + cs * CH_SLOT + CH_OFF_GC + (16 * T4 + 4 * hq) * 4);
                u32x4 b0w, b1w;
                b0w.x = pk2(ST[0][0], ST[0][1]); b0w.y = pk2(ST[0][2], ST[0][3]); b0w.z = pk2(ST[1][0], ST[1][1]); b0w.w = pk2(ST[1][2], ST[1][3]);
                b1w.x = pk2(ST[2][0], ST[2][1]); b1w.y = pk2(ST[2][2], ST[2][3]); b1w.z = pk2(ST[3][0], ST[3][1]); b1w.w = pk2(ST[3][2], ST[3][3]);
                const bf16x8 bop0 = __builtin_bit_cast(bf16x8, b0w), bop1 = __builtin_bit_cast(bf16x8, b1w);
                const u32x2 mkaf = __builtin_bit_cast(u32x2, mka), ttf = __builtin_bit_cast(u32x2, ttv), nbrf = __builtin_bit_cast(u32x2, nbr), nkrf = __builtin_bit_cast(u32x2, nkr), vf = __builtin_bit_cast(u32x2, vfv);
                const u32x2 bbf[4] = {__builtin_bit_cast(u32x2, bb0), __builtin_bit_cast(u32x2, bb1), __builtin_bit_cast(u32x2, bb2), __builtin_bit_cast(u32x2, bb3)};
                const u32x2 kbf[4] = {__builtin_bit_cast(u32x2, kb0), __builtin_bit_cast(u32x2, kb1), __builtin_bit_cast(u32x2, kb2), __builtin_bit_cast(u32x2, kb3)};
                const f32x4 z4 = (f32x4){0.f, 0.f, 0.f, 0.f};
                f32x4 XT = __builtin_amdgcn_mfma_f32_16x16x32_bf16(at0, bop0, z4, 0, 0, 0); XT = __builtin_amdgcn_mfma_f32_16x16x32_bf16(at1, bop1, XT, 0, 0, 0);
                XT = __builtin_amdgcn_mfma_f32_16x16x32_bf16(__builtin_bit_cast(bf16x8, (u32x4){mkaf.x, mkaf.y, 0u, 0u}), __builtin_bit_cast(bf16x8, (u32x4){vf.x, vf.y, 0u, 0u}), XT, 0, 0, 0);
                const f32x4 UT = __builtin_amdgcn_mfma_f32_16x16x32_bf16(__builtin_bit_cast(bf16x8, (u32x4){ttf.x, ttf.y, 0u, 0u}), __builtin_bit_cast(bf16x8, (u32x4){pk2(XT[0], XT[1]), pk2(XT[2], XT[3]), 0u, 0u}), z4, 0, 0, 0);
                const bf16x8 uvop = __builtin_bit_cast(bf16x8, (u32x4){pk2(UT[0], UT[1]), pk2(UT[2], UT[3]), vf.x, vf.y});
                f32x4 YT = __builtin_amdgcn_mfma_f32_16x16x32_bf16(rt0, bop0, z4, 0, 0, 0); YT = __builtin_amdgcn_mfma_f32_16x16x32_bf16(rt1, bop1, YT, 0, 0, 0);
                YT = __builtin_amdgcn_mfma_f32_16x16x32_bf16(__builtin_bit_cast(bf16x8, (u32x4){nbrf.x, nbrf.y, nkrf.x, nkrf.y}), uvop, YT, 0, 0, 0);
#pragma unroll
                for (int r = 0; r < 4; ++r) ybuf[(cs * 16 + 4 * hq + r) * 64 + 16 * w + n] = YT[r];
#pragma unroll
                for (int T4 = 0; T4 < 4; ++T4)
                    ST[T4] = __builtin_amdgcn_mfma_f32_16x16x32_bf16(__builtin_bit_cast(bf16x8, (u32x4){bbf[T4].x, bbf[T4].y, kbf[T4].x, kbf[T4].y}), uvop, ST[T4] * gcv[T4], 0, 0, 0);
                mka = nmka; ttv = nttv; nbr = nnbr; nkr = nnkr; vfv = nvfv;
                bb0 = nbb0; bb1 = nbb1; bb2 = nbb2; bb3 = nbb3; kb0 = nkb0; kb1 = nkb1; kb2 = nkb2; kb3 = nkb3;
            }
#undef CH_LOAD
        }
        __syncthreads();
        if (PARTS & 4) {
            const int j = F.tid & 15, ch = h * 64 + 4 * j;
#pragma unroll
            for (int ps = 0; ps < 4; ++ps) {
                const int tk = (F.tid >> 4) + 32 * ps, cs = tk >> 4, tl = tk & 15;
                const size_t gofs = (tbase + (size_t)g * 128 + tk) * D + ch;
                const u32x2 graw = graw4[ps];
                const f32x4 y4 = *(const LAS f32x4*)(ybuf + tk * 64 + 4 * j);
                const float mean = row16_sum((y4.x + y4.y) + (y4.z + y4.w)) * (1.0f / 64.0f);
                const f32x4 d4 = y4 - mean;
                const float var = row16_sum((d4.x * d4.x + d4.y * d4.y) + (d4.z * d4.z + d4.w * d4.w)) * (1.0f / 64.0f);
                const float rs = __builtin_amdgcn_rsqf(var + GN_EPS);
                const u32x2 vraw = *(const LAS u32x2*)(L + cs * CH_SLOT + CH_OFF_VV + (tl * CH_RS + 4 * j) * 2);
                const float rk = *(const LAS float*)(L + cs * CH_SLOT + CH_OFF_RK + 4 * tl);
                const f32x4 vt = (f32x4){bf_lo(vraw.x), bf_hi(vraw.x), bf_lo(vraw.y), bf_hi(vraw.y)}, g4 = (f32x4){bf_lo(graw.x), bf_hi(graw.x), bf_lo(graw.y), bf_hi(graw.y)};
                const f32x4 o = (d4 * rs * lnw + lnb + rk * vt) * g4;
                u32x2 wv; wv.x = pk2(o.x, o.y); wv.y = pk2(o.z, o.w);
                *(GAS u32x2*)(Z + gofs) = wv;
            }
        }
        __syncthreads();
    }
}

constexpr int AT_KS = 72;
struct AtUnit { int b, g, h, rho, jb, dil; };
__device__ __forceinline__ AtUnit at_decode(int u) { AtUnit a; const int sub = u & 15; int r = u >> 4; a.h = r & 7; r >>= 3; a.g = r % 3; a.b = r / 3;
    a.dil = a.g == 0 ? 1 : (a.g == 1 ? 4 : 16); a.rho = a.g == 0 ? 0 : (a.g == 1 ? (sub & 3) : sub); a.jb = a.g == 0 ? sub : (a.g == 1 ? (sub >> 2) : 0); return a; }
__device__ __forceinline__ void at_issue(int u, int tid, int w, int lane, const bf16* Q, const bf16* KK, const bf16* VV, u32x4 (&kr)[4], u32x4 (&vr)[4], u32x4 (&qr)[2]) {
    const int hq = lane >> 4, n = lane & 15;
    const AtUnit at = at_decode(u);
    const size_t cb = ((size_t)((at.b * 3 + at.g) * 8 + at.h) * 2048 + (size_t)at.rho * (2048 >> (2 * at.g))) * 64;
#pragma unroll
    for (int i = 0; i < 4; ++i) {
        const int p = tid + 512 * i, key = p >> 3, dp = p & 7, jp = at.jb * 128 - 128 + key;
        kr[i] = (u32x4){0u, 0u, 0u, 0u};
        if (jp >= 0) kr[i] = *(const GAS u32x4*)(KK + cb + (size_t)jp * 64 + dp * 8);
    }
#pragma unroll
    for (int i = 0; i < 4; ++i) {
        const int p = tid + 512 * i, key = p >> 3, dp = p & 7, jp = at.jb * 128 - 128 + key;
        vr[i] = (u32x4){0u, 0u, 0u, 0u};
        if (jp >= 0) vr[i] = *(const GAS u32x4*)(VV + cb + (size_t)jp * 64 + dp * 8);
    }
    const int jqq = at.jb * 128 + 16 * w + n;
#pragma unroll
    for (int s2 = 0; s2 < 2; ++s2) qr[s2] = *(const GAS u32x4*)(Q + cb + (size_t)jqq * 64 + 32 * s2 + 8 * hq);
}
__device__ __forceinline__ void p8_attn_mfma(const Args& a, Frame& F) {
    typedef short bf16x8 __attribute__((ext_vector_type(8)));
    unsigned char* ws = a.ws;
    const bf16 *Q = (const bf16*)(ws + WS_Q), *KK = (const bf16*)(ws + WS_KK), *VV = (const bf16*)(ws + WS_VV); bf16* OG = (bf16*)(ws + WS_OG); float* LSE = (float*)(ws + WS_LSE);
    LAS bf16* Ks = (LAS bf16*)F.lds; LAS bf16* Vt = Ks + 256 * AT_KS;
    const int lane = F.lane, w = F.wave, hq = lane >> 4, n = lane & 15;
    const int NU = NB * 3 * 8 * 16;
    u32x4 kr[4], vr[4], qr[2];
    int u = (F.G % 8 == 0) ? (F.bid % 8) * (F.G / 8) + F.bid / 8 : F.bid;
    if (u < NU) at_issue(u, F.tid, w, lane, Q, KK, VV, kr, vr, qr);
    for (; u < NU; u += F.G) {
        const AtUnit at = at_decode(u);
#pragma unroll
        for (int i = 0; i < 4; ++i) { const int p = F.tid + 512 * i, key = p >> 3, dp = p & 7; *(LAS u32x4*)(Ks + key * AT_KS + dp * 8) = kr[i]; }
#pragma unroll
        for (int i = 0; i < 4; ++i) { const int p = F.tid + 512 * i, key = p >> 3, dp = p & 7; *(LAS u32x4*)(Vt + key * AT_KS + dp * 8) = vr[i]; }
        const bf16x8 qf0 = __builtin_bit_cast(bf16x8, qr[0]), qf1 = __builtin_bit_cast(bf16x8, qr[1]);
        __syncthreads();
        if (u + F.G < NU) at_issue(u + F.G, F.tid, w, lane, Q, KK, VV, kr, vr, qr);
        const int ilo = at.jb == 0 ? (8 - w) : 0;
        f32x4 sc[9];
#pragma unroll
        for (int i = 0; i < 9; ++i) { sc[i] = (f32x4){0.f, 0.f, 0.f, 0.f};
            if (i >= ilo) {
                const LAS bf16* kp = Ks + (16 * (w + i) + n) * AT_KS + 8 * hq;
                const bf16x8 k0 = *(const LAS bf16x8*)(kp), k1 = *(const LAS bf16x8*)(kp + 32);
                sc[i] = __builtin_amdgcn_mfma_f32_16x16x32_bf16(k0, qf0, sc[i], 0, 0, 0);
                sc[i] = __builtin_amdgcn_mfma_f32_16x16x32_bf16(k1, qf1, sc[i], 0, 0, 0); } }
        const float slope = exp2f(-8.0f * (float)(at.g * 8 + at.h + 1) / 24.0f);
        const float c1 = 0.125f * 1.4426950408889634f, c2 = slope * (float)at.dil * 1.4426950408889634f;
        int nq = n; asm volatile("" : "+v"(nq));
        const int jq = 16 * w + nq;
        const int dq = nq - 4 * hq;
        const float cj = c2 * (float)(dq + 128), c2r1 = c2, c2r2 = 2.f * c2, c2r3 = 3.f * c2;
        float mx = -1e30f;
#pragma unroll
        for (int i = 0; i < 9; ++i) {
            const float b0 = (i >= ilo) ? (c2 * (float)(16 * i) - cj) : -1e30f;
            float v0 = sc[i][0] * c1 + b0, v1 = sc[i][1] * c1 + (b0 + c2r1), v2 = sc[i][2] * c1 + (b0 + c2r2), v3 = sc[i][3] * c1 + (b0 + c2r3);
            if (i == 0) { v0 = dq <= 0 ? v0 : -1e30f; v1 = dq <= 1 ? v1 : -1e30f; v2 = dq <= 2 ? v2 : -1e30f; v3 = dq <= 3 ? v3 : -1e30f; }
            if (i == 8) { v0 = dq >= 0 ? v0 : -1e30f; v1 = dq >= 1 ? v1 : -1e30f; v2 = dq >= 2 ? v2 : -1e30f; v3 = dq >= 3 ? v3 : -1e30f; }
            sc[i][0] = v0; sc[i][1] = v1; sc[i][2] = v2; sc[i][3] = v3;
            mx = fmaxf(mx, fmaxf(fmaxf(v0, v1), fmaxf(v2, v3)));
        }
        mx = fmaxf(mx, __shfl_xor(mx, 16)); mx = fmaxf(mx, __shfl_xor(mx, 32));
        float l = 0.f;
#pragma unroll
        for (int i = 0; i < 9; ++i)
#pragma unroll
            for (int r = 0; r < 4; ++r) { const float p = __builtin_amdgcn_exp2f(sc[i][r] - mx); sc[i][r] = p; l += p; }
        l += __shfl_xor(l, 16); l += __shfl_xor(l, 32);
        const int vboff = (4 * hq + ((lane & 15) >> 2)) * (AT_KS * 2) + 8 * (lane & 3);
        typedef short v4s __attribute__((ext_vector_type(4))); typedef LAS v4s* lv4;
        f32x4 o[4];
#pragma unroll
        for (int dt = 0; dt < 4; ++dt) o[dt] = (f32x4){0.f, 0.f, 0.f, 0.f};
#pragma unroll
        for (int ks = 0; ks < 4; ++ks) {
            if (2 * ks + 1 >= ilo) {
                u32x4 pw; pw.x = pk2(sc[2 * ks][0], sc[2 * ks][1]); pw.y = pk2(sc[2 * ks][2], sc[2 * ks][3]); pw.z = pk2(sc[2 * ks + 1][0], sc[2 * ks + 1][1]); pw.w = pk2(sc[2 * ks + 1][2], sc[2 * ks + 1][3]);
                const bf16x8 pb = __builtin_bit_cast(bf16x8, pw);
                LAS unsigned char* va = (LAS unsigned char*)Vt + vboff + (16 * (w + 2 * ks)) * (AT_KS * 2);
                u32x2 a0[4], a1[4];
#pragma unroll
                for (int dt = 0; dt < 4; ++dt) { a0[dt] = __builtin_bit_cast(u32x2, __builtin_amdgcn_ds_read_tr16_b64_v4i16((lv4)(va + 32 * dt))); a1[dt] = __builtin_bit_cast(u32x2, __builtin_amdgcn_ds_read_tr16_b64_v4i16((lv4)(va + 2304 + 32 * dt))); }
#pragma unroll
                for (int dt = 0; dt < 4; ++dt) {
                    const bf16x8 av = __builtin_bit_cast(bf16x8, (u32x4){a0[dt].x, a0[dt].y, a1[dt].x, a1[dt].y});
                    o[dt] = __builtin_amdgcn_mfma_f32_16x16x32_bf16(av, pb, o[dt], 0, 0, 0); } } }
        {
            const u32x2 pw = (u32x2){pk2(sc[8][0], sc[8][1]), pk2(sc[8][2], sc[8][3])};
            LAS unsigned char* va = (LAS unsigned char*)Vt + vboff + (16 * (w + 8)) * (AT_KS * 2);
            v4s a8[4];
#pragma unroll
            for (int dt = 0; dt < 4; ++dt) a8[dt] = __builtin_amdgcn_ds_read_tr16_b64_v4i16((lv4)(va + 32 * dt));
#pragma unroll
            for (int dt = 0; dt < 4; ++dt) o[dt] = __builtin_amdgcn_mfma_f32_16x16x16bf16_1k(a8[dt], __builtin_bit_cast(v4s, pw), o[dt], 0, 0, 0);
        }
        const float inv = 1.0f / l; const int tq = at.rho + at.dil * (at.jb * 128 + jq); const size_t tg = (size_t)at.b * SEQ + tq;
        bf16* op = OG + ((size_t)at.g * T + tg) * 512 + at.h * 64 + 4 * hq;
#pragma unroll
        for (int dt = 0; dt < 4; ++dt) { u32x2 wv; wv.x = pk2(o[dt][0] * inv, o[dt][1] * inv); wv.y = pk2(o[dt][2] * inv, o[dt][3] * inv); *(GAS u32x2*)(op + 16 * dt) = wv; }
        if (hq == 0) LSE[((size_t)at.g * T + tg) * 8 + at.h] = (mx + __builtin_amdgcn_logf(l)) * 0.6931471805599453f;
        __syncthreads();
    }
}
__device__ __forceinline__ void p9_merge(const Args& a, Frame& F) {
    unsigned char* ws = a.ws; const bf16* OG = (const bf16*)(ws + WS_OG); const float* LSE = (const float*)(ws + WS_LSE); bf16* OM = (bf16*)(ws + WS_OM);
    const int gw = F.bid * NWAVES + F.wave, NGW = F.G * NWAVES, hh = F.lane >> 3;
    for (int t = gw; t < T; t += NGW) {
        const float l0 = LSE[((size_t)0 * T + t) * 8 + hh], l1 = LSE[((size_t)1 * T + t) * 8 + hh], l2 = LSE[((size_t)2 * T + t) * 8 + hh];
        const float m = fmaxf(l0, fmaxf(l1, l2)); const float e0 = __expf(l0 - m), e1 = __expf(l1 - m), e2 = __expf(l2 - m); const float inv = 1.0f / (e0 + e1 + e2);
        const float w0 = e0 * inv, w1 = e1 * inv, w2 = e2 * inv;
        const u32x4 a0 = __builtin_nontemporal_load((const GAS u32x4*)(OG + ((size_t)0 * T + t) * 512 + 8 * F.lane)), a1 = __builtin_nontemporal_load((const GAS u32x4*)(OG + ((size_t)1 * T + t) * 512 + 8 * F.lane)), a2 = __builtin_nontemporal_load((const GAS u32x4*)(OG + ((size_t)2 * T + t) * 512 + 8 * F.lane));
        u32x4 r;
        r.x = pk2(w0 * bf_lo(a0.x) + w1 * bf_lo(a1.x) + w2 * bf_lo(a2.x), w0 * bf_hi(a0.x) + w1 * bf_hi(a1.x) + w2 * bf_hi(a2.x));
        r.y = pk2(w0 * bf_lo(a0.y) + w1 * bf_lo(a1.y) + w2 * bf_lo(a2.y), w0 * bf_hi(a0.y) + w1 * bf_hi(a1.y) + w2 * bf_hi(a2.y));
        r.z = pk2(w0 * bf_lo(a0.z) + w1 * bf_lo(a1.z) + w2 * bf_lo(a2.z), w0 * bf_hi(a0.z) + w1 * bf_hi(a1.z) + w2 * bf_hi(a2.z));
        r.w = pk2(w0 * bf_lo(a0.w) + w1 * bf_lo(a1.w) + w2 * bf_lo(a2.w), w0 * bf_hi(a0.w) + w1 * bf_hi(a1.w) + w2 * bf_hi(a2.w));
        *(GAS u32x4*)(OM + (size_t)t * 512 + 8 * F.lane) = r;
    }
}

__device__ __forceinline__ void p10_router(const Args& a, Frame& F) {
    unsigned char* ws = a.ws;
    const bf16* x3 = (const bf16*)(ws + WS_X3B); const unsigned long long* ss3 = (const unsigned long long*)(ws + CTL_SS3);
    unsigned* gcnt = (unsigned*)(ws + CTL_CNT); float* tgate = (float*)(ws + WS_TGATE); int* tokep = (int*)(ws + WS_TOKEP); unsigned char* xg = ws + WS_XG;
    LAS float* rw = (LAS float*)F.lds;
    LAS int* lcnt = (LAS int*)(rw + 8192);
    LAS int* lbase = lcnt + 8;
    LAS int* te = lbase + 8;
    LAS int* tp = te + 128;
    LAS float* tgt = (LAS float*)(tp + 128);
    const float* g = a.in[I_NG] + 3 * D; const float* rt = a.in[I_ROUTER]; const float* rb = a.in[I_RBIAS];
    for (int i = F.tid; i < 8192; i += 512) { const int k = i >> 3; rw[(((k & 3) << 8) + (k >> 2)) * 8 + (i & 7)] = rt[i] * g[k]; }
    for (int cb = F.bid; cb < T / 64; cb += F.G) {
        if (F.tid < 8) lcnt[F.tid] = 0;
        __syncthreads();
        {
            float v[64];
#pragma unroll
            for (int i = 0; i < 64; ++i) v[i] = 0.f;
            const bf16* xrow = x3 + (size_t)(cb * 64 + F.wave * 8) * D + 4 * F.lane;
#pragma unroll
            for (int jq = 0; jq < 4; ++jq) {
                u32x2 xw[8];
#pragma unroll
                for (int tt = 0; tt < 8; ++tt) xw[tt] = *(const GAS u32x2*)(xrow + (size_t)tt * D + 256 * jq);
#pragma unroll
                for (int i = 0; i < 4; ++i) { const LAS float* wp = rw + ((i << 8) + F.lane + 64 * jq) * 8; const f32x4 w0 = *(const LAS f32x4*)(wp), w1 = *(const LAS f32x4*)(wp + 4);
#pragma unroll
                    for (int tt = 0; tt < 8; ++tt) { const unsigned xu = (i < 2) ? xw[tt].x : xw[tt].y; const float xv = (i & 1) ? bf_hi(xu) : bf_lo(xu);
                        v[tt * 8 + 0] += xv * w0.x; v[tt * 8 + 1] += xv * w0.y; v[tt * 8 + 2] += xv * w0.z; v[tt * 8 + 3] += xv * w0.w;
                        v[tt * 8 + 4] += xv * w1.x; v[tt * 8 + 5] += xv * w1.y; v[tt * 8 + 6] += xv * w1.z; v[tt * 8 + 7] += xv * w1.w; } }
            }
#pragma unroll
            for (int d = 32, n = 64; d >= 1; d >>= 1, n >>= 1) { const bool up = (F.lane & d) != 0;
#pragma unroll
                for (int i = 0; i < n / 2; ++i) { const float send = up ? v[i] : v[i + n / 2], keep = up ? v[i + n / 2] : v[i]; v[i] = keep + __shfl_xor(send, d); } }
            const int tt = F.lane >> 3, e = F.lane & 7, tl = F.wave * 8 + tt, tok = cb * 64 + tl;
            const float lg = v[0] * rstd_from_ss(ss3, tok) + rb[e];
            float v0 = lg; int e0 = e;
#pragma unroll
            for (int d = 1; d < 8; d <<= 1) { const float ov = __shfl_xor(v0, d); const int oi = __shfl_xor(e0, d); const bool take = (ov > v0) || (ov == v0 && oi < e0); v0 = take ? ov : v0; e0 = take ? oi : e0; }
            float v1 = (e == e0) ? -3.0e38f : lg; int e1 = e;
#pragma unroll
            for (int d = 1; d < 8; d <<= 1) { const float ov = __shfl_xor(v1, d); const int oi = __shfl_xor(e1, d); const bool take = (ov > v1) || (ov == v1 && oi < e1); v1 = take ? ov : v1; e1 = take ? oi : e1; }
            if (e == 0) {
                const float p1 = __expf(v1 - v0), g0 = 1.0f / (1.0f + p1), g1 = p1 * g0;
                te[tl * 2] = e0; te[tl * 2 + 1] = e1; tgt[tl * 2] = g0; tgt[tl * 2 + 1] = g1;
                tp[tl * 2] = __hip_atomic_fetch_add(&lcnt[e0], 1, __ATOMIC_RELAXED, __HIP_MEMORY_SCOPE_WORKGROUP); tp[tl * 2 + 1] = __hip_atomic_fetch_add(&lcnt[e1], 1, __ATOMIC_RELAXED, __HIP_MEMORY_SCOPE_WORKGROUP);
            }
        }
        __syncthreads();
        if (F.tid < 8) lbase[F.tid] = (int)__hip_atomic_fetch_add(gcnt + F.tid, (unsigned)lcnt[F.tid], __ATOMIC_RELAXED, __HIP_MEMORY_SCOPE_AGENT);
        __syncthreads();
        if (F.tid < 128) { const int tl = F.tid >> 1, s = F.tid & 1, e = te[tl * 2 + s], pos = lbase[e] + tp[tl * 2 + s];
            tgate[(cb * 64 + tl) * 2 + s] = tgt[tl * 2 + s]; tokep[(cb * 64 + tl) * 2 + s] = (e << 16) | pos; }
        for (int k = 0; k < 16; ++k) {
            const int pi = F.wave * 16 + k, tl = pi >> 1, e = te[pi], pos = lbase[e] + tp[pi], tok = cb * 64 + tl;
            const GAS u32x4* src = (const GAS u32x4*)(x3 + (size_t)tok * D) + 2 * F.lane;
            const u32x4 p0 = src[0], p1 = src[1]; const float rs = rstd_from_ss(ss3, tok);
            u32x4 o; o.x = pk4_fp8(bf_lo(p0.x) * rs, bf_hi(p0.x) * rs, bf_lo(p0.y) * rs, bf_hi(p0.y) * rs); o.y = pk4_fp8(bf_lo(p0.z) * rs, bf_hi(p0.z) * rs, bf_lo(p0.w) * rs, bf_hi(p0.w) * rs);
            o.z = pk4_fp8(bf_lo(p1.x) * rs, bf_hi(p1.x) * rs, bf_lo(p1.y) * rs, bf_hi(p1.y) * rs); o.w = pk4_fp8(bf_lo(p1.z) * rs, bf_hi(p1.z) * rs, bf_lo(p1.w) * rs, bf_hi(p1.w) * rs);
            *(GAS u32x4*)(xg + ((size_t)e * T + pos) * D + 16 * F.lane) = o;
        }
        __syncthreads();
    }
}
__device__ __forceinline__ void p11_gather(const Args& a, Frame& F) {
    unsigned char* ws = a.ws;
    const unsigned* gcnt = (const unsigned*)(ws + CTL_CNT); const int* list = (const int*)(ws + WS_LIST);
    const bf16* x3 = (const bf16*)(ws + WS_X3B); unsigned char* xg = ws + WS_XG;
    const unsigned long long* ss3 = (const unsigned long long*)(ws + CTL_SS3);
    int cnt[8], up[9], pp[8]; { int s = 0, p = 0;
_Pragma("unroll")
        for (int e = 0; e < 8; ++e) { cnt[e] = (int)gcnt[e]; up[e] = s; pp[e] = p; s += cnt[e]; p += ((cnt[e] + 255) >> 8) << 8; } up[8] = s; }
    const int gw = F.bid * NWAVES + F.wave, NGW = F.G * NWAVES, total = up[8];
    for (int i = gw; i < total; i += NGW) {
        int e = 0;
#pragma unroll
        for (int k = 1; k < 8; ++k) e += (i >= up[k]) ? 1 : 0;
        int pos = i, pbase = 0;
#pragma unroll
        for (int k = 0; k < 8; ++k) if (k == e) { pos = i - up[k]; pbase = pp[k]; }
        const int tok = list[e * T + pos], slot = pbase + pos;
        const GAS u32x4* src = (const GAS u32x4*)(x3 + (size_t)tok * D) + 2 * F.lane;
        const u32x4 p0 = src[0], p1 = src[1]; const float rs = rstd_from_ss(ss3, tok);
        u32x4 o; o.x = pk4_fp8(bf_lo(p0.x) * rs, bf_hi(p0.x) * rs, bf_lo(p0.y) * rs, bf_hi(p0.y) * rs); o.y = pk4_fp8(bf_lo(p0.z) * rs, bf_hi(p0.z) * rs, bf_lo(p0.w) * rs, bf_hi(p0.w) * rs);
        o.z = pk4_fp8(bf_lo(p1.x) * rs, bf_hi(p1.x) * rs, bf_lo(p1.y) * rs, bf_hi(p1.y) * rs); o.w = pk4_fp8(bf_lo(p1.z) * rs, bf_hi(p1.z) * rs, bf_lo(p1.w) * rs, bf_hi(p1.w) * rs);
        *(GAS u32x4*)(xg + (size_t)slot * D + 16 * F.lane) = o;
    }
}
__device__ __forceinline__ void fin_rows(const bf16* cb, const bf16* slab, int s, int rowf, int lane, u32x2 (&r)[4]) {
    if (s < rowf) { const GAS u32x2* c = (const GAS u32x2*)(cb + (size_t)s * D) + lane;
#pragma unroll
        for (int j = 0; j < 4; ++j) r[j] = __builtin_nontemporal_load(c + 64 * j); }
    else {
#pragma unroll
        for (int j = 0; j < 4; ++j) { f32x4 e = (f32x4){0.f, 0.f, 0.f, 0.f};
#pragma unroll
            for (int sl = 0; sl < 7; ++sl) { const u32x2 p = *((const GAS u32x2*)(slab + ((size_t)sl * 2048 + (s - rowf)) * D) + lane + 64 * j); e += (f32x4){bf_lo(p.x), bf_hi(p.x), bf_lo(p.y), bf_hi(p.y)}; }
            r[j].x = pk2(e.x, e.y); r[j].y = pk2(e.z, e.w); }
    }
}
__device__ __forceinline__ void p15_final(const Args& a, Frame& F) {
    unsigned char* ws = a.ws;
    const unsigned* gcnt = (const unsigned*)(ws + CTL_CNT); const int* tokep = (const int*)(ws + WS_TOKEP); const bf16* cb = (const bf16*)(ws + WS_CONTRIB); const float* tgate = (const float*)(ws + WS_TGATE);
    const float* fg = a.in[I_FG]; float* out = a.out; const bf16* x3b = (const bf16*)(ws + WS_X3B);
    int pp[8]; int ptot; { int p = 0;
_Pragma("unroll")
        for (int e = 0; e < 8; ++e) { pp[e] = p; p += (((int)gcnt[e] + 255) >> 8) << 8; } ptot = p; }
    const int MT = ptot >> 8, rowf = (MT - pg8::moe_tail_tiles(MT)) << 8;
    const bf16* slab = (const bf16*)(ws + WS_SLAB);
    const int gw = F.bid * NWAVES + F.wave, NGW = F.G * NWAVES;
    f32x4 gv[4];
#pragma unroll
    for (int j = 0; j < 4; ++j) gv[j] = *(const GAS f32x4*)(fg + 4 * F.lane + 256 * j);
    for (int blk = gw; blk < T / 8; blk += NGW) {
        const int m0 = blk * 8;
        int tk = 0; float tg = 0.f;
        if (F.lane < 16) { tk = tokep[m0 * 2 + F.lane]; tg = tgate[m0 * 2 + F.lane]; }
        u32x2 cx[4], ca[4], cc[4], nx[4], na[4], nc[4];
#define FIN_LOAD(X, A, C, i) do { const int _e0 = __builtin_amdgcn_readlane(tk, 2 * (i)), _e1 = __builtin_amdgcn_readlane(tk, 2 * (i) + 1); int _s0 = _e0 & 0xffff, _s1 = _e1 & 0xffff; \
            _Pragma("unroll") for (int k = 0; k < 8; ++k) { if ((_e0 >> 16) == k) _s0 += pp[k]; if ((_e1 >> 16) == k) _s1 += pp[k]; } \
            const GAS u32x2* _x = (const GAS u32x2*)(x3b + (size_t)(m0 + (i)) * D) + F.lane; \
            _Pragma("unroll") for (int j = 0; j < 4; ++j) X[j] = __builtin_nontemporal_load(_x + 64 * j); \
            fin_rows(cb, slab, _s0, rowf, F.lane, A); fin_rows(cb, slab, _s1, rowf, F.lane, C); } while (0)
        FIN_LOAD(cx, ca, cc, 0);
#pragma unroll
        for (int i = 0; i < 8; ++i) {
            if (i + 1 < 8) FIN_LOAD(nx, na, nc, i + 1);
            const float g0 = __builtin_bit_cast(float, __builtin_amdgcn_readlane(__builtin_bit_cast(int, tg), 2 * i)), g1 = __builtin_bit_cast(float, __builtin_amdgcn_readlane(__builtin_bit_cast(int, tg), 2 * i + 1));
            f32x4 v[4]; float sq = 0.f;
#pragma unroll
            for (int j = 0; j < 4; ++j) {
                v[j].x = bf_lo(cx[j].x) + g0 * bf_lo(ca[j].x) + g1 * bf_lo(cc[j].x); v[j].y = bf_hi(cx[j].x) + g0 * bf_hi(ca[j].x) + g1 * bf_hi(cc[j].x);
                v[j].z = bf_lo(cx[j].y) + g0 * bf_lo(ca[j].y) + g1 * bf_lo(cc[j].y); v[j].w = bf_hi(cx[j].y) + g0 * bf_hi(ca[j].y) + g1 * bf_hi(cc[j].y);
                sq += (v[j].x * v[j].x + v[j].y * v[j].y) + (v[j].z * v[j].z + v[j].w * v[j].w); }
            const float rstd = 1.f / sqrtf(wave_sum(sq) * (1.f / D) + RMS_EPS);
            GAS f32x4* xr = (GAS f32x4*)(out + (size_t)(m0 + i) * D) + F.lane;
#pragma unroll
            for (int j = 0; j < 4; ++j) __builtin_nontemporal_store(v[j] * rstd * gv[j], xr + 64 * j);
#pragma unroll
            for (int j = 0; j < 4; ++j) { cx[j] = nx[j]; ca[j] = na[j]; cc[j] = nc[j]; }
        }
#undef FIN_LOAD
    }
}

__device__ __forceinline__ const LAS float* row_scale_table(Frame& F, const unsigned long long* ss) {
    if ((F.G & 7) != 0) return nullptr;
    LAS float* rtab = (LAS float*)(F.lds + 131072);
    const int r0 = 2048 * (F.bid & 7);
    for (int i = F.tid; i < 2048; i += NWAVES * 64) rtab[i] = rstd_from_ss(ss, r0 + i);
    __syncthreads();
    return rtab;
}
constexpr int NPHASE = 17;
__global__ void __launch_bounds__(NWAVES * 64, 2) fwd(Args args) {
    extern __shared__ __attribute__((aligned(16))) unsigned char lds[];
    Frame F; F.lds = (LAS unsigned char*)lds; F.tid = threadIdx.x; F.lane = F.tid & 63; F.wave = __builtin_amdgcn_readfirstlane(F.tid >> 6); F.G = gridDim.x; F.bid = blockIdx.x;
    volatile LAS unsigned* MISC = (volatile LAS unsigned*)(F.lds + MISC_OFF);
    unsigned char* ws = args.ws;
    if (F.tid < 64) MISC[F.tid] = 0u;
    __syncthreads();
    const int lo = args.ph_lo, hi = args.ph_hi;
    XcdBarrier bar; bar.bar = (unsigned*)(ws + CTL_BAR); bar.x = 0; bar.st = nullptr;
    if (hi - lo > 1) bar = xcd_barrier_post((unsigned*)(ws + CTL_BAR), MISC + 8);
#ifdef ONLY_PHASE
#define IN(k) ((k) == ONLY_PHASE && lo <= (k) && (k) < hi)
#else
#define IN(k) (lo <= (k) && (k) < hi)
#endif
#define SEAM(k) do { if (IN(k) && IN((k) + 1)) xcd_barrier(bar); } while (0)
    LAS unsigned char* ring = F.lds + RING_OFF;
    unsigned long long* ss1 = (unsigned long long*)(ws + CTL_SS1); unsigned long long* ss2 = (unsigned long long*)(ws + CTL_SS2); unsigned long long* ss3 = (unsigned long long*)(ws + CTL_SS3);

    if (IN(0)) { p0_zero(args, F); run_jobs(args, F, 0, NJ_EARLY, F.bid * NWAVES + F.wave, F.G * NWAVES); p0_hcat(args, F); }
#if defined(REPEAT_PHASE) && REPEAT_PHASE == 0
    if (IN(0)) { run_jobs(args, F, 0, NJ_EARLY, F.bid * NWAVES + F.wave, F.G * NWAVES); p0_hcat(args, F); }
#endif
    SEAM(0);
    if (IN(1)) {
        pg8::Gemm2 g{{(const bf16*)(ws + WS_XR), (const bf16*)(ws + WS_HCAT)}, {(const bf16*)(ws + WS_WRKV), (const bf16*)(ws + WS_WLORA)}, {1024, 1024}, {1024, 2048}};
        G1Order S{F.G, F.bid};
        EpiG1 E{(bf16*)(ws + WS_R), (bf16*)(ws + WS_LH)};
        pg8::gemm_phase2<EpiG1, G1Order>(ring, g, S, E, (unsigned*)(ws + CTL_LORA_DONE)); }
    if (IN(1) && IN(2)) {
        if (F.tid == 0) { unsigned* sigp = (unsigned*)(ws + CTL_LORA_DONE); unsigned sp = 0;
            while (__hip_atomic_load(sigp, __ATOMIC_RELAXED, __HIP_MEMORY_SCOPE_AGENT) < 64u) { __builtin_amdgcn_s_sleep(1); if (++sp > (1u << 22)) break; }
            __builtin_amdgcn_fence(__ATOMIC_ACQUIRE, "agent"); }
        __syncthreads(); }
    if (IN(2)) {
        pg8::Gemm2 g{{(const bf16*)(ws + WS_LH), (const bf16*)(ws + WS_LH)}, {(const bf16*)(ws + WS_WLU), (const bf16*)(ws + WS_WLU)}, {256, 256}, {128, 128}};
        G2Order S; S.so.init(T / 256, 3072 / 256, F.G, F.bid);
        EpiG2 E{(bf16*)(ws + WS_LW), args.in[I_W0], args.in[I_A0]};
        pg8::gemm_phase2<EpiG2, G2Order>(ring, g, S, E); }
    SEAM(2);
    if (IN(3)) {
        const int nscan = F.G > 128 ? 128 : F.G, nconv = F.G - nscan;
        constexpr int CONV_SPLIT = 32;
        if (F.bid < nscan) { for (int pair = F.bid; pair < 128; pair += nscan) { p3_scan_chunked(args, F, pair); __syncthreads(); }
#if defined(SCAN_TWICE)
            for (int pair = F.bid; pair < 128; pair += nscan) { p3_scan_chunked<SCAN_TWICE>(args, F, pair); __syncthreads(); }
#endif
            if (nconv > 0) run_jobs_moe(args, F, F.bid * NWAVES + F.wave, nscan * NWAVES, CONV_SPLIT, 32); else { run_jobs(args, F, NJ_EARLY, NJ0, F.bid * NWAVES + F.wave, F.G * NWAVES); run_jobs_moe(args, F, F.bid * NWAVES + F.wave, F.G * NWAVES, 0, 32); } }
        else { run_jobs(args, F, NJ_EARLY, NJ0, (F.bid - nscan) * NWAVES + F.wave, nconv * NWAVES); run_jobs_moe(args, F, (F.bid - nscan) * NWAVES + F.wave, nconv * NWAVES, 0, CONV_SPLIT); }
#if defined(CONV_TWICE)
        if (F.bid >= nscan) { __syncthreads(); run_jobs_moe(args, F, (F.bid - nscan) * NWAVES + F.wave, nconv * NWAVES, 0, CONV_SPLIT); }
#endif
    }
    SEAM(3);
    if (IN(4)) {
        pg8::Gemm g{(const bf16*)(ws + WS_Z), (const bf16*)(ws + WS_WO), 1024, 1024, 0}; pg8::StaticOrder S; S.init(T / 256, 4, F.G, F.bid);
        EpiResT<true> E{args.in[I_X], nullptr, (bf16*)(ws + WS_X1B), ss1};
        pg8::gemm_phase<EpiResT<true>, pg8::StaticOrder>(ring, g, S, E); }
    SEAM(4);
    if (IN(5)) {
        pg8::Gemm g{(const bf16*)(ws + WS_X1B), (const bf16*)(ws + WS_W13F), 1024, 1024, 0}; pg8::StaticOrder S; S.init(T / 256, 2 * FFD / 256, F.G, F.bid, true);
        const bool early = ((F.bid >> 3) & 1) != 0;
        pg8::TailHalfOrder TS0, TS1; TS0.init(T / 256, 2 * FFD / 256, F.G, F.bid, early); TS1.init(T / 256, 2 * FFD / 256, F.G, F.bid, !early);
        const LAS float* rtab = row_scale_table(F, ss1);
        EpiSwiglu E{(bf16*)(ws + WS_FH), FFD, ss1, nullptr, 1, rtab}; EpiSwigluT<true> EH{(bf16*)(ws + WS_FH), FFD, ss1, nullptr, 1, rtab};
        pg8::gemm_phase<EpiSwigluT<true>, pg8::TailHalfOrder, false, false, true, false, true>(ring, g, TS0, EH);
        __syncthreads();
        pg8::gemm_phase<EpiSwiglu, pg8::StaticOrder>(ring, g, S, E);
        __syncthreads();
        pg8::gemm_phase<EpiSwigluT<true>, pg8::TailHalfOrder, false, false, true, false, true>(ring, g, TS1, EH); }
    SEAM(5);
    if (IN(6)) {
        pg8::Gemm g{(const bf16*)(ws + WS_FH), (const bf16*)(ws + WS_W2F), FFD / 2, FFD / 2, 0}; pg8::StaticOrder S; S.init(T / 256, 4, F.G, F.bid);
        EpiResT<false> E{nullptr, (const bf16*)(ws + WS_X1B), (bf16*)(ws + WS_X2B), ss2, ws + WS_X2F8};
        pg8::gemm_phase<EpiResT<false>, pg8::StaticOrder, true>(ring, g, S, E, MW2_SCALE_BYTE * 0x01010101, 0x7F7F7F7F); }
    SEAM(6);
    if (IN(7)) {
        pg8::Gemm g{(const bf16*)(ws + WS_X2F8), (const bf16*)(ws + WS_WQKV), 512, 512, 0}; pg8::StaticOrder S; S.init(T / 256, 18, F.G, F.bid, true);
        const bool early = ((F.bid >> 3) & 1) != 0;
        pg8::TailHalfOrder TS0, TS1; TS0.init(T / 256, 18, F.G, F.bid, early); TS1.init(T / 256, 18, F.G, F.bid, !early);
        const LAS float* rtab = row_scale_table(F, ss2);
        EpiQKV E{(bf16*)(ws + WS_Q), ss2, rtab}; EpiQKVT<true> EH{(bf16*)(ws + WS_Q), ss2, rtab};
        pg8::gemm_phase<EpiQKVT<true>, pg8::TailHalfOrder, true, false, true, false, true>(ring, g, TS0, EH, WQKV_SCALE_BYTE * 0x01010101, 0x7F7F7F7F);
        __syncthreads();
        pg8::gemm_phase<EpiQKV, pg8::StaticOrder, true>(ring, g, S, E, WQKV_SCALE_BYTE * 0x01010101, 0x7F7F7F7F);
        __syncthreads();
        pg8::gemm_phase<EpiQKVT<true>, pg8::TailHalfOrder, true, false, true, false, true>(ring, g, TS1, EH, WQKV_SCALE_BYTE * 0x01010101, 0x7F7F7F7F); }
    SEAM(7);
    if (IN(8)) p8_attn_mfma(args, F);
#if defined(REPEAT_PHASE) && REPEAT_PHASE == 8
    if (IN(8)) p8_attn_mfma(args, F);
#endif
    SEAM(8);
    if (IN(9)) p9_merge(args, F);
    SEAM(9);
    if (IN(10)) {
        pg8::Gemm g{(const bf16*)(ws + WS_OM), (const bf16*)(ws + WS_WAO), 512, 512, 0}; pg8::StaticOrder S; S.init(T / 256, 4, F.G, F.bid);
        EpiResT<false> E{nullptr, (const bf16*)(ws + WS_X2B), (bf16*)(ws + WS_X3B), ss3};
        pg8::gemm_phase<EpiResT<false>, pg8::StaticOrder>(ring, g, S, E); }
    SEAM(10);
    if (IN(11)) p10_router(args, F);
    SEAM(11);
    if (IN(13)) {
        int cnt[8];
_Pragma("unroll")
        for (int e = 0; e < 8; ++e) cnt[e] = (int)((const unsigned*)(ws + CTL_CNT))[e];
        pg8::Gemm g{(const bf16*)(ws + WS_XG), (const bf16*)(ws + WS_MW13), 512, 512, (size_t)7168 * 512}; pg8::MoeOrder S; S.init(cnt, 28, F.G, F.bid);
        EpiSwiglu E{(bf16*)(ws + WS_MH), FFE, nullptr, nullptr, 1, nullptr};
        pg8::gemm_phase<EpiSwiglu, pg8::MoeOrder, true, false, MOEUP_ALIGN, true>(ring, g, S, E, MW13_SCALE_BYTE * 0x01010101, 0x7F7F7F7F); }
    SEAM(13);
    if (IN(15)) {
        int cnt[8];
_Pragma("unroll")
        for (int e = 0; e < 8; ++e) cnt[e] = (int)((const unsigned*)(ws + CTL_CNT))[e];
        pg8::Gemm g{(const bf16*)(ws + WS_MH), (const bf16*)(ws + WS_MW2), FFE / 2, FFE / 2, (size_t)1024 * (FFE / 2)}; pg8::MoeDownOrder S; S.init(cnt, FFE / 128, F.G, F.bid);
        EpiGate E{(bf16*)(ws + WS_CONTRIB), (bf16*)(ws + WS_SLAB), S.MTf};
        pg8::gemm_phase<EpiGate, pg8::MoeDownOrder, true, true>(ring, g, S, E, MW2_SCALE_BYTE * 0x01010101, 0x7F7F7F7F); }
    SEAM(15);
    if (IN(16)) p15_final(args, F);
#undef IN
#undef SEAM
}

extern "C" void kernel_launch(void* const* d_in, const int* in_sizes, int n_in, void* d_out, int out_size, void* d_ws, size_t ws_size, hipStream_t stream) {
    static int grid = 0;
    if (grid == 0) {
        if (n_in != 33 || in_sizes[0] != T * D || out_size != T * D || ws_size < WS_END) { fprintf(stderr, "kernel_launch: unexpected shapes: n_in %d in0 %d out %d ws %zu (need %zu)\n", n_in, n_in > 0 ? in_sizes[0] : -1, out_size, ws_size, (size_t)WS_END); grid = -1; return; }
        int dev = 0, cus = 0, per_cu = 0;
        if (hipGetDevice(&dev) != hipSuccess || hipDeviceGetAttribute(&cus, hipDeviceAttributeMultiprocessorCount, dev) != hipSuccess) { grid = -1; return; }
        if (hipFuncSetAttribute((const void*)fwd, hipFuncAttributeMaxDynamicSharedMemorySize, LDS_BYTES) != hipSuccess) { fprintf(stderr, "kernel_launch: hipFuncSetAttribute failed\n"); grid = -1; return; }
        if (hipOccupancyMaxActiveBlocksPerMultiprocessor(&per_cu, (const void*)fwd, NWAVES * 64, LDS_BYTES) != hipSuccess || per_cu < 1) fprintf(stderr, "kernel_launch: occupancy query says %d\n", per_cu);
        (void)hipGetLastError();
        grid = cus;
    }
    if (grid < 0) return;
    (void)hipMemsetAsync((char*)d_ws + WS_CTL, 0, CTL_ZERO_BYTES, stream);
    Args a{};
    for (int i = 0; i < 33; ++i) a.in[i] = (const float*)d_in[i];
    a.out = (float*)d_out; a.ws = (unsigned char*)d_ws;
#if MK_ONE_LAUNCH
    a.ph_lo = 0; a.ph_hi = NPHASE;
    hipLaunchKernelGGL(fwd, dim3(grid), dim3(NWAVES * 64), LDS_BYTES, stream, a);
#else
    for (int p = 0; p < NPHASE; ++p) { a.ph_lo = p; a.ph_hi = p + 1; hipLaunchKernelGGL(fwd, dim3(grid), dim3(NWAVES * 64), LDS_BYTES, stream, a); }
#endif
}
```

```cpp
#include <hip/hip_runtime.h>
#include <cstdio>
#include <cstdint>

#ifndef MOEUP_ALIGN
#define MOEUP_ALIGN true
#endif
#ifndef MK_ONE_LAUNCH
#define MK_ONE_LAUNCH 1
#endif

namespace pg8 {
#define PG8_LAS __attribute__((address_space(3)))
typedef unsigned short bf16_t;
typedef short bf16x8 __attribute__((ext_vector_type(8)));
typedef float f32x4 __attribute__((ext_vector_type(4)));
typedef unsigned u32x4 __attribute__((ext_vector_type(4)));
typedef unsigned u32x2 __attribute__((ext_vector_type(2)));
typedef int i32x8 __attribute__((ext_vector_type(8)));
constexpr int BM = 256, BK = 64, HALF = 128, HTB = HALF * BK * 2, STAGE_BYTES = 8 * HTB, NXCD = 8, WGM = 8;

__host__ __device__ __forceinline__ int lds_byte(int r, int c) { const int st = (r >> 4) * 2 + (c >> 5), rr = r & 15, cc = c & 31, ob = rr * 64 + cc * 2; return st * 1024 + (ob ^ (((ob >> 9) & 1) << 5)); }
__host__ __device__ __forceinline__ void stage_rc(int b, int& R, int& C) { const int st = b / 1024, sb = b % 1024, swz = sb ^ (((sb >> 9) & 1) << 5); R = (st >> 1) * 16 + swz / 64; C = (st & 1) * 32 + (swz % 64) / 2; }
__host__ __device__ __forceinline__ int perm32(int rho) { const int n = rho >> 4, i = rho & 15; return 8 * (i >> 2) + 4 * n + (i & 3); }

struct Unit { int pm, pn, e, acol, k0, ntu, slice, mh; };
struct Gemm { const bf16_t* A; const bf16_t* Bt; int lda, K; size_t bstride_e; };
struct Gemm2 { const bf16_t* A[2]; const bf16_t* Bt[2]; int lda[2], K[2]; };

__device__ __forceinline__ void static_map(int L, int nM, int nN, int nwg, Unit& u) {
    int wgid = L; { const int q = nwg / NXCD, r = nwg % NXCD, xcd = wgid % NXCD, off = wgid / NXCD; wgid = (xcd < r ? xcd * (q + 1) : r * (q + 1) + (xcd - r) * q) + off; }
    const int nig = WGM * nN, gid = wgid / nig, fm = gid * WGM, gsz = (nM - fm) < WGM ? (nM - fm) : WGM;
    u.pm = fm + ((wgid % nig) % gsz); u.pn = (wgid % nig) / gsz; u.e = 0; u.acol = 0;
}
__device__ __forceinline__ int tail_tiles(int nwg, int G) { const int rem = nwg % G; return 2 * rem > G ? 0 : rem; }
struct StaticOrder {
    int nM, nN, nwg, G, c, lim;
    __device__ __forceinline__ void init(int nM_, int nN_, int G_, int c_, bool whole = false) { nM = nM_; nN = nN_; nwg = nM * nN; G = G_; c = c_; lim = whole ? nwg - tail_tiles(nwg, G) : nwg; }
    __device__ __forceinline__ bool next(int i, Unit& u) const { const long L = (long)i * G + c; if (L >= lim) return false; static_map((int)L, nM, nN, nwg, u); return true; }
};
struct TailHalfOrder {
    int nM, nN, nwg, G, c, Lbase, rem;
    __device__ __forceinline__ void init(int nM_, int nN_, int G_, int c_, bool active = true) { nM = nM_; nN = nN_; nwg = nM * nN; G = G_; c = c_; rem = active ? tail_tiles(nwg, G) : 0; Lbase = nwg - tail_tiles(nwg, G); }
    __device__ __forceinline__ bool next(int i, Unit& u) const { const long v = (long)i * G + c; if (v >= 2 * rem) return false; const int mh = (int)v / rem; static_map(Lbase + ((int)v - mh * rem), nM, nN, nwg, u); u.mh = mh; return true; }
};
struct MoeOrder {
    int nM, nN, nwg, G, c; int tp[9];
    __device__ void init(const int* cnt, int nN_, int G_, int c_) { int s = 0;
_Pragma("unroll")
        for (int e = 0; e < 8; ++e) { tp[e] = s; s += (cnt[e] + 255) >> 8; } tp[8] = s; nM = s; nN = nN_; nwg = nM * nN; G = G_; c = c_; }
    __device__ bool next(int i, Unit& u) const {
        const long L = (long)i * G + c; if (L >= nwg) return false;
        int wgid = (int)L; { const int q = nwg / NXCD, r = nwg % NXCD, xcd = wgid % NXCD, off = wgid / NXCD; wgid = (xcd < r ? xcd * (q + 1) : r * (q + 1) + (xcd - r) * q) + off; }
        const int nig = WGM * nN, gid = wgid / nig, fm = gid * WGM, gsz = (nM - fm) < WGM ? (nM - fm) : WGM;
        u.pm = fm + ((wgid % nig) % gsz); u.pn = (wgid % nig) / gsz;
        int e = 0;
#pragma unroll
        for (int k = 1; k < 8; ++k) e += (u.pm >= tp[k]) ? 1 : 0;
        u.e = e; u.acol = e * 64 - tp_of(e) + u.pm; return true;
    }
    __device__ int tp_of(int e) const { int r = 0;
_Pragma("unroll")
        for (int k = 0; k < 8; ++k) r = (k == e) ? tp[k] : r; return r; }
};

__device__ __forceinline__ unsigned cvt_pk_bf16(float lo, float hi) { unsigned r; asm volatile("v_cvt_pk_bf16_f32 %0, %1, %2" : "=v"(r) : "v"(lo), "v"(hi)); return r; }

#if defined(FORCE_SLICE)
__host__ __device__ __forceinline__ int moe_tail_tiles(int MT) { return (MT & 63) ? (MT & 63) : 8; }
#else
__host__ __device__ __forceinline__ int moe_tail_tiles(int MT) { return MT & 63; }
#endif
struct MoeDownOrder {
    int MT, MTf, nfull, nwg, G, c, ntK; int tp[9];
    __device__ void init(const int* cnt, int ntK_, int G_, int c_) { int s = 0;
_Pragma("unroll")
        for (int e = 0; e < 8; ++e) { tp[e] = s; s += (cnt[e] + 255) >> 8; } tp[8] = s; MT = s; MTf = MT - moe_tail_tiles(MT); nfull = MTf * 4; nwg = nfull + (MT - MTf) * 4 * 7; G = G_; c = c_; ntK = ntK_; }
    __device__ bool next(int i, Unit& u) const {
        const long L = (long)i * G + c; if (L >= nwg) return false;
        if (L < nfull) {
            int wgid = (int)L; { const int q = nfull / NXCD, xcd = wgid % NXCD, off = wgid / NXCD; wgid = xcd * q + off; }
            const int nig = WGM * 4, gid = wgid / nig, fm = gid * WGM;
            u.pm = fm + ((wgid % nig) % WGM); u.pn = (wgid % nig) / WGM; u.k0 = 0; u.ntu = ntK; u.slice = -1;
        } else { const int r = (int)L - nfull, q = r / 7; u.slice = r - 7 * q; u.pn = q & 3; u.pm = MTf + (q >> 2); u.k0 = 4 * u.slice; u.ntu = 4; }
        int e = 0;
#pragma unroll
        for (int k = 1; k < 8; ++k) e += (u.pm >= tp[k]) ? 1 : 0;
        u.e = e; u.acol = 0; return true;
    }
};
template <class Epi, class Sched, bool FP8 = false, bool KS = false, bool ALIGN = true, bool PA = false, bool HM = false>
__device__ __forceinline__ void gemm_phase(PG8_LAS unsigned char* lds, const Gemm g, const Sched& S, const Epi& E, int scale_w = 0x7F7F7F7F, int scale_x = 0x7F7F7F7F) {
    const int tid = threadIdx.x, wid = __builtin_amdgcn_readfirstlane(tid >> 6), lane = tid & 63, wr = wid >> 2, wc = wid & 3, fr = lane & 15, fq = lane >> 4;
    int K = g.K; asm volatile("" : "+s"(K));
    const int nt = K / BK, lda = g.lda;
    unsigned voffA[2], voffB[2];
#pragma unroll
    for (int i = 0; i < 2; ++i) { int R, C; stage_rc(tid * 16 + i * 8192, R, C); const int Rb = (R & ~31) + perm32(R & 31);
        voffA[i] = (unsigned)(R * lda + C) * 2u; voffB[i] = (unsigned)(Rb * K + C) * 2u; }
    const size_t kstep = (size_t)(BK * 2);
    const size_t hstepA = (size_t)HALF * lda * 2, hstepB = (size_t)HALF * K * 2;
    const size_t tstepA = 2 * hstepA, tstepB = 2 * hstepB;
    const unsigned ldsw = (unsigned)wid * 1024u;
    const int aoff = lds_byte(wr * 64 + fr, fq * 8), boff = lds_byte(wc * 32 + fr, fq * 8);
#define PG8_SA(b, h) (((b) * 2 + (h)) * HTB)
#define PG8_SB(b, h) ((4 + (b) * 2 + (h)) * HTB)
#define PG8_STAGE(bufoff, gbase, voff) do { _Pragma("unroll") for (int _i = 0; _i < 2; ++_i) \
        __builtin_amdgcn_global_load_lds((const unsigned*)((const char*)(gbase) + (voff)[_i]), (PG8_LAS unsigned*)(lds + (bufoff) + ldsw + _i * 8192), 16, 0, 0); } while (0)
#define PG8_LDA(dst, b, h) do { _Pragma("unroll") for (int m = 0; m < 4; ++m) { const u32x4 _l = *(const PG8_LAS u32x4*)(lds + PG8_SA(b, h) + aoff + m * 2048), _h = *(const PG8_LAS u32x4*)(lds + PG8_SA(b, h) + aoff + m * 2048 + 1024); \
        dst[m] = (i32x8){(int)_l.x, (int)_l.y, (int)_l.z, (int)_l.w, (int)_h.x, (int)_h.y, (int)_h.z, (int)_h.w}; } } while (0)
#define PG8_LDB(dst, b, h) do { _Pragma("unroll") for (int n = 0; n < 2; ++n) { const u32x4 _l = *(const PG8_LAS u32x4*)(lds + PG8_SB(b, h) + boff + n * 2048), _h = *(const PG8_LAS u32x4*)(lds + PG8_SB(b, h) + boff + n * 2048 + 1024); \
        dst[n] = (i32x8){(int)_l.x, (int)_l.y, (int)_l.z, (int)_l.w, (int)_h.x, (int)_h.y, (int)_h.z, (int)_h.w}; } } while (0)
#define PG8_MMA(ai, bj, At, Bt) do { __builtin_amdgcn_s_setprio(1); \
        if constexpr (FP8) { _Pragma("unroll") for (int m = 0; m < 4; ++m) _Pragma("unroll") for (int n = 0; n < 2; ++n) \
            asm volatile("v_mfma_scale_f32_16x16x128_f8f6f4 %0, %1, %2, %0, %3, %4 op_sel_hi:[0,0,0]" : "+v"(acc[ai][bj][m][n]) : "v"(Bt[n]), "v"(At[m]), "v"(scale_w), "v"(scale_x)); } \
        else { _Pragma("unroll") for (int m = 0; m < 4; ++m) _Pragma("unroll") for (int n = 0; n < 2; ++n) { \
            const i32x8 _a = At[m], _b = Bt[n]; \
            const bf16x8 _a0 = __builtin_bit_cast(bf16x8, (u32x4){(unsigned)_a[0], (unsigned)_a[1], (unsigned)_a[2], (unsigned)_a[3]}), _a1 = __builtin_bit_cast(bf16x8, (u32x4){(unsigned)_a[4], (unsigned)_a[5], (unsigned)_a[6], (unsigned)_a[7]}); \
            const bf16x8 _b0 = __builtin_bit_cast(bf16x8, (u32x4){(unsigned)_b[0], (unsigned)_b[1], (unsigned)_b[2], (unsigned)_b[3]}), _b1 = __builtin_bit_cast(bf16x8, (u32x4){(unsigned)_b[4], (unsigned)_b[5], (unsigned)_b[6], (unsigned)_b[7]}); \
            acc[ai][bj][m][n] = __builtin_amdgcn_mfma_f32_16x16x32_bf16(_b0, _a0, acc[ai][bj][m][n], 0, 0, 0); \
            acc[ai][bj][m][n] = __builtin_amdgcn_mfma_f32_16x16x32_bf16(_b1, _a1, acc[ai][bj][m][n], 0, 0, 0); } } \
        __builtin_amdgcn_s_setprio(0); } while (0)
#define PG8_WAIT_V(n) asm volatile("s_waitcnt vmcnt(" #n ")" ::: "memory")
#define PG8_WAIT_L(n) asm volatile("s_waitcnt lgkmcnt(" #n ")" ::: "memory")
#define PG8_BAR __builtin_amdgcn_s_barrier()
#define PG8_SCHED __builtin_amdgcn_sched_barrier(0)
    Unit cur, nxt; int ui = 0;
    if (!S.next(0, cur)) return;
    f32x4 acc[2][2][4][2];
#pragma unroll
    for (int a = 0; a < 2; ++a)
#pragma unroll
        for (int b = 0; b < 2; ++b)
#pragma unroll
            for (int m = 0; m < 4; ++m)
#pragma unroll
                for (int n = 0; n < 2; ++n) acc[a][b][m][n] = (f32x4){0.f, 0.f, 0.f, 0.f};
    i32x8 At[4], B0[2], B1[2];
    const char* cA = (const char*)g.A + (size_t)(PA ? cur.acol : cur.pm) * tstepA + (HM ? (size_t)cur.mh * hstepA : 0); const char* cB = (const char*)(g.Bt + (size_t)cur.e * g.bstride_e) + (size_t)cur.pn * tstepB;
    if constexpr (KS) { cA += (size_t)cur.k0 * kstep; cB += (size_t)cur.k0 * kstep; }
    int ntc = KS ? cur.ntu : nt;
    PG8_STAGE(PG8_SB(0, 0), cB, voffB); PG8_STAGE(PG8_SB(0, 1), cB + hstepB, voffB); PG8_STAGE(PG8_SA(0, 0), cA, voffA); PG8_STAGE(PG8_SA(0, 1), cA + hstepA, voffA);
    if (wr == 1) PG8_BAR;
    PG8_WAIT_V(2); PG8_BAR;
    PG8_STAGE(PG8_SB(1, 0), cB + kstep, voffB); PG8_STAGE(PG8_SA(1, 0), cA + kstep, voffA); PG8_STAGE(PG8_SB(1, 1), cB + hstepB + kstep, voffB);
    PG8_WAIT_V(6); PG8_BAR;
    for (;;) {
        const bool has_next = S.next(ui + 1, nxt);
        const char* nA = has_next ? (const char*)g.A + (size_t)(PA ? nxt.acol : nxt.pm) * tstepA + (KS ? (size_t)nxt.k0 * kstep : 0) + (HM ? (size_t)nxt.mh * hstepA : 0) : cA;
        const char* nB = has_next ? (const char*)(g.Bt + (size_t)nxt.e * g.bstride_e) + (size_t)nxt.pn * tstepB + (KS ? (size_t)nxt.k0 * kstep : 0) : cB;
        for (int t = 0; t < ntc; t += 2) {
            const bool last = (t == ntc - 2);
            const char* a1 = cA + (size_t)(t + 1) * kstep;
            const char* a2 = last ? nA : cA + (size_t)(t + 2) * kstep; const char* b2 = last ? nB : cB + (size_t)(t + 2) * kstep;
            const char* a3 = a2 + kstep; const char* b3 = b2 + kstep;
            PG8_LDB(B0, 0, 0); PG8_LDB(B1, 0, 1); PG8_SCHED; PG8_LDA(At, 0, 0); PG8_STAGE(PG8_SA(1, 1), a1 + hstepA, voffA);
            PG8_WAIT_V(8); PG8_WAIT_L(0); PG8_BAR; PG8_MMA(0, 0, At, B0); PG8_MMA(0, 1, At, B1); PG8_BAR; PG8_SCHED;
            PG8_LDA(At, 0, 1); PG8_STAGE(PG8_SB(0, 0), b2, voffB); PG8_STAGE(PG8_SB(0, 1), b2 + hstepB, voffB); PG8_STAGE(PG8_SA(0, 0), a2, voffA);
            PG8_WAIT_V(8); PG8_WAIT_L(0); PG8_BAR; if constexpr (!HM) { PG8_MMA(1, 0, At, B0); PG8_MMA(1, 1, At, B1); } PG8_BAR; PG8_SCHED;
            PG8_LDB(B0, 1, 0); PG8_LDB(B1, 1, 1); PG8_SCHED; PG8_LDA(At, 1, 0); PG8_STAGE(PG8_SA(0, 1), a2 + hstepA, voffA);
            PG8_WAIT_V(8); PG8_WAIT_L(0); PG8_BAR; PG8_MMA(0, 0, At, B0); PG8_MMA(0, 1, At, B1); PG8_BAR; PG8_SCHED;
            PG8_LDA(At, 1, 1); PG8_STAGE(PG8_SB(1, 0), b3, voffB); PG8_STAGE(PG8_SB(1, 1), b3 + hstepB, voffB); PG8_STAGE(PG8_SA(1, 0), a3, voffA);
            PG8_WAIT_V(8); PG8_WAIT_L(0); PG8_BAR; if constexpr (!HM) { PG8_MMA(1, 0, At, B0); PG8_MMA(1, 1, At, B1); } PG8_BAR; PG8_SCHED;
        }
        if constexpr (ALIGN) { if (wr == 0) PG8_BAR; }
        if constexpr (FP8) asm volatile("s_nop 15\n\ts_nop 15" ::: "memory");
        E(acc, cur, wr, wc, fr, fq);
        if (!has_next) break;
#pragma unroll
        for (int a = 0; a < 2; ++a)
#pragma unroll
            for (int b = 0; b < 2; ++b)
#pragma unroll
                for (int m = 0; m < 4; ++m)
#pragma unroll
                    for (int n = 0; n < 2; ++n) acc[a][b][m][n] = (f32x4){0.f, 0.f, 0.f, 0.f};
        cur = nxt; cA = nA; cB = nB; ++ui; if constexpr (KS) ntc = cur.ntu;
        if constexpr (ALIGN) { if (wr == 1) PG8_BAR; }
    }
    PG8_WAIT_V(0);
    if constexpr (!ALIGN) { if (wr == 0) PG8_BAR; }
    PG8_BAR;
#undef PG8_SA
#undef PG8_SB
#undef PG8_STAGE
#undef PG8_LDA
#undef PG8_LDB
#undef PG8_MMA
#undef PG8_WAIT_V
#undef PG8_WAIT_L
#undef PG8_BAR
#undef PG8_SCHED
}
template <class Epi, class Sched>
__device__ __forceinline__ void gemm_phase2(PG8_LAS unsigned char* lds, const Gemm2 g, const Sched& S, const Epi& E, unsigned* sig = nullptr) {
    const int tid = threadIdx.x, wid = __builtin_amdgcn_readfirstlane(tid >> 6), lane = tid & 63, wr = wid >> 2, wc = wid & 3, fr = lane & 15, fq = lane >> 4;
    int K0 = g.K[0], K1 = g.K[1]; asm volatile("" : "+s"(K0), "+s"(K1));
    unsigned voffA0[2], voffA1[2], voffB0[2], voffB1[2];
#pragma unroll
    for (int i = 0; i < 2; ++i) { int R, C; stage_rc(tid * 16 + i * 8192, R, C); const int Rb = (R & ~31) + perm32(R & 31);
        voffA0[i] = (unsigned)(R * g.lda[0] + C) * 2u; voffB0[i] = (unsigned)(Rb * K0 + C) * 2u; voffA1[i] = (unsigned)(R * g.lda[1] + C) * 2u; voffB1[i] = (unsigned)(Rb * K1 + C) * 2u; }
    const size_t kstep = (size_t)(BK * 2);
    const unsigned ldsw = (unsigned)wid * 1024u;
    const int aoff = lds_byte(wr * 64 + fr, fq * 8), boff = lds_byte(wc * 32 + fr, fq * 8);
#define PG8_SA(b, h) (((b) * 2 + (h)) * HTB)
#define PG8_SB(b, h) ((4 + (b) * 2 + (h)) * HTB)
#define PG8_STAGE(bufoff, gbase, v0, v1) do { \
        __builtin_amdgcn_global_load_lds((const unsigned*)((const char*)(gbase) + (v0)), (PG8_LAS unsigned*)(lds + (bufoff) + ldsw), 16, 0, 0); \
        __builtin_amdgcn_global_load_lds((const unsigned*)((const char*)(gbase) + (v1)), (PG8_LAS unsigned*)(lds + (bufoff) + ldsw + 8192), 16, 0, 0); } while (0)
#define PG8_LDA(dst, b, h) do { _Pragma("unroll") for (int m = 0; m < 4; ++m) _Pragma("unroll") for (int k = 0; k < 2; ++k) dst[m][k] = *(const PG8_LAS bf16x8*)(lds + PG8_SA(b, h) + aoff + m * 2048 + k * 1024); } while (0)
#define PG8_LDB(dst, b, h) do { _Pragma("unroll") for (int n = 0; n < 2; ++n) _Pragma("unroll") for (int k = 0; k < 2; ++k) dst[n][k] = *(const PG8_LAS bf16x8*)(lds + PG8_SB(b, h) + boff + n * 2048 + k * 1024); } while (0)
#define PG8_MMA(ai, bj, At, Bt) do { __builtin_amdgcn_s_setprio(1); _Pragma("unroll") for (int m = 0; m < 4; ++m) _Pragma("unroll") for (int n = 0; n < 2; ++n) _Pragma("unroll") for (int k = 0; k < 2; ++k) \
        acc[ai][bj][m][n] = __builtin_amdgcn_mfma_f32_16x16x32_bf16(Bt[n][k], At[m][k], acc[ai][bj][m][n], 0, 0, 0); __builtin_amdgcn_s_setprio(0); } while (0)
#define PG8_WAIT_V(n) asm volatile("s_waitcnt vmcnt(" #n ")" ::: "memory")
#define PG8_WAIT_L(n) asm volatile("s_waitcnt lgkmcnt(" #n ")" ::: "memory")
#define PG8_BAR __builtin_amdgcn_s_barrier()
#define PG8_SCHED __builtin_amdgcn_sched_barrier(0)
    Unit cur, nxt; int ui = 0;
    if (!S.next(0, cur)) return;
    f32x4 acc[2][2][4][2];
#pragma unroll
    for (int a = 0; a < 2; ++a)
#pragma unroll
        for (int b = 0; b < 2; ++b)
#pragma unroll
            for (int m = 0; m < 4; ++m)
#pragma unroll
                for (int n = 0; n < 2; ++n) acc[a][b][m][n] = (f32x4){0.f, 0.f, 0.f, 0.f};
    bf16x8 At[4][2], B0[2][2], B1[2][2];
#define PG8_CFG(u, cA_, cB_, hA_, hB_, vA0_, vA1_, vB0_, vB1_, nt_) do { const int _k = (u).e; const int _K = _k ? K1 : K0; const int _lda = _k ? g.lda[1] : g.lda[0]; \
        hA_ = (size_t)HALF * _lda * 2; hB_ = (size_t)HALF * _K * 2; nt_ = _K / BK; \
        cA_ = (const char*)(_k ? g.A[1] : g.A[0]) + (size_t)(u).pm * 2 * hA_ + (size_t)(u).acol * 2; cB_ = (const char*)(_k ? g.Bt[1] : g.Bt[0]) + (size_t)(u).pn * 2 * hB_; \
        vA0_ = _k ? voffA1[0] : voffA0[0]; vA1_ = _k ? voffA1[1] : voffA0[1]; vB0_ = _k ? voffB1[0] : voffB0[0]; vB1_ = _k ? voffB1[1] : voffB0[1]; } while (0)
    const char *cA, *cB, *nA, *nB; size_t chA, chB, nhA, nhB; unsigned cvA0, cvA1, cvB0, cvB1, nvA0, nvA1, nvB0, nvB1; int nt, nnt;
    PG8_CFG(cur, cA, cB, chA, chB, cvA0, cvA1, cvB0, cvB1, nt);
    PG8_STAGE(PG8_SB(0, 0), cB, cvB0, cvB1); PG8_STAGE(PG8_SB(0, 1), cB + chB, cvB0, cvB1); PG8_STAGE(PG8_SA(0, 0), cA, cvA0, cvA1); PG8_STAGE(PG8_SA(0, 1), cA + chA, cvA0, cvA1);
    if (wr == 1) PG8_BAR;
    PG8_WAIT_V(2); PG8_BAR;
    PG8_STAGE(PG8_SB(1, 0), cB + kstep, cvB0, cvB1); PG8_STAGE(PG8_SA(1, 0), cA + kstep, cvA0, cvA1); PG8_STAGE(PG8_SB(1, 1), cB + chB + kstep, cvB0, cvB1);
    PG8_WAIT_V(6); PG8_BAR;
    for (;;) {
        const bool has_next = S.next(ui + 1, nxt);
        if (has_next) { PG8_CFG(nxt, nA, nB, nhA, nhB, nvA0, nvA1, nvB0, nvB1, nnt); }
        else { nA = cA; nB = cB; nhA = chA; nhB = chB; nvA0 = cvA0; nvA1 = cvA1; nvB0 = cvB0; nvB1 = cvB1; nnt = nt; }
        for (int t = 0; t < nt; t += 2) {
            const bool last = (t == nt - 2);
            const char* a1 = cA + (size_t)(t + 1) * kstep;
            const char* a2 = last ? nA : cA + (size_t)(t + 2) * kstep; const char* b2 = last ? nB : cB + (size_t)(t + 2) * kstep;
            const char* a3 = a2 + kstep; const char* b3 = b2 + kstep;
            const size_t hA2 = last ? nhA : chA, hB2 = last ? nhB : chB;
            const unsigned xA0 = last ? nvA0 : cvA0, xA1 = last ? nvA1 : cvA1, xB0 = last ? nvB0 : cvB0, xB1 = last ? nvB1 : cvB1;
            PG8_LDB(B0, 0, 0); PG8_LDB(B1, 0, 1); PG8_SCHED; PG8_LDA(At, 0, 0); PG8_STAGE(PG8_SA(1, 1), a1 + chA, cvA0, cvA1);
            PG8_WAIT_V(8); PG8_WAIT_L(0); PG8_BAR; PG8_MMA(0, 0, At, B0); PG8_MMA(0, 1, At, B1); PG8_BAR; PG8_SCHED;
            PG8_LDA(At, 0, 1); PG8_STAGE(PG8_SB(0, 0), b2, xB0, xB1); PG8_STAGE(PG8_SB(0, 1), b2 + hB2, xB0, xB1); PG8_STAGE(PG8_SA(0, 0), a2, xA0, xA1);
            PG8_WAIT_V(8); PG8_WAIT_L(0); PG8_BAR; PG8_MMA(1, 0, At, B0); PG8_MMA(1, 1, At, B1); PG8_BAR; PG8_SCHED;
            PG8_LDB(B0, 1, 0); PG8_LDB(B1, 1, 1); PG8_SCHED; PG8_LDA(At, 1, 0); PG8_STAGE(PG8_SA(0, 1), a2 + hA2, xA0, xA1);
            PG8_WAIT_V(8); PG8_WAIT_L(0); PG8_BAR; PG8_MMA(0, 0, At, B0); PG8_MMA(0, 1, At, B1); PG8_BAR; PG8_SCHED;
            PG8_LDA(At, 1, 1); PG8_STAGE(PG8_SB(1, 0), b3, xB0, xB1); PG8_STAGE(PG8_SB(1, 1), b3 + hB2, xB0, xB1); PG8_STAGE(PG8_SA(1, 0), a3, xA0, xA1);
            PG8_WAIT_V(8); PG8_WAIT_L(0); PG8_BAR; PG8_MMA(1, 0, At, B0); PG8_MMA(1, 1, At, B1); PG8_BAR; PG8_SCHED;
        }
        if (wr == 0) PG8_BAR;
        E(acc, cur, wr, wc, fr, fq);
        if (sig != nullptr && cur.e == 1) {
            PG8_WAIT_V(0); PG8_BAR;
            if (tid == 0) { __builtin_amdgcn_fence(__ATOMIC_RELEASE, "agent"); __hip_atomic_fetch_add(sig, 1u, __ATOMIC_RELAXED, __HIP_MEMORY_SCOPE_AGENT); } }
        if (!has_next) break;
#pragma unroll
        for (int a = 0; a < 2; ++a)
#pragma unroll
            for (int b = 0; b < 2; ++b)
#pragma unroll
                for (int m = 0; m < 4; ++m)
#pragma unroll
                    for (int n = 0; n < 2; ++n) acc[a][b][m][n] = (f32x4){0.f, 0.f, 0.f, 0.f};
        cur = nxt; cA = nA; cB = nB; chA = nhA; chB = nhB; cvA0 = nvA0; cvA1 = nvA1; cvB0 = nvB0; cvB1 = nvB1; nt = nnt; ++ui;
        if (wr == 1) PG8_BAR;
    }
    PG8_WAIT_V(0);
    PG8_BAR;
#undef PG8_CFG
#undef PG8_SA
#undef PG8_SB
#undef PG8_STAGE
#undef PG8_LDA
#undef PG8_LDB
#undef PG8_MMA
#undef PG8_WAIT_V
#undef PG8_WAIT_L
#undef PG8_BAR
#undef PG8_SCHED
}
}

constexpr int NB = 8, SEQ = 2048, D = 1024, T = NB * SEQ;
constexpr int NH = 16, HS = 64;
constexpr int FFD = 2816, FFE = 3584, NE = 8;
constexpr int QD = 1536;
constexpr int NCAT = 3328;
constexpr int MOE_ROWS = 34816;
constexpr float RMS_EPS = 1e-5f, GN_EPS = 64e-5f;
constexpr float SS_SCALE = 1048576.0f;

constexpr size_t MiB = 1u << 20;
constexpr size_t WS_CTL = 0, CTL_ZERO_BYTES = 32768;
constexpr size_t CTL_LORA_DONE = 1024;
constexpr size_t CTL_BAR = 16384;
constexpr size_t CTL_SS1 = 65536, CTL_SS2 = CTL_SS1 + 131072, CTL_SS3 = CTL_SS2 + 131072;
constexpr size_t CTL_CNT = 524288;
constexpr size_t WS_LIST = 1 * MiB;
constexpr size_t WS_LGATE = WS_LIST + 512 * 1024;
constexpr size_t WS_TOKEP = 2 * MiB;
constexpr size_t WS_TGATE = WS_TOKEP + 128 * 1024;
constexpr size_t WS_SRSTD = WS_TGATE + 128 * 1024;
constexpr size_t WS_SGATE = WS_SRSTD + 160 * 1024;
constexpr size_t WS_WRKV = 3 * MiB;
constexpr size_t WS_WLORA = 9 * MiB;
constexpr size_t WS_WLU = 16 * MiB;
constexpr size_t WS_WO = 18 * MiB;
constexpr size_t WS_W13F = 20 * MiB;
constexpr size_t WS_W2F = 31 * MiB;
constexpr size_t WS_WQKV = 37 * MiB;
constexpr size_t WS_WAO = 46 * MiB;
constexpr size_t WS_R = 47 * MiB, WS_K = 79 * MiB, WS_V = 111 * MiB, WS_LW = 143 * MiB, WS_AA = 175 * MiB, WS_GG = 207 * MiB;
constexpr size_t WS_MH = 3 * MiB;
constexpr size_t WS_MW13 = 241 * MiB;
constexpr size_t WS_MW2 = 297 * MiB;
constexpr size_t WS_HCAT = 353 * MiB;
constexpr size_t WS_XR = 241 * MiB;
constexpr size_t WS_Z = 353 * MiB;
constexpr size_t WS_LH = 417 * MiB;
constexpr size_t WS_X1B = 47 * MiB;
constexpr size_t WS_FH = 79 * MiB;
constexpr size_t WS_X2B = 207 * MiB;
constexpr size_t WS_Q = 47 * MiB, WS_KK = 95 * MiB, WS_VV = 143 * MiB;
constexpr size_t WS_OM = 191 * MiB;
constexpr size_t WS_X3B = 207 * MiB;
constexpr size_t WS_X2F8 = 425 * MiB;
constexpr size_t WS_XG = 325 * MiB;
constexpr size_t WS_CONTRIB = 122 * MiB;
constexpr size_t WS_SLAB = 325 * MiB;
constexpr size_t WS_OG = 353 * MiB;
constexpr size_t WS_LSE = 401 * MiB;
constexpr size_t WS_END = 453 * MiB;

constexpr int NWAVES = 8;
constexpr int LDS_BYTES = 163840;
constexpr int RING_OFF = 0;
constexpr int MISC_OFF = 163840 - 256;

#define GAS __attribute__((address_space(1)))
#define LAS __attribute__((address_space(3)))
typedef unsigned short bf16;
typedef float f32x4 __attribute__((ext_vector_type(4)));
typedef float f32x2 __attribute__((ext_vector_type(2)));
typedef unsigned u32x4 __attribute__((ext_vector_type(4)));
typedef unsigned u32x2 __attribute__((ext_vector_type(2)));

typedef __bf16 bf16x2_t __attribute__((ext_vector_type(2)));
__device__ __forceinline__ unsigned pk2(float lo, float hi) { bf16x2_t v; v.x = (__bf16)lo; v.y = (__bf16)hi; return __builtin_bit_cast(unsigned, v); }
__device__ __forceinline__ float bf_lo(unsigned u) { return __uint_as_float(u << 16); }
__device__ __forceinline__ float bf_hi(unsigned u) { return __uint_as_float(u & 0xffff0000u); }
__device__ __forceinline__ float bf1(bf16 b) { return __uint_as_float(((unsigned)b) << 16); }
__device__ __forceinline__ float fast_rcp(float x) { return __builtin_amdgcn_rcpf(x); }
__device__ __forceinline__ float sigmoidf_(float x) { return __builtin_amdgcn_rcpf(1.0f + __expf(-x)); }

#define XB_TMO      128
#define XB_XCNT(j)  (256  + 64 * (j))
#define XB_XSUB(j)  (1280 + 64 * (j))
#define XB_XGEN(j)  (2304 + 64 * (j))
#define XB_TOP      3328
#define XB_TOPGEN   3392
#define XCD_BAR_WORDS 3456
#define XB_SPIN_CAP (1u << 18)

__device__ __forceinline__ unsigned xb_ld(unsigned* p)              { return __hip_atomic_load(p, __ATOMIC_RELAXED, __HIP_MEMORY_SCOPE_AGENT); }
__device__ __forceinline__ unsigned xb_add(unsigned* p, unsigned v) { return __hip_atomic_fetch_add(p, v, __ATOMIC_RELAXED, __HIP_MEMORY_SCOPE_AGENT); }
__device__ __forceinline__ unsigned xb_xcc_id() { return (unsigned)__builtin_amdgcn_s_getreg((3 << 11) | 20) & 0xFu; }
#define XB_SPIN(cond, bar) do { unsigned _sp = 0; while (cond) { __builtin_amdgcn_s_sleep(1); \
    if ((++_sp & 255u) == 0u) { if (xb_ld(&(bar)[XB_TMO])) break; if (_sp > XB_SPIN_CAP) { atomicAdd(&(bar)[XB_TMO], 1u); break; } } } } while (0)

struct XcdBarrier { unsigned* bar; unsigned x; volatile LAS unsigned* st; };

__device__ __forceinline__ XcdBarrier xcd_barrier_post(unsigned* bar, volatile LAS unsigned* st) {
    XcdBarrier b; b.bar = bar; b.x = xb_xcc_id(); b.st = st;
    if (threadIdx.x == 0) (void)xb_add(&bar[XB_XCNT(b.x)], 1u);
    return b;
}
__device__ __forceinline__ void xcd_barrier_complete(unsigned* bar, unsigned x, unsigned& nloc, unsigned& nx) {
    const unsigned G = gridDim.x * gridDim.y * gridDim.z;
    unsigned sum, cnt, mine, sp = 0u;
    for (;;) {
        sum = 0u; cnt = 0u; mine = 0u;
#pragma unroll
        for (unsigned j = 0; j < 16; ++j) { const unsigned c = xb_ld(&bar[XB_XCNT(j)]); sum += c; cnt += (c > 0u) ? 1u : 0u; mine = (j == x) ? c : mine; }
        if (sum == G) break;
        __builtin_amdgcn_s_sleep(1);
        if ((++sp & 255u) == 0u) { if (xb_ld(&bar[XB_TMO])) break; if (sp > XB_SPIN_CAP) { atomicAdd(&bar[XB_TMO], 1u); break; } }
    }
    nloc = mine > 0u ? mine : 1u; nx = cnt > 0u ? cnt : 1u;
}
__device__ __forceinline__ void xcd_barrier(const XcdBarrier& b) {
    asm volatile("s_waitcnt vmcnt(0)" ::: "memory");
    __syncthreads();
    if (threadIdx.x == 0) {
        unsigned* bar = b.bar;
        __builtin_amdgcn_s_waitcnt(0);
        unsigned nloc = b.st[0], nx = b.st[1];
        if (nloc == 0u) { xcd_barrier_complete(bar, b.x, nloc, nx); b.st[0] = nloc; b.st[1] = nx; }
        const unsigned old = xb_add(&bar[XB_XSUB(b.x)], 1u);
        const unsigned gen = old / nloc;
        if (old + 1u == (gen + 1u) * nloc) {
            __builtin_amdgcn_fence(__ATOMIC_RELEASE, "agent");
            asm volatile("s_waitcnt vmcnt(0)" ::: "memory");
            const unsigned og = xb_add(&bar[XB_TOP], 1u);
            const unsigned tg = og / nx;
            if (og + 1u == (tg + 1u) * nx) xb_add(&bar[XB_TOPGEN], 1u);
            else XB_SPIN(xb_ld(&bar[XB_TOPGEN]) == tg, bar);
            __builtin_amdgcn_fence(__ATOMIC_ACQUIRE, "agent");
            xb_add(&bar[XB_XGEN(b.x)], 1u);
            asm volatile("s_waitcnt vmcnt(0)" ::: "memory");
        } else {
            XB_SPIN(xb_ld(&bar[XB_XGEN(b.x)]) == gen, bar);
            __builtin_amdgcn_fence(__ATOMIC_ACQUIRE, "agent");
            asm volatile("s_waitcnt vmcnt(0)" ::: "memory");
        }
    }
    __syncthreads();
}

struct Args { const float* in[33]; float* out; unsigned char* ws; int ph_lo, ph_hi; };
enum { I_X = 0, I_NG, I_MU, I_WR, I_WK, I_WV, I_W0, I_W1, I_W2, I_A0, I_A1, I_A2, I_G1, I_G2, I_KK, I_KA, I_RK, I_LNW, I_LNB, I_WO, I_KVG, I_WKV, I_WQ, I_AWO,
       I_F1, I_F3, I_F2, I_ROUTER, I_RBIAS, I_M1, I_M3, I_M2, I_FG };

struct TrJob { const float* src; int K, N; bf16* dst; int ldd, drow, dcol; const float* sc; int mode  , ileave  ; };
__device__ __forceinline__ int trjob_items(const TrJob& j) { return (j.K >> 6) * (j.N >> 6); }
__device__ __forceinline__ void tr_item(const TrJob& j, int item, LAS float* scr, int lane) {
    const int nblk = j.N >> 6, kb = item / nblk, nb = item - kb * nblk, k0 = kb << 6, n0 = nb << 6;
    const int lr = lane >> 4, n4 = (lane & 15) * 4;
#pragma unroll
    for (int half = 0; half < 2; ++half) {
        f32x4 v[8];
#pragma unroll
        for (int i = 0; i < 8; ++i) { const int kk = half * 32 + i * 4 + lr; v[i] = __builtin_nontemporal_load((const GAS f32x4*)(j.src + (size_t)(k0 + kk) * j.N + n0 + n4)); }
#pragma unroll
        for (int i = 0; i < 8; ++i) { const int kk = half * 32 + i * 4 + lr; float s = 1.0f;
            if (j.mode == 1) s = j.sc[k0 + kk]; else if (j.mode == 2) s = 1.0f - j.sc[k0 + kk];
            *(LAS f32x4*)(scr + kk * 68 + ((n4 + 4 * (kk >> 3)) & 63)) = v[i] * s; }
    }
    asm volatile("s_waitcnt lgkmcnt(0)" ::: "memory");
    const int c8 = lane & 7;
#pragma unroll
    for (int it = 0; it < 8; ++it) {
        const int n = it * 8 + (lane >> 3); const int col = (n + 4 * c8) & 63;
        const LAS float* s = scr + (8 * c8) * 68 + col;
        u32x4 o; o.x = pk2(s[0 * 68], s[1 * 68]); o.y = pk2(s[2 * 68], s[3 * 68]); o.z = pk2(s[4 * 68], s[5 * 68]); o.w = pk2(s[6 * 68], s[7 * 68]);
        const int ng = n0 + n; int row = j.drow + ng;
        if (j.ileave) row = j.drow + (ng >> 7) * 256 + (j.ileave - 1) * 128 + (ng & 127);
        *(GAS u32x4*)(j.dst + (size_t)row * j.ldd + j.dcol + k0 + 8 * c8) = o;
    }
    asm volatile("s_waitcnt lgkmcnt(0)" ::: "memory");
}

__device__ __forceinline__ unsigned pk4_fp8(float a, float b, float c, float d) { int w = 0; w = __builtin_amdgcn_cvt_pk_fp8_f32(a, b, w, false); w = __builtin_amdgcn_cvt_pk_fp8_f32(c, d, w, true); return (unsigned)w; }
__device__ __forceinline__ float clamp_fp8(float x) { return __builtin_amdgcn_fmed3f(x, -448.0f, 448.0f); }
struct TrJob8 { const float* src; int K, N; unsigned char* dst; int ldd; const float* sc; float mul; int ileave; };
__device__ __forceinline__ void tr_item8(const TrJob8& j, int item, LAS float* scr, int lane) {
    const int nblk = j.N >> 6, kb = item / nblk, nb = item - kb * nblk, k0 = kb << 6, n0 = nb << 6;
    const int lr = lane >> 4, n4 = (lane & 15) * 4;
#pragma unroll
    for (int half = 0; half < 2; ++half) {
        f32x4 v[8];
#pragma unroll
        for (int i = 0; i < 8; ++i) { const int kk = half * 32 + i * 4 + lr; v[i] = __builtin_nontemporal_load((const GAS f32x4*)(j.src + (size_t)(k0 + kk) * j.N + n0 + n4)); }
#pragma unroll
        for (int i = 0; i < 8; ++i) { const int kk = half * 32 + i * 4 + lr; const float s = j.sc ? j.sc[k0 + kk] * j.mul : j.mul;
            *(LAS f32x4*)(scr + kk * 68 + ((n4 + 4 * (kk >> 3)) & 63)) = v[i] * s; }
    }
    asm volatile("s_waitcnt lgkmcnt(0)" ::: "memory");
    const int c16 = lane & 3;
#pragma unroll
    for (int it = 0; it < 4; ++it) {
        const int n = it * 16 + (lane >> 2);
        u32x4 o; unsigned wv[4];
#pragma unroll
        for (int q = 0; q < 4; ++q) { const int c8 = 2 * c16 + (q >> 1), kb8 = 8 * c8 + 4 * (q & 1); const LAS float* sp = scr + kb8 * 68 + ((n + 4 * c8) & 63);
            wv[q] = pk4_fp8(sp[0], sp[68], sp[2 * 68], sp[3 * 68]); }
        o.x = wv[0]; o.y = wv[1]; o.z = wv[2]; o.w = wv[3];
        const int ng = n0 + n; int row = ng;
        if (j.ileave) row = (ng >> 7) * 256 + (j.ileave - 1) * 128 + (ng & 127);
        *(GAS u32x4*)(j.dst + (size_t)row * j.ldd + k0 + 16 * c16) = o;
    }
    asm volatile("s_waitcnt lgkmcnt(0)" ::: "memory");
}
constexpr int NJ0 = 3 + 6 + 3 + 1 + 2 + 1;
constexpr int NJ_EARLY = 12;
__device__ __forceinline__ TrJob job0(const Args& a, int j) {
    unsigned char* ws = a.ws; TrJob t; t.ileave = 0; t.mode = 0; t.sc = nullptr; t.dcol = 0; t.drow = 0;
    if (j < 3) { t.src = j == 0 ? a.in[I_WR] : (j == 1 ? a.in[I_WK] : a.in[I_WV]); t.K = 1024; t.N = 1024; t.dst = (bf16*)(ws + WS_WRKV); t.ldd = 1024; t.drow = 1024 * j; return t; }
    j -= 3;
    if (j < 6) {
        const int w = j >> 1, hi = j & 1;
        t.src = w == 0 ? a.in[I_W1] : (w == 1 ? a.in[I_A1] : a.in[I_G1]); const int mu = w == 0 ? 1 : (w == 1 ? 4 : 5);
        t.K = 1024; t.N = w == 2 ? 128 : 64; t.dst = (bf16*)(ws + WS_WLORA); t.ldd = 2048; t.drow = 64 * w; t.dcol = hi * 1024; t.sc = a.in[I_MU] + mu * D; t.mode = hi ? 2 : 1;
        return t; }
    j -= 6;
    if (j < 3) {
        t.src = j == 0 ? a.in[I_W2] : (j == 1 ? a.in[I_A2] : a.in[I_G2]); t.K = j == 2 ? 128 : 64; t.N = 1024; t.dst = (bf16*)(ws + WS_WLU); t.ldd = 128; t.drow = 1024 * j; t.dcol = j == 1 ? 64 : 0; return t; }
    j -= 3;
    if (j < 1) { t.src = a.in[I_WO]; t.K = 1024; t.N = 1024; t.dst = (bf16*)(ws + WS_WO); t.ldd = 1024; return t; }
    j -= 1;
    if (j < 2) { t.src = a.in[j ? I_F3 : I_F1]; t.K = 1024; t.N = FFD; t.dst = (bf16*)(ws + WS_W13F); t.ldd = 1024; t.sc = a.in[I_NG] + 1 * D; t.mode = 1; t.ileave = 1 + j; return t; }
    j -= 2;
    t.src = a.in[I_AWO]; t.K = 512; t.N = 1024; t.dst = (bf16*)(ws + WS_WAO); t.ldd = 512; return t;
}
constexpr float MW13_MUL = 64.0f, MW2_MUL = 128.0f, WQKV_MUL = 64.0f; constexpr int MW13_SCALE_BYTE = 127 - 6, MW2_SCALE_BYTE = 127 - 7, WQKV_SCALE_BYTE = 127 - 6;
__device__ __forceinline__ TrJob8 job_moe(const Args& a, int j) {
    TrJob8 t;
    if (j < 16) { const int e = j >> 1, w = j & 1;
        t.src = a.in[w ? I_M3 : I_M1] + (size_t)e * D * FFE; t.K = 1024; t.N = FFE; t.dst = a.ws + WS_MW13 + (size_t)e * 7168 * 1024; t.ldd = 1024; t.sc = a.in[I_NG] + 3 * D; t.mul = MW13_MUL; t.ileave = 1 + w; }
    else if (j == 26) { t.src = a.in[I_F2]; t.K = FFD; t.N = 1024; t.dst = a.ws + WS_W2F; t.ldd = FFD; t.sc = nullptr; t.mul = MW2_MUL; t.ileave = 0; }
    else if (j == 24) { t.src = a.in[I_WQ]; t.K = 1024; t.N = QD; t.dst = a.ws + WS_WQKV; t.ldd = 1024; t.sc = a.in[I_NG] + 2 * D; t.mul = WQKV_MUL; t.ileave = 0; }
    else if (j == 25) { t.src = a.in[I_WKV]; t.K = 1024; t.N = 2 * QD; t.dst = a.ws + WS_WQKV + (size_t)QD * 1024; t.ldd = 1024; t.sc = a.in[I_KVG]; t.mul = WQKV_MUL; t.ileave = 0; }
    else { const int e = j - 16;
        t.src = a.in[I_M2] + (size_t)e * FFE * D; t.K = FFE; t.N = 1024; t.dst = a.ws + WS_MW2 + (size_t)e * 1024 * FFE; t.ldd = FFE; t.sc = nullptr; t.mul = MW2_MUL; t.ileave = 0; }
    return t;
}
__device__ __forceinline__ float wave_sum(float v) {
#pragma unroll
    for (int o = 1; o < 64; o <<= 1) v += __shfl_xor(v, o);
    return v;
}
__device__ __forceinline__ float row16_sum(float v) {
    v += __builtin_bit_cast(float, __builtin_amdgcn_update_dpp(0, __builtin_bit_cast(int, v), 0xB1, 0xf, 0xf, false));
    v += __builtin_bit_cast(float, __builtin_amdgcn_update_dpp(0, __builtin_bit_cast(int, v), 0x4E, 0xf, 0xf, false));
    v += __builtin_bit_cast(float, __builtin_amdgcn_update_dpp(0, __builtin_bit_cast(int, v), 0x141, 0xf, 0xf, false));
    v += __builtin_bit_cast(float, __builtin_amdgcn_update_dpp(0, __builtin_bit_cast(int, v), 0x140, 0xf, 0xf, false));
    return v;
}


using pg8::Unit;
__device__ __forceinline__ float rstd_from_ss(const unsigned long long* ss, int row) {
    const float s = (float)ss[row] * (1.0f / SS_SCALE);
    return __builtin_amdgcn_rsqf(s * (1.0f / D) + RMS_EPS);
}
struct G1Order {
    int G, c, mode;
    __device__ bool next(int i, Unit& u) const {
        int L;
        if (mode == 0) { if (c >= 64 || i > 0) return false; u.pm = c; u.pn = 0; u.e = 1; u.acol = (c >> 3) * 1024; return true; }
        if (c < 64) { if (i > 1) return false; L = i * 64 + c; }
        else { L = 128 + (c - 64) + (G - 64) * i; if (L >= 768) return false; }
        const int xcd = L % 8, off = L / 8, wgid = xcd * 96 + off;
        const int gid = wgid / 32, fm = gid * 8;
        u.pm = fm + ((wgid % 32) % 8); u.pn = (u.pm >> 6) * 4 + (wgid % 32) / 8; u.e = 0; u.acol = 0; return true;
    }
};
struct EpiG1 {
    bf16 *r, *lh;
    __device__ __forceinline__ void operator()(const f32x4 (&acc)[2][2][4][2], const Unit& u, int wr, int wc, int fr, int fq) const {
        const int cw = wc * 32 + 8 * fq;
        if (u.e == 0) {
            const int which = u.pn >> 2, row0 = (u.pm - 64 * which) * 256 + wr * 64 + fr;
            bf16* base = r + (size_t)which * ((size_t)T * D); const int colt = (u.pn & 3) * 256 + cw;
#pragma unroll
            for (int ai = 0; ai < 2; ++ai)
#pragma unroll
                for (int m = 0; m < 4; ++m) { bf16* rowp = base + (size_t)(row0 + ai * 128 + m * 16) * D + colt;
#pragma unroll
                    for (int bj = 0; bj < 2; ++bj) { const f32x4 v0 = acc[ai][bj][m][0], v1 = acc[ai][bj][m][1];
                        u32x4 w; w.x = pk2(v0[0], v0[1]); w.y = pk2(v0[2], v0[3]); w.z = pk2(v1[0], v1[1]); w.w = pk2(v1[2], v1[3]);
                        *(GAS u32x4*)(rowp + bj * 128) = w; } }
        } else {
            const int row0 = u.pm * 256 + wr * 64 + fr;
#pragma unroll
            for (int ai = 0; ai < 2; ++ai)
#pragma unroll
                for (int m = 0; m < 4; ++m) { bf16* rowp = lh + (size_t)(row0 + ai * 128 + m * 16) * 256 + cw;
#pragma unroll
                    for (int bj = 0; bj < 2; ++bj) { const int c = cw + bj * 128; float x[8];
#pragma unroll
                        for (int i = 0; i < 4; ++i) { x[i] = acc[ai][bj][m][0][i]; x[4 + i] = acc[ai][bj][m][1][i]; }
#pragma unroll
                        for (int i = 0; i < 8; ++i) { if (c < 64) x[i] = 1.0f - 2.0f * __builtin_amdgcn_rcpf(1.0f + __expf(2.0f * x[i])); else if (c >= 128) x[i] = sigmoidf_(x[i]); }
                        u32x4 w; w.x = pk2(x[0], x[1]); w.y = pk2(x[2], x[3]); w.z = pk2(x[4], x[5]); w.w = pk2(x[6], x[7]);
                        *(GAS u32x4*)(rowp + bj * 128) = w; } }
        }
    }
};
struct G2Order { pg8::StaticOrder so;
    __device__ bool next(int i, Unit& u) const {
        if (so.G == 256) { int L; if (so.c >= 128) { if (i >= 4) return false; L = i * 128 + so.c - 128; } else { if (i >= 2) return false; L = 512 + i * 128 + so.c; }
            pg8::static_map(L, so.nM, so.nN, so.nwg, u); }
        else if (!so.next(i, u)) return false;
        u.acol = u.pn >= 8 ? 128 : 0; return true; } };
struct EpiG2 {
    bf16 *lw; const float *w0, *a0;
    __device__ __forceinline__ void operator()(const f32x4 (&acc)[2][2][4][2], const Unit& u, int wr, int wc, int fr, int fq) const {
        const int row0 = u.pm * 256 + wr * 64 + fr, which = u.pn >> 2, colt = (u.pn & 3) * 256 + wc * 32 + 8 * fq;
        bf16* base = lw + (size_t)which * ((size_t)T * D);
        const float* bp = which == 0 ? w0 : a0; const float bsc = which == 2 ? 0.f : 1.f, osc = which == 0 ? -0.6065306597f * 1.4426950408889634f : 1.0f;
#pragma unroll
        for (int bj = 0; bj < 2; ++bj) {
            const f32x4 b0 = *(const GAS f32x4*)(bp + colt + bj * 128) * bsc, b1 = *(const GAS f32x4*)(bp + colt + bj * 128 + 4) * bsc;
#pragma unroll
            for (int ai = 0; ai < 2; ++ai)
#pragma unroll
                for (int m = 0; m < 4; ++m) { bf16* rowp = base + (size_t)(row0 + ai * 128 + m * 16) * D + colt; float x[8];
#pragma unroll
                    for (int i = 0; i < 4; ++i) { x[i] = acc[ai][bj][m][0][i] + b0[i]; x[4 + i] = acc[ai][bj][m][1][i] + b1[i]; }
                    if (which != 2) {
#pragma unroll
                        for (int i = 0; i < 8; ++i) x[i] = osc * sigmoidf_(x[i]);
                    }
                    u32x4 w; w.x = pk2(x[0], x[1]); w.y = pk2(x[2], x[3]); w.z = pk2(x[4], x[5]); w.w = pk2(x[6], x[7]);
                    *(GAS u32x4*)(rowp + bj * 128) = w;
                    asm volatile("" ::: "memory"); }
        }
    }
};
template <bool R32> struct EpiResT {
    const float* resid32; const bf16* resid16; bf16* xb; unsigned long long* ss; unsigned char* x8;
    __device__ __forceinline__ void load(int row0, int col0, int st, f32x4 (&r)[4], u32x4 (&h)[2]) const {
        const size_t off = (size_t)(row0 + (st >> 2) * 128 + (st & 3) * 16) * D + col0;
        if constexpr (R32) { r[0] = *(const GAS f32x4*)(resid32 + off); r[1] = *(const GAS f32x4*)(resid32 + off + 4); r[2] = *(const GAS f32x4*)(resid32 + off + 128); r[3] = *(const GAS f32x4*)(resid32 + off + 132); }
        else { h[0] = *(const GAS u32x4*)(resid16 + off); h[1] = *(const GAS u32x4*)(resid16 + off + 128); }
    }
    __device__ __forceinline__ void operator()(const f32x4 (&acc)[2][2][4][2], const Unit& u, int wr, int wc, int fr, int fq) const {
        const int row0 = u.pm * 256 + wr * 64 + fr, col0 = u.pn * 256 + wc * 32 + 8 * fq;
        constexpr int DIST = R32 ? 1 : 3;
        f32x4 ring[4][4]; u32x4 ringh[4][2];
#pragma unroll
        for (int st = 0; st < DIST; ++st) load(row0, col0, st, ring[st], ringh[st]);
#pragma unroll
        for (int st = 0; st < 8; ++st) { const int ai = st >> 2, m = st & 3;
            if (st + DIST < 8) load(row0, col0, st + DIST, ring[(st + DIST) & 3], ringh[(st + DIST) & 3]);
            const int row = row0 + ai * 128 + m * 16; const size_t off = (size_t)row * D + col0; float sq = 0.f;
#pragma unroll
            for (int bj = 0; bj < 2; ++bj) {
                f32x4 r0, r1;
                if constexpr (R32) { r0 = ring[st & 3][2 * bj]; r1 = ring[st & 3][2 * bj + 1]; }
                else { const u32x4 rw = ringh[st & 3][bj]; r0 = (f32x4){bf_lo(rw.x), bf_hi(rw.x), bf_lo(rw.y), bf_hi(rw.y)}; r1 = (f32x4){bf_lo(rw.z), bf_hi(rw.z), bf_lo(rw.w), bf_hi(rw.w)}; }
                const f32x4 o0 = r0 + acc[ai][bj][m][0], o1 = r1 + acc[ai][bj][m][1];
                u32x4 w; w.x = pk2(o0[0], o0[1]); w.y = pk2(o0[2], o0[3]); w.z = pk2(o1[0], o1[1]); w.w = pk2(o1[2], o1[3]);
                *(GAS u32x4*)(xb + off + bj * 128) = w;
                if (x8) { u32x2 w8; w8.x = pk4_fp8(clamp_fp8(o0[0]), clamp_fp8(o0[1]), clamp_fp8(o0[2]), clamp_fp8(o0[3])); w8.y = pk4_fp8(clamp_fp8(o1[0]), clamp_fp8(o1[1]), clamp_fp8(o1[2]), clamp_fp8(o1[3])); *(GAS u32x2*)(x8 + off + bj * 128) = w8; }
                sq += (o0[0] * o0[0] + o0[1] * o0[1]) + (o0[2] * o0[2] + o0[3] * o0[3]) + (o1[0] * o1[0] + o1[1] * o1[1]) + (o1[2] * o1[2] + o1[3] * o1[3]); }
            sq += __shfl_xor(sq, 16); sq += __shfl_xor(sq, 32);
            if (fq == 0) atomicAdd(ss + row, (unsigned long long)(sq * SS_SCALE + 0.5f)); }
    }
};
template <bool HM> struct EpiSwigluT {
    bf16* hid; int ldc; const unsigned long long* ss; const float* srstd; int out8; const LAS float* rtab;
    __device__ __forceinline__ void operator()(const f32x4 (&acc)[2][2][4][2], const Unit& u, int wr, int wc, int fr, int fq) const {
        const int row0 = u.pm * 256 + wr * 64 + fr + (HM ? u.mh * 128 : 0), col0 = u.pn * 128 + wc * 32 + 8 * fq;
        float rsv[2][4];
#pragma unroll
        for (int ai = 0; ai < (HM ? 1 : 2); ++ai)
#pragma unroll
            for (int m = 0; m < 4; ++m) { const int row = row0 + ai * 128 + m * 16; rsv[ai][m] = rtab ? rtab[row & 2047] : (ss ? rstd_from_ss(ss, row) : (srstd ? srstd[row] : 1.0f)); }
#pragma unroll
        for (int ai = 0; ai < (HM ? 1 : 2); ++ai)
#pragma unroll
            for (int m = 0; m < 4; ++m) { const int row = row0 + ai * 128 + m * 16; const float rs = rsv[ai][m], rs2 = rs * rs, nrl = -1.4426950408889634f * rs; float x[8];
#pragma unroll
                for (int n = 0; n < 2; ++n)
#pragma unroll
                    for (int i = 0; i < 4; ++i) { const float a = acc[ai][0][m][n][i], b = acc[ai][1][m][n][i]; x[n * 4 + i] = (a * rs2) * b * __builtin_amdgcn_rcpf(1.0f + __builtin_amdgcn_exp2f(a * nrl)); if (out8) x[n * 4 + i] = clamp_fp8(x[n * 4 + i]); }
                if (out8) { u32x2 w; w.x = pk4_fp8(x[0], x[1], x[2], x[3]); w.y = pk4_fp8(x[4], x[5], x[6], x[7]); *(GAS u32x2*)((unsigned char*)hid + (size_t)row * ldc + col0) = w; }
                else { u32x4 w; w.x = pk2(x[0], x[1]); w.y = pk2(x[2], x[3]); w.z = pk2(x[4], x[5]); w.w = pk2(x[6], x[7]);
                    *(GAS u32x4*)(hid + (size_t)row * ldc + col0) = w; } }
    }
};
typedef EpiSwigluT<false> EpiSwiglu;
template <bool HM> struct EpiQKVT {
    bf16 *q; const unsigned long long* ss; const LAS float* rtab;
    __device__ __forceinline__ void operator()(const f32x4 (&acc)[2][2][4][2], const Unit& u, int wr, int wc, int fr, int fq) const {
        const int row0 = u.pm * 256 + wr * 64 + fr + (HM ? u.mh * 128 : 0), which = u.pn / 6, pnl = u.pn - which * 6, g = pnl >> 1, sh = 2 * g;
        const int h0 = (pnl & 1) * 4 + (wc >> 1), d0 = (wc & 1) * 32 + 8 * fq;
        bf16* base = q + (size_t)which * ((size_t)T * QD);
        float rsv[2][4];
#pragma unroll
        for (int ai = 0; ai < (HM ? 1 : 2); ++ai)
#pragma unroll
            for (int m = 0; m < 4; ++m) { const int row = row0 + ai * 128 + m * 16; rsv[ai][m] = rtab ? rtab[row & 2047] : rstd_from_ss(ss, row); }
#pragma unroll
        for (int ai = 0; ai < (HM ? 1 : 2); ++ai)
#pragma unroll
            for (int m = 0; m < 4; ++m) { const int row = row0 + ai * 128 + m * 16; const float rs = rsv[ai][m];
                const int b = row >> 11, sq = row & 2047, pos = ((sq & ((1 << sh) - 1)) << (11 - sh)) + (sq >> sh);
                bf16* rowp = base + ((size_t)((b * 3 + g) * 8 + h0) * 2048 + pos) * 64 + d0;
#pragma unroll
                for (int bj = 0; bj < 2; ++bj) { const f32x4 v0 = acc[ai][bj][m][0] * rs, v1 = acc[ai][bj][m][1] * rs;
                    u32x4 w; w.x = pk2(v0[0], v0[1]); w.y = pk2(v0[2], v0[3]); w.z = pk2(v1[0], v1[1]); w.w = pk2(v1[2], v1[3]);
                    *(GAS u32x4*)(rowp + bj * (2 * 2048 * 64)) = w; } }
    }
};
typedef EpiQKVT<false> EpiQKV;
struct EpiGate {
    bf16* c; bf16* slab; int MTf;
    __device__ __forceinline__ void operator()(const f32x4 (&acc)[2][2][4][2], const Unit& u, int wr, int wc, int fr, int fq) const {
        const int col0 = u.pn * 256 + wc * 32 + 8 * fq;
        bf16* base = u.slice < 0 ? c + (size_t)(u.pm * 256) * D : slab + ((size_t)u.slice * 2048 + (size_t)(u.pm - MTf) * 256) * D;
        const int row0 = wr * 64 + fr;
#pragma unroll
        for (int ai = 0; ai < 2; ++ai)
#pragma unroll
            for (int m = 0; m < 4; ++m) { const int row = row0 + ai * 128 + m * 16; bf16* rowp = base + (size_t)row * D + col0;
#pragma unroll
                for (int bj = 0; bj < 2; ++bj) { const f32x4 v0 = acc[ai][bj][m][0], v1 = acc[ai][bj][m][1];
                    u32x4 w; w.x = pk2(v0[0], v0[1]); w.y = pk2(v0[2], v0[3]); w.z = pk2(v1[0], v1[1]); w.w = pk2(v1[2], v1[3]);
                    *(GAS u32x4*)(rowp + bj * 128) = w; } }
    }
};

struct Frame { LAS unsigned char* lds; int tid, lane, wave, G, bid; };

__device__ __forceinline__ void run_jobs(const Args& a, Frame& F, int j0, int j1, int gw, int NGW) {
    LAS float* scr = (LAS float*)(F.lds) + F.wave * (64 * 68);
    int base = 0;
    for (int j = j0; j < j1; ++j) {
        const TrJob t = job0(a, j);
        const int ni = trjob_items(t);
        int first = (gw - (base % NGW) + NGW) % NGW;
        for (int it = first; it < ni; it += NGW) tr_item(t, it, scr, F.lane);
        base += ni;
    }
}
__device__ __forceinline__ void run_jobs_moe(const Args& a, Frame& F, int gw, int NGW, int lo, int hi) {
    LAS float* scr = (LAS float*)(F.lds) + F.wave * (64 * 68);
    constexpr int NMOE = 24 * 896, NQ = (1024 / 64) * (QD / 64), NKV = (1024 / 64) * (2 * QD / 64), NF2 = (FFD / 64) * (1024 / 64);
    static_assert((NMOE + NQ + NKV + NF2) % 32 == 0, "item count");
    const int wsh = hi - lo, total = ((NMOE + NQ + NKV + NF2) / 32) * wsh;
    for (int r = gw; r < total; r += NGW) {
        const int gi = (r / wsh) * 32 + lo + (r % wsh); int j, it;
        if (gi < NMOE) { j = gi / 896; it = gi - j * 896; } else if (gi < NMOE + NQ) { j = 24; it = gi - NMOE; } else if (gi < NMOE + NQ + NKV) { j = 25; it = gi - NMOE - NQ; } else { j = 26; it = gi - NMOE - NQ - NKV; }
        const TrJob8 t = job_moe(a, j);
        tr_item8(t, it, scr, F.lane);
    }
}
__device__ __forceinline__ void p0_zero(const Args& a, Frame& F) {
    const int gt = F.bid * (NWAVES * 64) + F.tid, NT = F.G * NWAVES * 64;
    GAS u32x4* z = (GAS u32x4*)(a.ws + CTL_SS1);
    for (int i = gt; i < (int)(3 * 131072 / 16); i += NT) z[i] = (u32x4){0u, 0u, 0u, 0u};
    if (gt < 2) ((GAS u32x4*)(a.ws + CTL_CNT))[gt] = (u32x4){0u, 0u, 0u, 0u};
    if (gt < 8 * 128) *(GAS u32x4*)((bf16*)(a.ws + WS_HCAT) + (size_t)(gt >> 7) * 2049 * 1024 + 8 * (gt & 127)) = (u32x4){0u, 0u, 0u, 0u};
    bf16* wlu = (bf16*)(a.ws + WS_WLU);
    for (int i = gt; i < 2048 * 8; i += NT) { const int row = i >> 3, ch = i & 7; *(GAS u32x4*)(wlu + (size_t)row * 128 + (row < 1024 ? 64 : 0) + 8 * ch) = (u32x4){0u, 0u, 0u, 0u}; }
}
__device__ __forceinline__ void p0_hcat(const Args& a, Frame& F) {
    const float* x = a.in[I_X]; const float* g = a.in[I_NG];
    bf16* hc = (bf16*)(a.ws + WS_HCAT); bf16* xr = (bf16*)(a.ws + WS_XR);
    const float* mu = a.in[I_MU];
    const int gw = F.bid * NWAVES + F.wave, NGW = F.G * NWAVES;
    constexpr int RPW = 8;
    f32x4 gv[4], m0v[4], m2v[4], m3v[4];
#pragma unroll
    for (int j = 0; j < 4; ++j) { const int c = 4 * F.lane + 256 * j; gv[j] = *(const GAS f32x4*)(g + c); m0v[j] = *(const GAS f32x4*)(mu + 0 * D + c); m2v[j] = *(const GAS f32x4*)(mu + 2 * D + c); m3v[j] = *(const GAS f32x4*)(mu + 3 * D + c); }
    for (int blk = gw; blk < T / RPW; blk += NGW) {
        const int m0 = blk * RPW;
        f32x4 hp[4], v[4], nv[4];
#pragma unroll
        for (int j = 0; j < 4; ++j) hp[j] = (f32x4){0.f, 0.f, 0.f, 0.f};
        const int mi0 = ((m0 & (SEQ - 1)) != 0 ? -1 : 0);
        { const GAS f32x4* xrw = (const GAS f32x4*)(x + (size_t)(m0 + mi0) * D) + F.lane;
#pragma unroll
          for (int j = 0; j < 4; ++j) v[j] = __builtin_nontemporal_load(xrw + 64 * j); }
        for (int mi = mi0; mi < RPW; ++mi) {
            const int m = m0 + mi;
            if (mi + 1 < RPW) { const GAS f32x4* xrw = (const GAS f32x4*)(x + (size_t)(m + 1) * D) + F.lane;
#pragma unroll
                for (int j = 0; j < 4; ++j) nv[j] = __builtin_nontemporal_load(xrw + 64 * j); }
            float s = 0.f;
#pragma unroll
            for (int j = 0; j < 4; ++j) s += (v[j].x * v[j].x + v[j].y * v[j].y) + (v[j].z * v[j].z + v[j].w * v[j].w);
            const float rstd = 1.f / sqrtf(wave_sum(s) * (1.f / D) + RMS_EPS);
#pragma unroll
            for (int j = 0; j < 4; ++j) { const int c = 4 * F.lane + 256 * j;
                const f32x4 h = v[j] * rstd * gv[j];
                if (mi >= 0) {
                    const f32x4 dlt = hp[j] - h;
                    u32x2 w; w.x = pk2(h.x, h.y); w.y = pk2(h.z, h.w);
                    *(GAS u32x2*)(hc + ((size_t)m + (m >> 11) + 1) * 1024 + c) = w;
                    const f32x4 r4 = h + dlt * m0v[j], k4 = h + dlt * m2v[j], v4 = h + dlt * m3v[j];
                    w.x = pk2(r4.x, r4.y); w.y = pk2(r4.z, r4.w); *(GAS u32x2*)(xr + (size_t)m * D + c) = w;
                    w.x = pk2(k4.x, k4.y); w.y = pk2(k4.z, k4.w); *(GAS u32x2*)(xr + ((size_t)T + m) * D + c) = w;
                    w.x = pk2(v4.x, v4.y); w.y = pk2(v4.z, v4.w); *(GAS u32x2*)(xr + ((size_t)2 * T + m) * D + c) = w;
                }
                hp[j] = h; }
#pragma unroll
            for (int j = 0; j < 4; ++j) v[j] = nv[j];
        }
    }
}

constexpr int CH_NS = 8;
constexpr int CH_RS = 72;
constexpr int CH_OFF_AT = 0, CH_OFF_RT = 2304, CH_OFF_BB = 4608, CH_OFF_KB = 4608 + 2304, CH_OFF_VV = 4608 + 2 * 2304, CH_OFF_MKA = 4608 + 3 * 2304, CH_OFF_TT = CH_OFF_MKA + 512,
              CH_OFF_NBR = CH_OFF_TT + 512, CH_OFF_NKR = CH_OFF_NBR + 512, CH_OFF_MF = CH_OFF_NKR + 512, CH_OFF_GC = CH_OFF_MF + 1024, CH_OFF_RK = CH_OFF_GC + 256, CH_SLOT = CH_OFF_RK + 64;
constexpr int CH_YBUF = CH_NS * CH_SLOT;
constexpr int CH_PAR = CH_YBUF + 8 * 4608;
static_assert(CH_PAR + 768 <= MISC_OFF && (CH_SLOT % 16) == 0 && (CH_PAR % 16) == 0, "chunked scan LDS map");
#define ROW_SHR_ADD(x, ctrl) x += __builtin_bit_cast(float, __builtin_amdgcn_update_dpp(0, __builtin_bit_cast(int, x), ctrl, 0xf, 0xf, true))
template <int PARTS = 7>
__device__ __forceinline__ void p3_scan_chunked(const Args& a, Frame& F, int pair) {
    typedef short bf16x8 __attribute__((ext_vector_type(8)));
    unsigned char* ws = a.ws;
    const bf16 *Rg = (const bf16*)(ws + WS_R), *Kg = (const bf16*)(ws + WS_K), *Vg = (const bf16*)(ws + WS_V), *LWg = (const bf16*)(ws + WS_LW), *AAg = (const bf16*)(ws + WS_AA), *GGg = (const bf16*)(ws + WS_GG);
    bf16* Z = (bf16*)(ws + WS_Z);
    const int b = pair >> 4, h = pair & 15, lane = F.lane, w = F.wave;
    const size_t tbase = (size_t)b * SEQ;
    LAS unsigned char* L = F.lds;
    LAS float* ybuf = (LAS float*)(L + CH_YBUF);
    const unsigned lbase = (unsigned)(size_t)L;
    const int t = lane & 15, chq = lane >> 4, ch0 = h * 64 + 16 * chq;
    const int n = lane & 15, hq = lane >> 4;
    f32x4 ST[4];
#pragma unroll
    for (int T4 = 0; T4 < 4; ++T4) ST[T4] = (f32x4){0.f, 0.f, 0.f, 0.f};
    { LAS float* par = (LAS float*)(L + CH_PAR);
      if (F.tid < 192) { const int pi = F.tid >> 6, cc = F.tid & 63; par[F.tid] = (pi == 0 ? a.in[I_KK] : (pi == 1 ? a.in[I_KA] : a.in[I_RK]))[h * 64 + cc]; } }
    __syncthreads();
    const f32x4 lnw = *(const GAS f32x4*)(a.in[I_LNW] + h * 64 + 4 * (F.tid & 15)), lnb = *(const GAS f32x4*)(a.in[I_LNB] + h * 64 + 4 * (F.tid & 15));
    u32x4 raw[5][2];
    { const size_t off = (tbase + 16 * w + t) * D + ch0;
#pragma unroll
      for (int hf = 0; hf < 2; ++hf) { raw[0][hf] = __builtin_nontemporal_load((const GAS u32x4*)(Rg + off + 8 * hf)); raw[1][hf] = __builtin_nontemporal_load((const GAS u32x4*)(Kg + off + 8 * hf)); raw[2][hf] = __builtin_nontemporal_load((const GAS u32x4*)(Vg + off + 8 * hf));
          raw[3][hf] = __builtin_nontemporal_load((const GAS u32x4*)(LWg + off + 8 * hf)); raw[4][hf] = __builtin_nontemporal_load((const GAS u32x4*)(AAg + off + 8 * hf)); } }
    for (int g = 0; g < SEQ / (16 * CH_NS); ++g) {
        {
            LAS unsigned char* sl = L + w * CH_SLOT;
            LAS bf16* BT = (LAS bf16*)(L + CH_YBUF + w * 4608); LAS bf16* KT = BT + 16 * CH_RS;
            float rr[16], kk_[16], lw[16], al[16];
#pragma unroll
            for (int hf = 0; hf < 2; ++hf) {
                const u32x4 q0 = raw[0][hf], q1 = raw[1][hf], q2 = raw[2][hf], q3 = raw[3][hf], q4 = raw[4][hf];
                rr[8 * hf + 0] = bf_lo(q0.x); rr[8 * hf + 1] = bf_hi(q0.x); rr[8 * hf + 2] = bf_lo(q0.y); rr[8 * hf + 3] = bf_hi(q0.y); rr[8 * hf + 4] = bf_lo(q0.z); rr[8 * hf + 5] = bf_hi(q0.z); rr[8 * hf + 6] = bf_lo(q0.w); rr[8 * hf + 7] = bf_hi(q0.w);
                kk_[8 * hf + 0] = bf_lo(q1.x); kk_[8 * hf + 1] = bf_hi(q1.x); kk_[8 * hf + 2] = bf_lo(q1.y); kk_[8 * hf + 3] = bf_hi(q1.y); kk_[8 * hf + 4] = bf_lo(q1.z); kk_[8 * hf + 5] = bf_hi(q1.z); kk_[8 * hf + 6] = bf_lo(q1.w); kk_[8 * hf + 7] = bf_hi(q1.w);
                lw[8 * hf + 0] = bf_lo(q3.x); lw[8 * hf + 1] = bf_hi(q3.x); lw[8 * hf + 2] = bf_lo(q3.y); lw[8 * hf + 3] = bf_hi(q3.y); lw[8 * hf + 4] = bf_lo(q3.z); lw[8 * hf + 5] = bf_hi(q3.z); lw[8 * hf + 6] = bf_lo(q3.w); lw[8 * hf + 7] = bf_hi(q3.w);
                al[8 * hf + 0] = bf_lo(q4.x); al[8 * hf + 1] = bf_hi(q4.x); al[8 * hf + 2] = bf_lo(q4.y); al[8 * hf + 3] = bf_hi(q4.y); al[8 * hf + 4] = bf_lo(q4.z); al[8 * hf + 5] = bf_hi(q4.z); al[8 * hf + 6] = bf_lo(q4.w); al[8 * hf + 7] = bf_hi(q4.w);
                *(LAS u32x4*)(sl + CH_OFF_VV + (t * CH_RS + 16 * chq + 8 * hf) * 2) = q2;
            }
            if (g + 1 < SEQ / (16 * CH_NS)) { const size_t off = (tbase + (size_t)(g + 1) * 128 + 16 * w + t) * D + ch0;
    #pragma unroll
                for (int hf = 0; hf < 2; ++hf) { raw[0][hf] = __builtin_nontemporal_load((const GAS u32x4*)(Rg + off + 8 * hf)); raw[1][hf] = __builtin_nontemporal_load((const GAS u32x4*)(Kg + off + 8 * hf)); raw[2][hf] = __builtin_nontemporal_load((const GAS u32x4*)(Vg + off + 8 * hf));
                    raw[3][hf] = __builtin_nontemporal_load((const GAS u32x4*)(LWg + off + 8 * hf)); raw[4][hf] = __builtin_nontemporal_load((const GAS u32x4*)(AAg + off + 8 * hf)); } }
            float ssq = 0.f, rks = 0.f; float av[16], bv[16];
#pragma unroll
            for (int c4 = 0; c4 < 4; ++c4) {
                const LAS float* par = (const LAS float*)(L + CH_PAR) + 16 * chq + 4 * c4;
                const f32x4 kkp = *(const LAS f32x4*)(par), kap = *(const LAS f32x4*)(par + 64), rkp = *(const LAS f32x4*)(par + 128);
#pragma unroll
                for (int i = 0; i < 4; ++i) { const int c = 4 * c4 + i; const float kr = kk_[c] * kkp[i]; ssq += kr * kr; av[c] = kr;
                    const float kp = kk_[c] * (1.0f + (al[c] - 1.0f) * kap[i]); rks += rr[c] * kp * rkp[i]; kk_[c] = kp; }
            }
            ssq += __shfl_xor(ssq, 16); ssq += __shfl_xor(ssq, 32); rks += __shfl_xor(rks, 16); rks += __shfl_xor(rks, 32);
            const float inv = __builtin_amdgcn_rsqf(fmaxf(ssq, 1e-24f));
#pragma unroll
            for (int c = 0; c < 16; ++c) { const float kkn = av[c] * inv; av[c] = -kkn; bv[c] = kkn * al[c]; }
            if (chq == 0) *(LAS float*)(sl + CH_OFF_RK + 4 * t) = rks;
            const int pbase = 32 * (chq >> 1) + 4 * (chq & 1);
            f32x4 gcs[4];
#pragma unroll
            for (int c4 = 0; c4 < 4; ++c4) {
                float at4[4], rt4[4], bt4[4], kt4[4], bb4[4], kb4[4];
#pragma unroll
                for (int i = 0; i < 4; ++i) { const int c = 4 * c4 + i;
                    float x = lw[c]; ROW_SHR_ADD(x, 0x111); ROW_SHR_ADD(x, 0x112); ROW_SHR_ADD(x, 0x114); ROW_SHR_ADD(x, 0x118);
                    const float e1 = __builtin_amdgcn_exp2f(x), i1 = __builtin_amdgcn_exp2f(-x);
                    const float em1 = __builtin_bit_cast(float, __builtin_amdgcn_update_dpp(0x3f800000, __builtin_bit_cast(int, e1), 0x111, 0xf, 0xf, false));
                    const float eC = i1 * __builtin_bit_cast(float, __builtin_amdgcn_update_dpp(0, __builtin_bit_cast(int, e1), 0x15F, 0xf, 0xf, false));
                    at4[i] = em1 * av[c]; rt4[i] = e1 * rr[c]; bt4[i] = bv[c] * i1; kt4[i] = kk_[c] * i1; bb4[i] = bv[c] * eC; kb4[i] = kk_[c] * eC;
                    gcs[c4][i] = e1; }
                *(LAS u32x2*)(sl + CH_OFF_AT + (t * CH_RS + pbase + 8 * c4) * 2) = (u32x2){pk2(at4[0], at4[1]), pk2(at4[2], at4[3])};
                *(LAS u32x2*)(sl + CH_OFF_RT + (t * CH_RS + pbase + 8 * c4) * 2) = (u32x2){pk2(rt4[0], rt4[1]), pk2(rt4[2], rt4[3])};
                *(LAS u32x2*)((LAS unsigned char*)BT + (t * CH_RS + pbase + 8 * c4) * 2) = (u32x2){pk2(bt4[0], bt4[1]), pk2(bt4[2], bt4[3])};
                *(LAS u32x2*)((LAS unsigned char*)KT + (t * CH_RS + pbase + 8 * c4) * 2) = (u32x2){pk2(kt4[0], kt4[1]), pk2(kt4[2], kt4[3])};
                *(LAS u32x2*)(sl + CH_OFF_BB + (t * CH_RS + 16 * chq + 4 * c4) * 2) = (u32x2){pk2(bb4[0], bb4[1]), pk2(bb4[2], bb4[3])};
                *(LAS u32x2*)(sl + CH_OFF_KB + (t * CH_RS + 16 * chq + 4 * c4) * 2) = (u32x2){pk2(kb4[0], kb4[1]), pk2(kb4[2], kb4[3])};
            }
            if (t == 15) {
#pragma unroll
                for (int c4 = 0; c4 < 4; ++c4) *(LAS f32x4*)(sl + CH_OFF_GC + 4 * (16 * chq + 4 * c4)) = gcs[c4]; }
            asm volatile("s_waitcnt lgkmcnt(0)" ::: "memory");
            if (!(PARTS & 16)) {
                const LAS bf16* pa = (const LAS bf16*)(sl + CH_OFF_AT) + n * CH_RS + 8 * hq; const LAS bf16* pr = (const LAS bf16*)(sl + CH_OFF_RT) + n * CH_RS + 8 * hq;
                const LAS bf16* pb = BT + n * CH_RS + 8 * hq; const LAS bf16* pk = KT + n * CH_RS + 8 * hq;
                const bf16x8 fa0 = *(const LAS bf16x8*)pa, fa1 = *(const LAS bf16x8*)(pa + 32), fr0 = *(const LAS bf16x8*)pr, fr1 = *(const LAS bf16x8*)(pr + 32);
                const bf16x8 fb0 = *(const LAS bf16x8*)pb, fb1 = *(const LAS bf16x8*)(pb + 32), fk0 = *(const LAS bf16x8*)pk, fk1 = *(const LAS bf16x8*)(pk + 32);
                const f32x4 z4 = (f32x4){0.f, 0.f, 0.f, 0.f};
                f32x4 mba = __builtin_amdgcn_mfma_f32_16x16x32_bf16(fb0, fa0, z4, 0, 0, 0); mba = __builtin_amdgcn_mfma_f32_16x16x32_bf16(fb1, fa1, mba, 0, 0, 0);
                f32x4 mka = __builtin_amdgcn_mfma_f32_16x16x32_bf16(fk0, fa0, z4, 0, 0, 0); mka = __builtin_amdgcn_mfma_f32_16x16x32_bf16(fk1, fa1, mka, 0, 0, 0);
                f32x4 nbr = __builtin_amdgcn_mfma_f32_16x16x32_bf16(fb0, fr0, z4, 0, 0, 0); nbr = __builtin_amdgcn_mfma_f32_16x16x32_bf16(fb1, fr1, nbr, 0, 0, 0);
                f32x4 nkr = __builtin_amdgcn_mfma_f32_16x16x32_bf16(fk0, fr0, z4, 0, 0, 0); nkr = __builtin_amdgcn_mfma_f32_16x16x32_bf16(fk1, fr1, nkr, 0, 0, 0);
                float m2[4], m3[4], m4[4]; f32x4 Mb, Ma;
                f32x4 mta = __builtin_amdgcn_mfma_f32_16x16x32_bf16(fa0, fb0, z4, 0, 0, 0); mta = __builtin_amdgcn_mfma_f32_16x16x32_bf16(fa1, fb1, mta, 0, 0, 0);
#pragma unroll
                for (int r = 0; r < 4; ++r) { const int sI = 4 * hq + r; const bool lt = sI < n, le = sI <= n;
                    Mb[r] = lt ? mba[r] : 0.f; Ma[r] = n < sI ? mta[r] : 0.f; m2[r] = lt ? mka[r] : 0.f; m3[r] = le ? nbr[r] : 0.f; m4[r] = le ? nkr[r] : 0.f; }
                *(LAS u32x2*)(sl + CH_OFF_MKA + lane * 8) = (u32x2){pk2(m2[0], m2[1]), pk2(m2[2], m2[3])};
                *(LAS u32x2*)(sl + CH_OFF_NBR + lane * 8) = (u32x2){pk2(m3[0], m3[1]), pk2(m3[2], m3[3])};
                *(LAS u32x2*)(sl + CH_OFF_NKR + lane * 8) = (u32x2){pk2(m4[0], m4[1]), pk2(m4[2], m4[3])};
                typedef short v4s __attribute__((ext_vector_type(4)));
#define PK4(v) __builtin_bit_cast(v4s, (u32x2){pk2((v)[0], (v)[1]), pk2((v)[2], (v)[3])})
#define MM16(A, B, C) __builtin_amdgcn_mfma_f32_16x16x16bf16_1k(A, B, C, 0, 0, 0)
                f32x4 idm;
#pragma unroll
                for (int r = 0; r < 4; ++r) idm[r] = (4 * hq + r == n) ? 1.0f : 0.0f;
                const v4s Mb16 = PK4(Mb), Ma16 = PK4(Ma);
                const f32x4 P1b = Mb + idm, P1a = Ma + idm; const v4s P1a16 = PK4(P1a);
                const f32x4 M2b = MM16(Ma16, Mb16, z4), M2a = MM16(Mb16, Ma16, z4); const v4s M2b16 = PK4(M2b), M2a16 = PK4(M2a);
                const f32x4 P2b = MM16(P1a16, M2b16, P1b), P2a = MM16(M2b16, P1a16, P1a); const v4s P2a16 = PK4(P2a);
                const f32x4 M4b = MM16(M2a16, M2b16, z4), M4a = MM16(M2b16, M2a16, z4); const v4s M4b16 = PK4(M4b), M4a16 = PK4(M4a);
                const f32x4 P3b = MM16(P2a16, M4b16, P2b), P3a = MM16(M4b16, P2a16, P2a);
                const f32x4 M8b = MM16(M4a16, M4b16, z4);
                const f32x4 Tb = MM16(PK4(P3a), PK4(M8b), P3b);
                *(LAS u32x2*)(sl + CH_OFF_TT + lane * 8) = (u32x2){pk2(Tb[0], Tb[1]), pk2(Tb[2], Tb[3])};
#undef PK4
#undef MM16
            }
        }
        __syncthreads();
        u32x2 graw4[4];
        { const int jj = F.tid & 15;
#pragma unroll
          for (int ps = 0; ps < 4; ++ps) graw4[ps] = *(const GAS u32x2*)(GGg + (tbase + (size_t)g * 128 + (F.tid >> 4) + 32 * ps) * D + h * 64 + 4 * jj); }
        if (w < 4 && (PARTS & 2)) {
            const int q = (lane & 15) >> 2, p = lane & 3;
            const int m16 = ((4 * hq + q) * 16 + 4 * p) * 2;
            const int m72 = ((4 * hq + q) * CH_RS + 4 * p) * 2;
            typedef short v4s __attribute__((ext_vector_type(4))); typedef LAS v4s* lv4;
#define CH_LOAD(CS, MKA, TTF, NBR, NKR, VF, BB0, BB1, BB2, BB3, KB0, KB1, KB2, KB3) do { LAS unsigned char* _sl = L + (CS) * CH_SLOT; \
            MKA = *(const LAS v4s*)(_sl + CH_OFF_MKA + lane * 8); TTF = *(const LAS v4s*)(_sl + CH_OFF_TT + lane * 8); \
            NBR = *(const LAS v4s*)(_sl + CH_OFF_NBR + lane * 8); NKR = *(const LAS v4s*)(_sl + CH_OFF_NKR + lane * 8); \
            VF = __builtin_amdgcn_ds_read_tr16_b64_v4i16((lv4)(_sl + CH_OFF_VV + m72 + 32 * w)); \
            BB0 = __builtin_amdgcn_ds_read_tr16_b64_v4i16((lv4)(_sl + CH_OFF_BB + m72)); BB1 = __builtin_amdgcn_ds_read_tr16_b64_v4i16((lv4)(_sl + CH_OFF_BB + m72 + 32)); \
            BB2 = __builtin_amdgcn_ds_read_tr16_b64_v4i16((lv4)(_sl + CH_OFF_BB + m72 + 64)); BB3 = __builtin_amdgcn_ds_read_tr16_b64_v4i16((lv4)(_sl + CH_OFF_BB + m72 + 96)); \
            KB0 = __builtin_amdgcn_ds_read_tr16_b64_v4i16((lv4)(_sl + CH_OFF_KB + m72)); KB1 = __builtin_amdgcn_ds_read_tr16_b64_v4i16((lv4)(_sl + CH_OFF_KB + m72 + 32)); \
            KB2 = __builtin_amdgcn_ds_read_tr16_b64_v4i16((lv4)(_sl + CH_OFF_KB + m72 + 64)); KB3 = __builtin_amdgcn_ds_read_tr16_b64_v4i16((lv4)(_sl + CH_OFF_KB + m72 + 96)); } while (0)
            v4s mka, ttv, nbr, nkr, vfv, bb0, bb1, bb2, bb3, kb0, kb1, kb2, kb3;
            CH_LOAD(0, mka, ttv, nbr, nkr, vfv, bb0, bb1, bb2, bb3, kb0, kb1, kb2, kb3);
#pragma unroll 1
            for (int cs = 0; cs < CH_NS; ++cs) {
                v4s nmka, nttv, nnbr, nnkr, nvfv, nbb0, nbb1, nbb2, nbb3, nkb0, nkb1, nkb2, nkb3;
                const LAS bf16* pa = (const LAS bf16*)(L + cs * CH_SLOT + CH_OFF_AT) + n * CH_RS + 8 * hq; const LAS bf16* pr = (const LAS bf16*)(L + cs * CH_SLOT + CH_OFF_RT) + n * CH_RS + 8 * hq;
                const bf16x8 at0 = *(const LAS bf16x8*)pa, at1 = *(const LAS bf16x8*)(pa + 32), rt0 = *(const LAS bf16x8*)pr, rt1 = *(const LAS bf16x8*)(pr + 32);
                { const int csn = cs + 1 < CH_NS ? cs + 1 : cs;
                  CH_LOAD(csn, nmka, nttv, nnbr, nnkr, nvfv, nbb0, nbb1, nbb2, nbb3, nkb0, nkb1, nkb2, nkb3); }
                f32x4 gcv[4];
#pragma unroll
                for (int T4 = 0; T4 < 4; ++T4) gcv[T4] = *(const LAS f32x4*)(L + cs * CH_SLOT + CH_OFF_GC + (16 * T4 + 4 * hq) * 4);
                u32x4 b0w, b1w;
                b0w.x = pk2(ST[0][0], ST[0][1]); b0w.y = pk2(ST[0][2], ST[0][3]); b0w.z = pk2(ST[1][0], ST[1][1]); b0w.w = pk2(ST[1][2], ST[1][3]);
                b1w.x = pk2(ST[2][0], ST[2][1]); b1w.y = pk2(ST[2][2], ST[2][3]); b1w.z = pk2(ST[3][0], ST[3][1]); b1w.w = pk2(ST[3][2], ST[3][3]);
                const bf16x8 bop0 = __builtin_bit_cast(bf16x8, b0w), bop1 = __builtin_bit_cast(bf16x8, b1w);
                const u32x2 mkaf = __builtin_bit_cast(u32x2, mka), ttf = __builtin_bit_cast(u32x2, ttv), nbrf = __builtin_bit_cast(u32x2, nbr), nkrf = __builtin_bit_cast(u32x2, nkr), vf = __builtin_bit_cast(u32x2, vfv);
                const u32x2 bbf[4] = {__builtin_bit_cast(u32x2, bb0), __builtin_bit_cast(u32x2, bb1), __builtin_bit_cast(u32x2, bb2), __builtin_bit_cast(u32x2, bb3)};
                const u32x2 kbf[4] = {__builtin_bit_cast(u32x2, kb0), __builtin_bit_cast(u32x2, kb1), __builtin_bit_cast(u32x2, kb2), __builtin_bit_cast(u32x2, kb3)};
                const f32x4 z4 = (f32x4){0.f, 0.f, 0.f, 0.f};
                f32x4 XT = __builtin_amdgcn_mfma_f32_16x16x32_bf16(at0, bop0, z4, 0, 0, 0); XT = __builtin_amdgcn_mfma_f32_16x16x32_bf16(at1, bop1, XT, 0, 0, 0);
                XT = __builtin_amdgcn_mfma_f32_16x16x32_bf16(__builtin_bit_cast(bf16x8, (u32x4){mkaf.x, mkaf.y, 0u, 0u}), __builtin_bit_cast(bf16x8, (u32x4){vf.x, vf.y, 0u, 0u}), XT, 0, 0, 0);
                const f32x4 UT = __builtin_amdgcn_mfma_f32_16x16x32_bf16(__builtin_bit_cast(bf16x8, (u32x4){ttf.x, ttf.y, 0u, 0u}), __builtin_bit_cast(bf16x8, (u32x4){pk2(XT[0], XT[1]), pk2(XT[2], XT[3]), 0u, 0u}), z4, 0, 0, 0);
                const bf16x8 uvop = __builtin_bit_cast(bf16x8, (u32x4){pk2(UT[0], UT[1]), pk2(UT[2], UT[3]), vf.x, vf.y});
                f32x4 YT = __builtin_amdgcn_mfma_f32_16x16x32_bf16(rt0, bop0, z4, 0, 0, 0); YT = __builtin_amdgcn_mfma_f32_16x16x32_bf16(rt1, bop1, YT, 0, 0, 0);
                YT = __builtin_amdgcn_mfma_f32_16x16x32_bf16(__builtin_bit_cast(bf16x8, (u32x4){nbrf.x, nbrf.y, nkrf.x, nkrf.y}), uvop, YT, 0, 0, 0);
#pragma unroll
                for (int r = 0; r < 4; ++r) ybuf[(cs * 16 + 4 * hq + r) * 64 + 16 * w + n] = YT[r];
#pragma unroll
                for (int T4 = 0; T4 < 4; ++T4)
                    ST[T4] = __builtin_amdgcn_mfma_f32_16x16x32_bf16(__builtin_bit_cast(bf16x8, (u32x4){bbf[T4].x, bbf[T4].y, kbf[T4].x, kbf[T4].y}), uvop, ST[T4] * gcv[T4], 0, 0, 0);
                mka = nmka; ttv = nttv; nbr = nnbr; nkr = nnkr; vfv = nvfv;
                bb0 = nbb0; bb1 = nbb1; bb2 = nbb2; bb3 = nbb3; kb0 = nkb0; kb1 = nkb1; kb2 = nkb2; kb3 = nkb3;
            }
#undef CH_LOAD
        }
        __syncthreads();
        if (PARTS & 4) {
            const int j = F.tid & 15, ch = h * 64 + 4 * j;
#pragma unroll
            for (int ps = 0; ps < 4; ++ps) {
                const int tk = (F.tid >> 4) + 32 * ps, cs = tk >> 4, tl = tk & 15;
                const size_t gofs = (tbase + (size_t)g * 128 + tk) * D + ch;
                const u32x2 graw = graw4[ps];
                const f32x4 y4 = *(const LAS f32x4*)(ybuf + tk * 64 + 4 * j);
                const float mean = row16_sum((y4.x + y4.y) + (y4.z + y4.w)) * (1.0f / 64.0f);
                const f32x4 d4 = y4 - mean;
                const float var = row16_sum((d4.x * d4.x + d4.y * d4.y) + (d4.z * d4.z + d4.w * d4.w)) * (1.0f / 64.0f);
                const float rs = __builtin_amdgcn_rsqf(var + GN_EPS);
                const u32x2 vraw = *(const LAS u32x2*)(L + cs * CH_SLOT + CH_OFF_VV + (tl * CH_RS + 4 * j) * 2);
                const float rk = *(const LAS float*)(L + cs * CH_SLOT + CH_OFF_RK + 4 * tl);
                const f32x4 vt = (f32x4){bf_lo(vraw.x), bf_hi(vraw.x), bf_lo(vraw.y), bf_hi(vraw.y)}, g4 = (f32x4){bf_lo(graw.x), bf_hi(graw.x), bf_lo(graw.y), bf_hi(graw.y)};
                const f32x4 o = (d4 * rs * lnw + lnb + rk * vt) * g4;
                u32x2 wv; wv.x = pk2(o.x, o.y); wv.y = pk2(o.z, o.w);
                *(GAS u32x2*)(Z + gofs) = wv;
            }
        }
        __syncthreads();
    }
}

constexpr int AT_KS = 72;
struct AtUnit { int b, g, h, rho, jb, dil; };
__device__ __forceinline__ AtUnit at_decode(int u) { AtUnit a; const int sub = u & 15; int r = u >> 4; a.h = r & 7; r >>= 3; a.g = r % 3; a.b = r / 3;
    a.dil = a.g == 0 ? 1 : (a.g == 1 ? 4 : 16); a.rho = a.g == 0 ? 0 : (a.g == 1 ? (sub & 3) : sub); a.jb = a.g == 0 ? sub : (a.g == 1 ? (sub >> 2) : 0); return a; }
__device__ __forceinline__ void at_issue(int u, int tid, int w, int lane, const bf16* Q, const bf16* KK, const bf16* VV, u32x4 (&kr)[4], u32x4 (&vr)[4], u32x4 (&qr)[2]) {
    const int hq = lane >> 4, n = lane & 15;
    const AtUnit at = at_decode(u);
    const size_t cb = ((size_t)((at.b * 3 + at.g) * 8 + at.h) * 2048 + (size_t)at.rho * (2048 >> (2 * at.g))) * 64;
#pragma unroll
    for (int i = 0; i < 4; ++i) {
        const int p = tid + 512 * i, key = p >> 3, dp = p & 7, jp = at.jb * 128 - 128 + key;
        kr[i] = (u32x4){0u, 0u, 0u, 0u};
        if (jp >= 0) kr[i] = *(const GAS u32x4*)(KK + cb + (size_t)jp * 64 + dp * 8);
    }
#pragma unroll
    for (int i = 0; i < 4; ++i) {
        const int p = tid + 512 * i, key = p >> 3, dp = p & 7, jp = at.jb * 128 - 128 + key;
        vr[i] = (u32x4){0u, 0u, 0u, 0u};
        if (jp >= 0) vr[i] = *(const GAS u32x4*)(VV + cb + (size_t)jp * 64 + dp * 8);
    }
    const int jqq = at.jb * 128 + 16 * w + n;
#pragma unroll
    for (int s2 = 0; s2 < 2; ++s2) qr[s2] = *(const GAS u32x4*)(Q + cb + (size_t)jqq * 64 + 32 * s2 + 8 * hq);
}
__device__ __forceinline__ void p8_attn_mfma(const Args& a, Frame& F) {
    typedef short bf16x8 __attribute__((ext_vector_type(8)));
    unsigned char* ws = a.ws;
    const bf16 *Q = (const bf16*)(ws + WS_Q), *KK = (const bf16*)(ws + WS_KK), *VV = (const bf16*)(ws + WS_VV); bf16* OG = (bf16*)(ws + WS_OG); float* LSE = (float*)(ws + WS_LSE);
    LAS bf16* Ks = (LAS bf16*)F.lds; LAS bf16* Vt = Ks + 256 * AT_KS;
    const int lane = F.lane, w = F.wave, hq = lane >> 4, n = lane & 15;
    const int NU = NB * 3 * 8 * 16;
    u32x4 kr[4], vr[4], qr[2];
    int u = (F.G % 8 == 0) ? (F.bid % 8) * (F.G / 8) + F.bid / 8 : F.bid;
    if (u < NU) at_issue(u, F.tid, w, lane, Q, KK, VV, kr, vr, qr);
    for (; u < NU; u += F.G) {
        const AtUnit at = at_decode(u);
#pragma unroll
        for (int i = 0; i < 4; ++i) { const int p = F.tid + 512 * i, key = p >> 3, dp = p & 7; *(LAS u32x4*)(Ks + key * AT_KS + dp * 8) = kr[i]; }
#pragma unroll
        for (int i = 0; i < 4; ++i) { const int p = F.tid + 512 * i, key = p >> 3, dp = p & 7; *(LAS u32x4*)(Vt + key * AT_KS + dp * 8) = vr[i]; }
        const bf16x8 qf0 = __builtin_bit_cast(bf16x8, qr[0]), qf1 = __builtin_bit_cast(bf16x8, qr[1]);
        __syncthreads();
        if (u + F.G < NU) at_issue(u + F.G, F.tid, w, lane, Q, KK, VV, kr, vr, qr);
        const int ilo = at.jb == 0 ? (8 - w) : 0;
        f32x4 sc[9];
#pragma unroll
        for (int i = 0; i < 9; ++i) { sc[i] = (f32x4){0.f, 0.f, 0.f, 0.f};
            if (i >= ilo) {
                const LAS bf16* kp = Ks + (16 * (w + i) + n) * AT_KS + 8 * hq;
                const bf16x8 k0 = *(const LAS bf16x8*)(kp), k1 = *(const LAS bf16x8*)(kp + 32);
                sc[i] = __builtin_amdgcn_mfma_f32_16x16x32_bf16(k0, qf0, sc[i], 0, 0, 0);
                sc[i] = __builtin_amdgcn_mfma_f32_16x16x32_bf16(k1, qf1, sc[i], 0, 0, 0); } }
        const float slope = exp2f(-8.0f * (float)(at.g * 8 + at.h + 1) / 24.0f);
        const float c1 = 0.125f * 1.4426950408889634f, c2 = slope * (float)at.dil * 1.4426950408889634f;
        int nq = n; asm volatile("" : "+v"(nq));
        const int jq = 16 * w + nq;
        const int dq = nq - 4 * hq;
        const float cj = c2 * (float)(dq + 128), c2r1 = c2, c2r2 = 2.f * c2, c2r3 = 3.f * c2;
        float mx = -1e30f;
#pragma unroll
        for (int i = 0; i < 9; ++i) {
            const float b0 = (i >= ilo) ? (c2 * (float)(16 * i) - cj) : -1e30f;
            float v0 = sc[i][0] * c1 + b0, v1 = sc[i][1] * c1 + (b0 + c2r1), v2 = sc[i][2] * c1 + (b0 + c2r2), v3 = sc[i][3] * c1 + (b0 + c2r3);
            if (i == 0) { v0 = dq <= 0 ? v0 : -1e30f; v1 = dq <= 1 ? v1 : -1e30f; v2 = dq <= 2 ? v2 : -1e30f; v3 = dq <= 3 ? v3 : -1e30f; }
            if (i == 8) { v0 = dq >= 0 ? v0 : -1e30f; v1 = dq >= 1 ? v1 : -1e30f; v2 = dq >= 2 ? v2 : -1e30f; v3 = dq >= 3 ? v3 : -1e30f; }
            sc[i][0] = v0; sc[i][1] = v1; sc[i][2] = v2; sc[i][3] = v3;
            mx = fmaxf(mx, fmaxf(fmaxf(v0, v1), fmaxf(v2, v3)));
        }
        mx = fmaxf(mx, __shfl_xor(mx, 16)); mx = fmaxf(mx, __shfl_xor(mx, 32));
        float l = 0.f;
#pragma unroll
        for (int i = 0; i < 9; ++i)
#pragma unroll
            for (int r = 0; r < 4; ++r) { const float p = __builtin_amdgcn_exp2f(sc[i][r] - mx); sc[i][r] = p; l += p; }
        l += __shfl_xor(l, 16); l += __shfl_xor(l, 32);
        const int vboff = (4 * hq + ((lane & 15) >> 2)) * (AT_KS * 2) + 8 * (lane & 3);
        typedef short v4s __attribute__((ext_vector_type(4))); typedef LAS v4s* lv4;
        f32x4 o[4];
#pragma unroll
        for (int dt = 0; dt < 4; ++dt) o[dt] = (f32x4){0.f, 0.f, 0.f, 0.f};
#pragma unroll
        for (int ks = 0; ks < 4; ++ks) {
            if (2 * ks + 1 >= ilo) {
                u32x4 pw; pw.x = pk2(sc[2 * ks][0], sc[2 * ks][1]); pw.y = pk2(sc[2 * ks][2], sc[2 * ks][3]); pw.z = pk2(sc[2 * ks + 1][0], sc[2 * ks + 1][1]); pw.w = pk2(sc[2 * ks + 1][2], sc[2 * ks + 1][3]);
                const bf16x8 pb = __builtin_bit_cast(bf16x8, pw);
                LAS unsigned char* va = (LAS unsigned char*)Vt + vboff + (16 * (w + 2 * ks)) * (AT_KS * 2);
                u32x2 a0[4], a1[4];
#pragma unroll
                for (int dt = 0; dt < 4; ++dt) { a0[dt] = __builtin_bit_cast(u32x2, __builtin_amdgcn_ds_read_tr16_b64_v4i16((lv4)(va + 32 * dt))); a1[dt] = __builtin_bit_cast(u32x2, __builtin_amdgcn_ds_read_tr16_b64_v4i16((lv4)(va + 2304 + 32 * dt))); }
#pragma unroll
                for (int dt = 0; dt < 4; ++dt) {
                    const bf16x8 av = __builtin_bit_cast(bf16x8, (u32x4){a0[dt].x, a0[dt].y, a1[dt].x, a1[dt].y});
                    o[dt] = __builtin_amdgcn_mfma_f32_16x16x32_bf16(av, pb, o[dt], 0, 0, 0); } } }
        {
            const u32x2 pw = (u32x2){pk2(sc[8][0], sc[8][1]), pk2(sc[8][2], sc[8][3])};
            LAS unsigned char* va = (LAS unsigned char*)Vt + vboff + (16 * (w + 8)) * (AT_KS * 2);
            v4s a8[4];
#pragma unroll
            for (int dt = 0; dt < 4; ++dt) a8[dt] = __builtin_amdgcn_ds_read_tr16_b64_v4i16((lv4)(va + 32 * dt));
#pragma unroll
            for (int dt = 0; dt < 4; ++dt) o[dt] = __builtin_amdgcn_mfma_f32_16x16x16bf16_1k(a8[dt], __builtin_bit_cast(v4s, pw), o[dt], 0, 0, 0);
        }
        const float inv = 1.0f / l; const int tq = at.rho + at.dil * (at.jb * 128 + jq); const size_t tg = (size_t)at.b * SEQ + tq;
        bf16* op = OG + ((size_t)at.g * T + tg) * 512 + at.h * 64 + 4 * hq;
#pragma unroll
        for (int dt = 0; dt < 4; ++dt) { u32x2 wv; wv.x = pk2(o[dt][0] * inv, o[dt][1] * inv); wv.y = pk2(o[dt][2] * inv, o[dt][3] * inv); *(GAS u32x2*)(op + 16 * dt) = wv; }
        if (hq == 0) LSE[((size_t)at.g * T + tg) * 8 + at.h] = (mx + __builtin_amdgcn_logf(l)) * 0.6931471805599453f;
        __syncthreads();
    }
}
__device__ __forceinline__ void p9_merge(const Args& a, Frame& F) {
    unsigned char* ws = a.ws; const bf16* OG = (const bf16*)(ws + WS_OG); const float* LSE = (const float*)(ws + WS_LSE); bf16* OM = (bf16*)(ws + WS_OM);
    const int gw = F.bid * NWAVES + F.wave, NGW = F.G * NWAVES, hh = F.lane >> 3;
    for (int t = gw; t < T; t += NGW) {
        const float l0 = LSE[((size_t)0 * T + t) * 8 + hh], l1 = LSE[((size_t)1 * T + t) * 8 + hh], l2 = LSE[((size_t)2 * T + t) * 8 + hh];
        const float m = fmaxf(l0, fmaxf(l1, l2)); const float e0 = __expf(l0 - m), e1 = __expf(l1 - m), e2 = __expf(l2 - m); const float inv = 1.0f / (e0 + e1 + e2);
        const float w0 = e0 * inv, w1 = e1 * inv, w2 = e2 * inv;
        const u32x4 a0 = __builtin_nontemporal_load((const GAS u32x4*)(OG + ((size_t)0 * T + t) * 512 + 8 * F.lane)), a1 = __builtin_nontemporal_load((const GAS u32x4*)(OG + ((size_t)1 * T + t) * 512 + 8 * F.lane)), a2 = __builtin_nontemporal_load((const GAS u32x4*)(OG + ((size_t)2 * T + t) * 512 + 8 * F.lane));
        u32x4 r;
        r.x = pk2(w0 * bf_lo(a0.x) + w1 * bf_lo(a1.x) + w2 * bf_lo(a2.x), w0 * bf_hi(a0.x) + w1 * bf_hi(a1.x) + w2 * bf_hi(a2.x));
        r.y = pk2(w0 * bf_lo(a0.y) + w1 * bf_lo(a1.y) + w2 * bf_lo(a2.y), w0 * bf_hi(a0.y) + w1 * bf_hi(a1.y) + w2 * bf_hi(a2.y));
        r.z = pk2(w0 * bf_lo(a0.z) + w1 * bf_lo(a1.z) + w2 * bf_lo(a2.z), w0 * bf_hi(a0.z) + w1 * bf_hi(a1.z) + w2 * bf_hi(a2.z));
        r.w = pk2(w0 * bf_lo(a0.w) + w1 * bf_lo(a1.w) + w2 * bf_lo(a2.w), w0 * bf_hi(a0.w) + w1 * bf_hi(a1.w) + w2 * bf_hi(a2.w));
        *(GAS u32x4*)(OM + (size_t)t * 512 + 8 * F.lane) = r;
    }
}

__device__ __forceinline__ void p10_router(const Args& a, Frame& F) {
    unsigned char* ws = a.ws;
    const bf16* x3 = (const bf16*)(ws + WS_X3B); const unsigned long long* ss3 = (const unsigned long long*)(ws + CTL_SS3);
    unsigned* gcnt = (unsigned*)(ws + CTL_CNT); float* tgate = (float*)(ws + WS_TGATE); int* tokep = (int*)(ws + WS_TOKEP); unsigned char* xg = ws + WS_XG;
    LAS float* rw = (LAS float*)F.lds;
    LAS int* lcnt = (LAS int*)(rw + 8192);
    LAS int* lbase = lcnt + 8;
    LAS int* te = lbase + 8;
    LAS int* tp = te + 128;
    LAS float* tgt = (LAS float*)(tp + 128);
    const float* g = a.in[I_NG] + 3 * D; const float* rt = a.in[I_ROUTER]; const float* rb = a.in[I_RBIAS];
    for (int i = F.tid; i < 8192; i += 512) { const int k = i >> 3; rw[(((k & 3) << 8) + (k >> 2)) * 8 + (i & 7)] = rt[i] * g[k]; }
    for (int cb = F.bid; cb < T / 64; cb += F.G) {
        if (F.tid < 8) lcnt[F.tid] = 0;
        __syncthreads();
        {
            float v[64];
#pragma unroll
            for (int i = 0; i < 64; ++i) v[i] = 0.f;
            const bf16* xrow = x3 + (size_t)(cb * 64 + F.wave * 8) * D + 4 * F.lane;
#pragma unroll
            for (int jq = 0; jq < 4; ++jq) {
                u32x2 xw[8];
#pragma unroll
                for (int tt = 0; tt < 8; ++tt) xw[tt] = *(const GAS u32x2*)(xrow + (size_t)tt * D + 256 * jq);
#pragma unroll
                for (int i = 0; i < 4; ++i) { const LAS float* wp = rw + ((i << 8) + F.lane + 64 * jq) * 8; const f32x4 w0 = *(const LAS f32x4*)(wp), w1 = *(const LAS f32x4*)(wp + 4);
#pragma unroll
                    for (int tt = 0; tt < 8; ++tt) { const unsigned xu = (i < 2) ? xw[tt].x : xw[tt].y; const float xv = (i & 1) ? bf_hi(xu) : bf_lo(xu);
                        v[tt * 8 + 0] += xv * w0.x; v[tt * 8 + 1] += xv * w0.y; v[tt * 8 + 2] += xv * w0.z; v[tt * 8 + 3] += xv * w0.w;
                        v[tt * 8 + 4] += xv * w1.x; v[tt * 8 + 5] += xv * w1.y; v[tt * 8 + 6] += xv * w1.z; v[tt * 8 + 7] += xv * w1.w; } }
            }
#pragma unroll
            for (int d = 32, n = 64; d >= 1; d >>= 1, n >>= 1) { const bool up = (F.lane & d) != 0;
#pragma unroll
                for (int i = 0; i < n / 2; ++i) { const float send = up ? v[i] : v[i + n / 2], keep = up ? v[i + n / 2] : v[i]; v[i] = keep + __shfl_xor(send, d); } }
            const int tt = F.lane >> 3, e = F.lane & 7, tl = F.wave * 8 + tt, tok = cb * 64 + tl;
            const float lg = v[0] * rstd_from_ss(ss3, tok) + rb[e];
            float v0 = lg; int e0 = e;
#pragma unroll
            for (int d = 1; d < 8; d <<= 1) { const float ov = __shfl_xor(v0, d); const int oi = __shfl_xor(e0, d); const bool take = (ov > v0) || (ov == v0 && oi < e0); v0 = take ? ov : v0; e0 = take ? oi : e0; }
            float v1 = (e == e0) ? -3.0e38f : lg; int e1 = e;
#pragma unroll
            for (int d = 1; d < 8; d <<= 1) { const float ov = __shfl_xor(v1, d); const int oi = __shfl_xor(e1, d); const bool take = (ov > v1) || (ov == v1 && oi < e1); v1 = take ? ov : v1; e1 = take ? oi : e1; }
            if (e == 0) {
                const float p1 = __expf(v1 - v0), g0 = 1.0f / (1.0f + p1), g1 = p1 * g0;
                te[tl * 2] = e0; te[tl * 2 + 1] = e1; tgt[tl * 2] = g0; tgt[tl * 2 + 1] = g1;
                tp[tl * 2] = __hip_atomic_fetch_add(&lcnt[e0], 1, __ATOMIC_RELAXED, __HIP_MEMORY_SCOPE_WORKGROUP); tp[tl * 2 + 1] = __hip_atomic_fetch_add(&lcnt[e1], 1, __ATOMIC_RELAXED, __HIP_MEMORY_SCOPE_WORKGROUP);
            }
        }
        __syncthreads();
        if (F.tid < 8) lbase[F.tid] = (int)__hip_atomic_fetch_add(gcnt + F.tid, (unsigned)lcnt[F.tid], __ATOMIC_RELAXED, __HIP_MEMORY_SCOPE_AGENT);
        __syncthreads();
        if (F.tid < 128) { const int tl = F.tid >> 1, s = F.tid & 1, e = te[tl * 2 + s], pos = lbase[e] + tp[tl * 2 + s];
            tgate[(cb * 64 + tl) * 2 + s] = tgt[tl * 2 + s]; tokep[(cb * 64 + tl) * 2 + s] = (e << 16) | pos; }
        for (int k = 0; k < 16; ++k) {
            const int pi = F.wave * 16 + k, tl = pi >> 1, e = te[pi], pos = lbase[e] + tp[pi], tok = cb * 64 + tl;
            const GAS u32x4* src = (const GAS u32x4*)(x3 + (size_t)tok * D) + 2 * F.lane;
            const u32x4 p0 = src[0], p1 = src[1]; const float rs = rstd_from_ss(ss3, tok);
            u32x4 o; o.x = pk4_fp8(bf_lo(p0.x) * rs, bf_hi(p0.x) * rs, bf_lo(p0.y) * rs, bf_hi(p0.y) * rs); o.y = pk4_fp8(bf_lo(p0.z) * rs, bf_hi(p0.z) * rs, bf_lo(p0.w) * rs, bf_hi(p0.w) * rs);
            o.z = pk4_fp8(bf_lo(p1.x) * rs, bf_hi(p1.x) * rs, bf_lo(p1.y) * rs, bf_hi(p1.y) * rs); o.w = pk4_fp8(bf_lo(p1.z) * rs, bf_hi(p1.z) * rs, bf_lo(p1.w) * rs, bf_hi(p1.w) * rs);
            *(GAS u32x4*)(xg + ((size_t)e * T + pos) * D + 16 * F.lane) = o;
        }
        __syncthreads();
    }
}
__device__ __forceinline__ void p11_gather(const Args& a, Frame& F) {
    unsigned char* ws = a.ws;
    const unsigned* gcnt = (const unsigned*)(ws + CTL_CNT); const int* list = (const int*)(ws + WS_LIST);
    const bf16* x3 = (const bf16*)(ws + WS_X3B); unsigned char* xg = ws + WS_XG;
    const unsigned long long* ss3 = (const unsigned long long*)(ws + CTL_SS3);
    int cnt[8], up[9], pp[8]; { int s = 0, p = 0;
_Pragma("unroll")
        for (int e = 0; e < 8; ++e) { cnt[e] = (int)gcnt[e]; up[e] = s; pp[e] = p; s += cnt[e]; p += ((cnt[e] + 255) >> 8) << 8; } up[8] = s; }
    const int gw = F.bid * NWAVES + F.wave, NGW = F.G * NWAVES, total = up[8];
    for (int i = gw; i < total; i += NGW) {
        int e = 0;
#pragma unroll
        for (int k = 1; k < 8; ++k) e += (i >= up[k]) ? 1 : 0;
        int pos = i, pbase = 0;
#pragma unroll
        for (int k = 0; k < 8; ++k) if (k == e) { pos = i - up[k]; pbase = pp[k]; }
        const int tok = list[e * T + pos], slot = pbase + pos;
        const GAS u32x4* src = (const GAS u32x4*)(x3 + (size_t)tok * D) + 2 * F.lane;
        const u32x4 p0 = src[0], p1 = src[1]; const float rs = rstd_from_ss(ss3, tok);
        u32x4 o; o.x = pk4_fp8(bf_lo(p0.x) * rs, bf_hi(p0.x) * rs, bf_lo(p0.y) * rs, bf_hi(p0.y) * rs); o.y = pk4_fp8(bf_lo(p0.z) * rs, bf_hi(p0.z) * rs, bf_lo(p0.w) * rs, bf_hi(p0.w) * rs);
        o.z = pk4_fp8(bf_lo(p1.x) * rs, bf_hi(p1.x) * rs, bf_lo(p1.y) * rs, bf_hi(p1.y) * rs); o.w = pk4_fp8(bf_lo(p1.z) * rs, bf_hi(p1.z) * rs, bf_lo(p1.w) * rs, bf_hi(p1.w) * rs);
        *(GAS u32x4*)(xg + (size_t)slot * D + 16 * F.lane) = o;
    }
}
__device__ __forceinline__ void fin_rows(const bf16* cb, const bf16* slab, int s, int rowf, int lane, u32x2 (&r)[4]) {
    if (s < rowf) { const GAS u32x2* c = (const GAS u32x2*)(cb + (size_t)s * D) + lane;
#pragma unroll
        for (int j = 0; j < 4; ++j) r[j] = __builtin_nontemporal_load(c + 64 * j); }
    else {
#pragma unroll
        for (int j = 0; j < 4; ++j) { f32x4 e = (f32x4){0.f, 0.f, 0.f, 0.f};
#pragma unroll
            for (int sl = 0; sl < 7; ++sl) { const u32x2 p = *((const GAS u32x2*)(slab + ((size_t)sl * 2048 + (s - rowf)) * D) + lane + 64 * j); e += (f32x4){bf_lo(p.x), bf_hi(p.x), bf_lo(p.y), bf_hi(p.y)}; }
            r[j].x = pk2(e.x, e.y); r[j].y = pk2(e.z, e.w); }
    }
}
__device__ __forceinline__ void p15_final(const Args& a, Frame& F) {
    unsigned char* ws = a.ws;
    const unsigned* gcnt = (const unsigned*)(ws + CTL_CNT); const int* tokep = (const int*)(ws + WS_TOKEP); const bf16* cb = (const bf16*)(ws + WS_CONTRIB); const float* tgate = (const float*)(ws + WS_TGATE);
    const float* fg = a.in[I_FG]; float* out = a.out; const bf16* x3b = (const bf16*)(ws + WS_X3B);
    int pp[8]; int ptot; { int p = 0;
_Pragma("unroll")
        for (int e = 0; e < 8; ++e) { pp[e] = p; p += (((int)gcnt[e] + 255) >> 8) << 8; } ptot = p; }
    const int MT = ptot >> 8, rowf = (MT - pg8::moe_tail_tiles(MT)) << 8;
    const bf16* slab = (const bf16*)(ws + WS_SLAB);
    const int gw = F.bid * NWAVES + F.wave, NGW = F.G * NWAVES;
    f32x4 gv[4];
#pragma unroll
    for (int j = 0; j < 4; ++j) gv[j] = *(const GAS f32x4*)(fg + 4 * F.lane + 256 * j);
    for (int blk = gw; blk < T / 8; blk += NGW) {
        const int m0 = blk * 8;
        int tk = 0; float tg = 0.f;
        if (F.lane < 16) { tk = tokep[m0 * 2 + F.lane]; tg = tgate[m0 * 2 + F.lane]; }
        u32x2 cx[4], ca[4], cc[4], nx[4], na[4], nc[4];
#define FIN_LOAD(X, A, C, i) do { const int _e0 = __builtin_amdgcn_readlane(tk, 2 * (i)), _e1 = __builtin_amdgcn_readlane(tk, 2 * (i) + 1); int _s0 = _e0 & 0xffff, _s1 = _e1 & 0xffff; \
            _Pragma("unroll") for (int k = 0; k < 8; ++k) { if ((_e0 >> 16) == k) _s0 += pp[k]; if ((_e1 >> 16) == k) _s1 += pp[k]; } \
            const GAS u32x2* _x = (const GAS u32x2*)(x3b + (size_t)(m0 + (i)) * D) + F.lane; \
            _Pragma("unroll") for (int j = 0; j < 4; ++j) X[j] = __builtin_nontemporal_load(_x + 64 * j); \
            fin_rows(cb, slab, _s0, rowf, F.lane, A); fin_rows(cb, slab, _s1, rowf, F.lane, C); } while (0)
        FIN_LOAD(cx, ca, cc, 0);
#pragma unroll
        for (int i = 0; i < 8; ++i) {
            if (i + 1 < 8) FIN_LOAD(nx, na, nc, i + 1);
            const float g0 = __builtin_bit_cast(float, __builtin_amdgcn_readlane(__builtin_bit_cast(int, tg), 2 * i)), g1 = __builtin_bit_cast(float, __builtin_amdgcn_readlane(__builtin_bit_cast(int, tg), 2 * i + 1));
            f32x4 v[4]; float sq = 0.f;
#pragma unroll
            for (int j = 0; j < 4; ++j) {
                v[j].x = bf_lo(cx[j].x) + g0 * bf_lo(ca[j].x) + g1 * bf_lo(cc[j].x); v[j].y = bf_hi(cx[j].x) + g0 * bf_hi(ca[j].x) + g1 * bf_hi(cc[j].x);
                v[j].z = bf_lo(cx[j].y) + g0 * bf_lo(ca[j].y) + g1 * bf_lo(cc[j].y); v[j].w = bf_hi(cx[j].y) + g0 * bf_hi(ca[j].y) + g1 * bf_hi(cc[j].y);
                sq += (v[j].x * v[j].x + v[j].y * v[j].y) + (v[j].z * v[j].z + v[j].w * v[j].w); }
            const float rstd = 1.f / sqrtf(wave_sum(sq) * (1.f / D) + RMS_EPS);
            GAS f32x4* xr = (GAS f32x4*)(out + (size_t)(m0 + i) * D) + F.lane;
#pragma unroll
            for (int j = 0; j < 4; ++j) __builtin_nontemporal_store(v[j] * rstd * gv[j], xr + 64 * j);
#pragma unroll
            for (int j = 0; j < 4; ++j) { cx[j] = nx[j]; ca[j] = na[j]; cc[j] = nc[j]; }
        }
#undef FIN_LOAD
    }
}

__device__ __forceinline__ const LAS float* row_scale_table(Frame& F, const unsigned long long* ss) {
    if ((F.G & 7) != 0) return nullptr;
    LAS float* rtab = (LAS float*)(F.lds + 131072);
    const int r0 = 2048 * (F.bid & 7);
    for (int i = F.tid; i < 2048; i += NWAVES * 64) rtab[i] = rstd_from_ss(ss, r0 + i);
    __syncthreads();
    return rtab;
}
constexpr int NPHASE = 17;
__global__ void __launch_bounds__(NWAVES * 64, 2) fwd(Args args) {
    extern __shared__ __attribute__((aligned(16))) unsigned char lds[];
    Frame F; F.lds = (LAS unsigned char*)lds; F.tid = threadIdx.x; F.lane = F.tid & 63; F.wave = __builtin_amdgcn_readfirstlane(F.tid >> 6); F.G = gridDim.x; F.bid = blockIdx.x;
    volatile LAS unsigned* MISC = (volatile LAS unsigned*)(F.lds + MISC_OFF);
    unsigned char* ws = args.ws;
    if (F.tid < 64) MISC[F.tid] = 0u;
    __syncthreads();
    const int lo = args.ph_lo, hi = args.ph_hi;
    XcdBarrier bar; bar.bar = (unsigned*)(ws + CTL_BAR); bar.x = 0; bar.st = nullptr;
    if (hi - lo > 1) bar = xcd_barrier_post((unsigned*)(ws + CTL_BAR), MISC + 8);
#ifdef ONLY_PHASE
#define IN(k) ((k) == ONLY_PHASE && lo <= (k) && (k) < hi)
#else
#define IN(k) (lo <= (k) && (k) < hi)
#endif
#define SEAM(k) do { if (IN(k) && IN((k) + 1)) xcd_barrier(bar); } while (0)
    LAS unsigned char* ring = F.lds + RING_OFF;
    unsigned long long* ss1 = (unsigned long long*)(ws + CTL_SS1); unsigned long long* ss2 = (unsigned long long*)(ws + CTL_SS2); unsigned long long* ss3 = (unsigned long long*)(ws + CTL_SS3);

    if (IN(0)) { p0_zero(args, F); run_jobs(args, F, 0, NJ_EARLY, F.bid * NWAVES + F.wave, F.G * NWAVES); p0_hcat(args, F); }
#if defined(REPEAT_PHASE) && REPEAT_PHASE == 0
    if (IN(0)) { run_jobs(args, F, 0, NJ_EARLY, F.bid * NWAVES + F.wave, F.G * NWAVES); p0_hcat(args, F); }
#endif
    SEAM(0);
    if (IN(1)) {
        pg8::Gemm2 g{{(const bf16*)(ws + WS_HCAT), (const bf16*)(ws + WS_HCAT)}, {(const bf16*)(ws + WS_WLORA), (const bf16*)(ws + WS_WLORA)}, {1024, 1024}, {2048, 2048}};
        G1Order S{F.G, F.bid, 0};
        EpiG1 E{(bf16*)(ws + WS_R), (bf16*)(ws + WS_LH)};
        pg8::gemm_phase2<EpiG1, G1Order>(ring, g, S, E, (unsigned*)(ws + CTL_LORA_DONE));
        __syncthreads();
        pg8::Gemm g1{(const bf16*)(ws + WS_XR), (const bf16*)(ws + WS_WRKV), 1024, 1024, 0}; G1Order S1{F.G, F.bid, 1};
        pg8::gemm_phase<EpiG1, G1Order>(ring, g1, S1, E); }
    if (IN(1) && IN(2)) {
        if (F.tid == 0) { unsigned* sigp = (unsigned*)(ws + CTL_LORA_DONE); unsigned sp = 0;
            while (__hip_atomic_load(sigp, __ATOMIC_RELAXED, __HIP_MEMORY_SCOPE_AGENT) < 64u) { __builtin_amdgcn_s_sleep(1); if (++sp > (1u << 22)) break; }
            __builtin_amdgcn_fence(__ATOMIC_ACQUIRE, "agent"); }
        __syncthreads(); }
    if (IN(2)) {
        pg8::Gemm2 g{{(const bf16*)(ws + WS_LH), (const bf16*)(ws + WS_LH)}, {(const bf16*)(ws + WS_WLU), (const bf16*)(ws + WS_WLU)}, {256, 256}, {128, 128}};
        G2Order S; S.so.init(T / 256, 3072 / 256, F.G, F.bid);
        EpiG2 E{(bf16*)(ws + WS_LW), args.in[I_W0], args.in[I_A0]};
        pg8::gemm_phase2<EpiG2, G2Order>(ring, g, S, E); }
    SEAM(2);
    if (IN(3)) {
        const int nscan = F.G > 128 ? 128 : F.G, nconv = F.G - nscan;
        constexpr int CONV_SPLIT = 32;
        if (F.bid < nscan) { for (int pair = F.bid; pair < 128; pair += nscan) { p3_scan_chunked(args, F, pair); __syncthreads(); }
#if defined(SCAN_TWICE)
            for (int pair = F.bid; pair < 128; pair += nscan) { p3_scan_chunked<SCAN_TWICE>(args, F, pair); __syncthreads(); }
#endif
            if (nconv > 0) run_jobs_moe(args, F, F.bid * NWAVES + F.wave, nscan * NWAVES, CONV_SPLIT, 32); else { run_jobs(args, F, NJ_EARLY, NJ0, F.bid * NWAVES + F.wave, F.G * NWAVES); run_jobs_moe(args, F, F.bid * NWAVES + F.wave, F.G * NWAVES, 0, 32); } }
        else { run_jobs(args, F, NJ_EARLY, NJ0, (F.bid - nscan) * NWAVES + F.wave, nconv * NWAVES); run_jobs_moe(args, F, (F.bid - nscan) * NWAVES + F.wave, nconv * NWAVES, 0, CONV_SPLIT); }
#if defined(CONV_TWICE)
        if (F.bid >= nscan) { __syncthreads(); run_jobs_moe(args, F, (F.bid - nscan) * NWAVES + F.wave, nconv * NWAVES, 0, CONV_SPLIT); }
#endif
    }
    SEAM(3);
    if (IN(4)) {
        pg8::Gemm g{(const bf16*)(ws + WS_Z), (const bf16*)(ws + WS_WO), 1024, 1024, 0}; pg8::StaticOrder S; S.init(T / 256, 4, F.G, F.bid);
        EpiResT<true> E{args.in[I_X], nullptr, (bf16*)(ws + WS_X1B), ss1};
        pg8::gemm_phase<EpiResT<true>, pg8::StaticOrder>(ring, g, S, E); }
    SEAM(4);
    if (IN(5)) {
        pg8::Gemm g{(const bf16*)(ws + WS_X1B), (const bf16*)(ws + WS_W13F), 1024, 1024, 0}; pg8::StaticOrder S; S.init(T / 256, 2 * FFD / 256, F.G, F.bid, true);
        const bool early = ((F.bid >> 3) & 1) != 0;
        pg8::TailHalfOrder TS0, TS1; TS0.init(T / 256, 2 * FFD / 256, F.G, F.bid, early); TS1.init(T / 256, 2 * FFD / 256, F.G, F.bid, !early);
        const LAS float* rtab = row_scale_table(F, ss1);
        EpiSwiglu E{(bf16*)(ws + WS_FH), FFD, ss1, nullptr, 1, rtab}; EpiSwigluT<true> EH{(bf16*)(ws + WS_FH), FFD, ss1, nullptr, 1, rtab};
        pg8::gemm_phase<EpiSwigluT<true>, pg8::TailHalfOrder, false, false, true, false, true>(ring, g, TS0, EH);
        __syncthreads();
        pg8::gemm_phase<EpiSwiglu, pg8::StaticOrder>(ring, g, S, E);
        __syncthreads();
        pg8::gemm_phase<EpiSwigluT<true>, pg8::TailHalfOrder, false, false, true, false, true>(ring, g, TS1, EH); }
    SEAM(5);
    if (IN(6)) {
        pg8::Gemm g{(const bf16*)(ws + WS_FH), (const bf16*)(ws + WS_W2F), FFD / 2, FFD / 2, 0}; pg8::StaticOrder S; S.init(T / 256, 4, F.G, F.bid);
        EpiResT<false> E{nullptr, (const bf16*)(ws + WS_X1B), (bf16*)(ws + WS_X2B), ss2, ws + WS_X2F8};
        pg8::gemm_phase<EpiResT<false>, pg8::StaticOrder, true>(ring, g, S, E, MW2_SCALE_BYTE * 0x01010101, 0x7F7F7F7F); }
    SEAM(6);
    if (IN(7)) {
        pg8::Gemm g{(const bf16*)(ws + WS_X2F8), (const bf16*)(ws + WS_WQKV), 512, 512, 0}; pg8::StaticOrder S; S.init(T / 256, 18, F.G, F.bid, true);
        const bool early = ((F.bid >> 3) & 1) != 0;
        pg8::TailHalfOrder TS0, TS1; TS0.init(T / 256, 18, F.G, F.bid, early); TS1.init(T / 256, 18, F.G, F.bid, !early);
        const LAS float* rtab = row_scale_table(F, ss2);
        EpiQKV E{(bf16*)(ws + WS_Q), ss2, rtab}; EpiQKVT<true> EH{(bf16*)(ws + WS_Q), ss2, rtab};
        pg8::gemm_phase<EpiQKVT<true>, pg8::TailHalfOrder, true, false, true, false, true>(ring, g, TS0, EH, WQKV_SCALE_BYTE * 0x01010101, 0x7F7F7F7F);
        __syncthreads();
        pg8::gemm_phase<EpiQKV, pg8::StaticOrder, true>(ring, g, S, E, WQKV_SCALE_BYTE * 0x01010101, 0x7F7F7F7F);
        __syncthreads();
        pg8::gemm_phase<EpiQKVT<true>, pg8::TailHalfOrder, true, false, true, false, true>(ring, g, TS1, EH, WQKV_SCALE_BYTE * 0x01010101, 0x7F7F7F7F); }
    SEAM(7);
    if (IN(8)) p8_attn_mfma(args, F);
#if defined(REPEAT_PHASE) && REPEAT_PHASE == 8
    if (IN(8)) p8_attn_mfma(args, F);
#endif
    SEAM(8);
    if (IN(9)) p9_merge(args, F);
    SEAM(9);
    if (IN(10)) {
        pg8::Gemm g{(const bf16*)(ws + WS_OM), (const bf16*)(ws + WS_WAO), 512, 512, 0}; pg8::StaticOrder S; S.init(T / 256, 4, F.G, F.bid);
        EpiResT<false> E{nullptr, (const bf16*)(ws + WS_X2B), (bf16*)(ws + WS_X3B), ss3};
        pg8::gemm_phase<EpiResT<false>, pg8::StaticOrder>(ring, g, S, E); }
    SEAM(10);
    if (IN(11)) p10_router(args, F);
    SEAM(11);
    if (IN(13)) {
        int cnt[8];
_Pragma("unroll")
        for (int e = 0; e < 8; ++e) cnt[e] = (int)((const unsigned*)(ws + CTL_CNT))[e];
        pg8::Gemm g{(const bf16*)(ws + WS_XG), (const bf16*)(ws + WS_MW13), 512, 512, (size_t)7168 * 512}; pg8::MoeOrder S; S.init(cnt, 28, F.G, F.bid);
        EpiSwiglu E{(bf16*)(ws + WS_MH), FFE, nullptr, nullptr, 1, nullptr};
        pg8::gemm_phase<EpiSwiglu, pg8::MoeOrder, true, false, MOEUP_ALIGN, true>(ring, g, S, E, MW13_SCALE_BYTE * 0x01010101, 0x7F7F7F7F); }
    SEAM(13);
    if (IN(15)) {
        int cnt[8];
_Pragma("unroll")
        for (int e = 0; e < 8; ++e) cnt[e] = (int)((const unsigned*)(ws + CTL_CNT))[e];
        pg8::Gemm g{(const bf16*)(ws + WS_MH), (const bf16*)(ws + WS_MW2), FFE / 2, FFE / 2, (size_t)1024 * (FFE / 2)}; pg8::MoeDownOrder S; S.init(cnt, FFE / 128, F.G, F.bid);
        EpiGate E{(bf16*)(ws + WS_CONTRIB), (bf16*)(ws + WS_SLAB), S.MTf};
        pg8::gemm_phase<EpiGate, pg8::MoeDownOrder, true, true>(ring, g, S, E, MW2_SCALE_BYTE * 0x01010101, 0x7F7F7F7F); }
    SEAM(15);
    if (IN(16)) p15_final(args, F);
#undef IN
#undef SEAM
}

extern "C" void kernel_launch(void* const* d_in, const int* in_sizes, int n_in, void* d_out, int out_size, void* d_ws, size_t ws_size, hipStream_t stream) {
    static int grid = 0;
    if (grid == 0) {
        if (n_in != 33 || in_sizes[0] != T * D || out_size != T * D || ws_size < WS_END) { fprintf(stderr, "kernel_launch: unexpected shapes: n_in %d in0 %d out %d ws %zu (need %zu)\n", n_in, n_in > 0 ? in_sizes[0] : -1, out_size, ws_size, (size_t)WS_END); grid = -1; return; }
        int dev = 0, cus = 0, per_cu = 0;
        if (hipGetDevice(&dev) != hipSuccess || hipDeviceGetAttribute(&cus, hipDeviceAttributeMultiprocessorCount, dev) != hipSuccess) { grid = -1; return; }
        if (hipFuncSetAttribute((const void*)fwd, hipFuncAttributeMaxDynamicSharedMemorySize, LDS_BYTES) != hipSuccess) { fprintf(stderr, "kernel_launch: hipFuncSetAttribute failed\n"); grid = -1; return; }
        if (hipOccupancyMaxActiveBlocksPerMultiprocessor(&per_cu, (const void*)fwd, NWAVES * 64, LDS_BYTES) != hipSuccess || per_cu < 1) fprintf(stderr, "kernel_launch: occupancy query says %d\n", per_cu);
        (void)hipGetLastError();
        grid = cus;
    }
    if (grid < 0) return;
    (void)hipMemsetAsync((char*)d_ws + WS_CTL, 0, CTL_ZERO_BYTES, stream);
    Args a{};
    for (int i = 0; i < 33; ++i) a.in[i] = (const float*)d_in[i];
    a.out = (float*)d_out; a.ws = (unsigned char*)d_ws;
#if MK_ONE_LAUNCH
    a.ph_lo = 0; a.ph_hi = NPHASE;
    hipLaunchKernelGGL(fwd, dim3(grid), dim3(NWAVES * 64), LDS_BYTES, stream, a);
#else
    for (int p = 0; p < NPHASE; ++p) { a.ph_lo = p; a.ph_hi = p + 1; hipLaunchKernelGGL(fwd, dim3(grid), dim3(NWAVES * 64), LDS_BYTES, stream, a); }
#endif
}
```
